# Optimizing an MI355X kernel written in HIP

```python
import math
import jax
import jax.numpy as jnp
from jax import lax
import numpy as np

D_MODEL = 1024
BATCH = 16
SEQ = 2048
DEPTH = 2

CHUNK = 64
Q_BLOCK = 128
D_FF = 4 * D_MODEL
NORM_EPS = 1e-6

FOX_HEADS = 8
FOX_HEAD_DIM = D_MODEL // 16
FOX_W = FOX_HEADS * FOX_HEAD_DIM
FOX_F_BIAS_MEAN = 2.0
GDN_HEADS = 4
GDN_HEAD_DIM = D_MODEL // 8
GDN_W = GDN_HEADS * GDN_HEAD_DIM
GDN_CONV = 4
EVEN_SPLIT = (FOX_W, FOX_W, FOX_W, FOX_HEADS,
              GDN_W, GDN_W, GDN_W, GDN_HEADS, GDN_HEADS, GDN_W)
EVEN_IN = 3 * FOX_W + FOX_HEADS + 4 * GDN_W + 2 * GDN_HEADS

HGRN_EXPAND = 128
HGRN_HEADS = D_MODEL // HGRN_EXPAND
HGRN_HEAD_DIM = HGRN_EXPAND
ODD_IN = 4 * D_MODEL

kernel_name = "fox_gdn_hgrn2_hybrid_trunk"


def rms_norm(x, gain):
    xf = x.astype(jnp.float32)
    y = xf * lax.rsqrt(jnp.mean(xf * xf, axis=-1, keepdims=True) + NORM_EPS)
    return (y * gain.astype(jnp.float32)).astype(x.dtype)


def l2_normalize(x):
    xf = x.astype(jnp.float32)
    return xf * lax.rsqrt(jnp.sum(xf * xf, axis=-1, keepdims=True) + NORM_EPS)


def split_cols(z, sizes):
    out, start = [], 0
    for s in sizes:
        out.append(z[..., start:start + s])
        start += s
    return out


def causal_depthwise_conv(x, w):
    k_w, c = w.shape
    return lax.conv_general_dilated(
        x, w[:, None, :].astype(x.dtype), window_strides=(1,),
        padding=[(k_w - 1, 0)], dimension_numbers=("NWC", "WIO", "NWC"),
        feature_group_count=c)


def squared_relu_mlp(h, w1, w2):
    a = jax.nn.relu(h @ w1)
    return (a * a) @ w2


def forgetting_attention(q, k, v, f_logit):
    b, t, h, dh = q.shape
    c = jnp.cumsum(jax.nn.log_sigmoid(f_logit.astype(jnp.float32)), axis=1)
    c = c.transpose(0, 2, 1)
    scale = dh ** -0.5
    outs = []
    for i in range(t // Q_BLOCK):
        q0, q1 = i * Q_BLOCK, (i + 1) * Q_BLOCK
        s = jnp.einsum("bqhd,bkhd->bhqk", q[:, q0:q1], k[:, :q1]).astype(jnp.float32) * scale
        s = s + c[:, :, q0:q1, None] - c[:, :, None, :q1]
        mask = (q0 + jnp.arange(Q_BLOCK))[:, None] >= jnp.arange(q1)[None, :]
        s = jnp.where(mask, s, -jnp.inf)
        p = jax.nn.softmax(s, axis=-1).astype(v.dtype)
        outs.append(jnp.einsum("bhqk,bkhd->bqhd", p, v[:, :q1]))
    return jnp.concatenate(outs, axis=1)


def gated_delta_rule(q, k, v, log_alpha, beta):
    b, h, t, dk = q.shape
    dv = v.shape[-1]
    n = t // CHUNK
    rs = lambda a: a.reshape(b, h, n, CHUNK, *a.shape[3:])
    q = rs(q * dk ** -0.5)
    k, v = rs(k), rs(v)
    beta = rs(beta)
    g = jnp.cumsum(rs(log_alpha), axis=-1)
    idx = jnp.arange(CHUNK)
    causal = idx[:, None] >= idx[None, :]
    strict = idx[:, None] > idx[None, :]
    decay = jnp.exp(jnp.where(causal, g[..., :, None] - g[..., None, :], -jnp.inf))
    k_beta = k * beta[..., None]
    a_mat = jnp.where(strict, jnp.einsum("bhnck,bhndk->bhncd", k_beta, k) * decay, 0.0)
    eye = jnp.eye(CHUNK, dtype=jnp.float32)
    rhs = jnp.concatenate([v * beta[..., None], k_beta * jnp.exp(g)[..., None]], axis=-1)
    wu = lax.linalg.triangular_solve(eye + a_mat, rhs, left_side=True, lower=True,
                                     unit_diagonal=True)
    u, w = wu[..., :dv], wu[..., dv:]
    qk = jnp.where(causal, jnp.einsum("bhnck,bhndk->bhncd", q, k) * decay, 0.0)
    q_dec = q * jnp.exp(g)[..., None]
    g_last = g[..., -1]
    k_dec = k * jnp.exp(g_last[..., None] - g)[..., None]

    def step(s_state, xs):
        qk_i, q_dec_i, k_dec_i, u_i, w_i, gl_i = xs
        v_new = u_i - jnp.einsum("bhck,bhkv->bhcv", w_i, s_state)
        o = (jnp.einsum("bhck,bhkv->bhcv", q_dec_i, s_state)
             + jnp.einsum("bhcd,bhdv->bhcv", qk_i, v_new))
        s_state = (s_state * jnp.exp(gl_i)[..., None, None]
                   + jnp.einsum("bhck,bhcv->bhkv", k_dec_i, v_new))
        return s_state, o

    xs = tuple(jnp.moveaxis(a, 2, 0) for a in (qk, q_dec, k_dec, u, w, g_last))
    s0 = jnp.zeros((b, h, dk, dv), jnp.float32)
    _, o = lax.scan(step, s0, xs)
    return jnp.moveaxis(o, 0, 2).reshape(b, h, t, dv)


def hgrn2_recurrence(q, k, i_val, log_f):
    b, h, t, dk = q.shape
    dv = i_val.shape[-1]
    n = t // CHUNK
    rs = lambda a: a.reshape(b, h, n, CHUNK, a.shape[-1])
    q, k, i_val = rs(q), rs(k), rs(i_val)
    bcum = jnp.cumsum(rs(log_f), axis=-2)
    b_last = bcum[..., -1, :]
    q_dec = q * jnp.exp(bcum)
    k_dec = k * jnp.exp(b_last[..., None, :] - bcum)
    idx = jnp.arange(CHUNK)
    causal = (idx[:, None] >= idx[None, :])[:, :, None]

    def step(s_state, xs):
        q_i, k_i, v_i, b_i, q_dec_i, k_dec_i, bl_i = xs
        diff = b_i[:, :, :, None, :] - b_i[:, :, None, :, :]
        dec = jnp.exp(jnp.where(causal, diff, -jnp.inf))
        a_mat = jnp.einsum("bhtk,bhsk,bhtsk->bhts", q_i, k_i, dec)
        o = (jnp.einsum("bhtk,bhkv->bhtv", q_dec_i, s_state)
             + jnp.einsum("bhts,bhsv->bhtv", a_mat, v_i))
        s_state = (s_state * jnp.exp(bl_i)[..., None]
                   + jnp.einsum("bhsk,bhsv->bhkv", k_dec_i, v_i))
        return s_state, o

    xs = tuple(jnp.moveaxis(a, 2, 0) for a in (q, k, i_val, bcum, q_dec, k_dec, b_last))
    s0 = jnp.zeros((b, h, dk, dv), jnp.float32)
    _, o = lax.scan(step, s0, xs)
    return jnp.moveaxis(o, 0, 2).reshape(b, h, t, dv)


def fox_gdn_mixer(h, w_in, fox_q_norm, fox_k_norm, fox_f_bias, gdn_conv, gdn_A_log,
                  gdn_dt_bias, gdn_o_norm, w_out):
    b, t, _ = h.shape
    z = h @ w_in
    fq, fk, fv, ff, gq, gk, gv, gb, ga, gg = split_cols(z, EVEN_SPLIT)
    fq = rms_norm(fq.reshape(b, t, FOX_HEADS, FOX_HEAD_DIM), fox_q_norm)
    fk = rms_norm(fk.reshape(b, t, FOX_HEADS, FOX_HEAD_DIM), fox_k_norm)
    fv = fv.reshape(b, t, FOX_HEADS, FOX_HEAD_DIM)
    fox_o = forgetting_attention(fq, fk, fv, ff + fox_f_bias)
    fox_o = fox_o.reshape(b, t, FOX_W).astype(h.dtype)
    conv = jax.nn.silu(causal_depthwise_conv(jnp.concatenate([gq, gk, gv], axis=-1), gdn_conv))
    cq, ck, cv = split_cols(conv, (GDN_W, GDN_W, GDN_W))
    to_heads = lambda a: a.reshape(b, t, GDN_HEADS, GDN_HEAD_DIM).transpose(0, 2, 1, 3)
    q = to_heads(l2_normalize(cq.reshape(b, t, GDN_HEADS, GDN_HEAD_DIM)).reshape(b, t, GDN_W))
    k = to_heads(l2_normalize(ck.reshape(b, t, GDN_HEADS, GDN_HEAD_DIM)).reshape(b, t, GDN_W))
    v = to_heads(cv.astype(jnp.float32))
    beta = jax.nn.sigmoid(gb.astype(jnp.float32)).transpose(0, 2, 1)
    log_alpha = (-jnp.exp(gdn_A_log.astype(jnp.float32))
                 * jax.nn.softplus(ga.astype(jnp.float32) + gdn_dt_bias.astype(jnp.float32)))
    gdn_o = gated_delta_rule(q, k, v, log_alpha.transpose(0, 2, 1), beta)
    gdn_o = gdn_o.transpose(0, 2, 1, 3)
    gate = jax.nn.silu(gg.astype(jnp.float32)).reshape(b, t, GDN_HEADS, GDN_HEAD_DIM)
    gdn_o = (rms_norm(gdn_o, gdn_o_norm) * gate).reshape(b, t, GDN_W).astype(h.dtype)
    return jnp.concatenate([fox_o, gdn_o], axis=-1) @ w_out


def hgrn2_mixer(h, w_in, lower_bound, o_norm, w_out):
    b, t, _ = h.shape
    z = h @ w_in
    zq, zf, zi, zg = split_cols(z, (D_MODEL, D_MODEL, D_MODEL, D_MODEL))
    q = jax.nn.silu(zq.astype(jnp.float32))
    f = lower_bound + (1.0 - lower_bound) * jax.nn.sigmoid(zf.astype(jnp.float32))
    k = 1.0 - f
    log_f = jnp.log(f)
    to_heads = lambda a: a.reshape(b, t, HGRN_HEADS, HGRN_HEAD_DIM).transpose(0, 2, 1, 3)
    o = hgrn2_recurrence(to_heads(q), to_heads(k), to_heads(zi.astype(jnp.float32)),
                         to_heads(log_f))
    o = o.transpose(0, 2, 1, 3)
    gate = jax.nn.silu(zg.astype(jnp.float32)).reshape(b, t, HGRN_HEADS, HGRN_HEAD_DIM)
    o = (rms_norm(o, o_norm) * gate).reshape(b, t, D_MODEL).astype(h.dtype)
    return o @ w_out


def setup_inputs(seed: int = 0) -> dict:
    key = jax.random.key(seed)
    ks = jax.random.split(key, 24)
    f32 = jnp.float32

    def dense(k, fan_in, fan_out):
        return jax.random.normal(k, (fan_in, fan_out), f32) * fan_in ** -0.5

    def gain(k, n):
        return 1.0 + 0.1 * jax.random.normal(k, (n,), f32)

    dt = jnp.exp(jax.random.uniform(ks[8], (GDN_HEADS,), f32, math.log(1e-3), math.log(1e-1)))
    return {
        "x": jax.random.normal(ks[0], (BATCH, SEQ, D_MODEL), f32),
        "l0_mix_norm": gain(ks[1], D_MODEL),
        "l0_w_in": dense(ks[2], D_MODEL, EVEN_IN),
        "l0_fox_q_norm": gain(ks[3], FOX_HEAD_DIM),
        "l0_fox_k_norm": gain(ks[4], FOX_HEAD_DIM),
        "l0_fox_f_bias": FOX_F_BIAS_MEAN + 0.1 * jax.random.normal(ks[5], (FOX_HEADS,), f32),
        "l0_gdn_conv": jax.random.normal(ks[6], (GDN_CONV, 3 * GDN_W), f32) * GDN_CONV ** -0.5,
        "l0_gdn_A_log": jnp.log(jax.random.uniform(ks[7], (GDN_HEADS,), f32, 1.0, 16.0)),
        "l0_gdn_dt_bias": dt + jnp.log(-jnp.expm1(-dt)),
        "l0_gdn_o_norm": gain(ks[9], GDN_HEAD_DIM),
        "l0_w_out": dense(ks[10], FOX_W + GDN_W, D_MODEL),
        "l0_ffn_norm": gain(ks[11], D_MODEL),
        "l0_w_ff1": dense(ks[12], D_MODEL, D_FF),
        "l0_w_ff2": dense(ks[13], D_FF, D_MODEL),
        "l1_mix_norm": gain(ks[14], D_MODEL),
        "l1_w_in": dense(ks[15], D_MODEL, ODD_IN),
        "l1_hgrn_o_norm": gain(ks[16], HGRN_HEAD_DIM),
        "l1_w_out": dense(ks[17], D_MODEL, D_MODEL),
        "l1_ffn_norm": gain(ks[18], D_MODEL),
        "l1_w_ff1": dense(ks[19], D_MODEL, D_FF),
        "l1_w_ff2": dense(ks[20], D_FF, D_MODEL),
        "hgrn_lb_logits": 0.5 * jax.random.normal(ks[21], (DEPTH, D_MODEL), f32),
    }


def reference(x, l0_mix_norm, l0_w_in, l0_fox_q_norm, l0_fox_k_norm, l0_fox_f_bias,
              l0_gdn_conv, l0_gdn_A_log, l0_gdn_dt_bias, l0_gdn_o_norm, l0_w_out,
              l0_ffn_norm, l0_w_ff1, l0_w_ff2, l1_mix_norm, l1_w_in, l1_hgrn_o_norm,
              l1_w_out, l1_ffn_norm, l1_w_ff1, l1_w_ff2, hgrn_lb_logits):
    lb_soft = jax.nn.softmax(hgrn_lb_logits.astype(jnp.float32), axis=0)
    lower_bounds = jnp.cumsum(lb_soft, axis=0) - lb_soft[0]
    layers = (
        dict(mix_norm=l0_mix_norm, ffn_norm=l0_ffn_norm, w_ff1=l0_w_ff1, w_ff2=l0_w_ff2),
        dict(mix_norm=l1_mix_norm, ffn_norm=l1_ffn_norm, w_ff1=l1_w_ff1, w_ff2=l1_w_ff2),
    )
    for l in range(DEPTH):
        p = layers[l]
        h = rms_norm(x, p["mix_norm"])
        if l % 2 == 0:
            mix = fox_gdn_mixer(h, l0_w_in, l0_fox_q_norm, l0_fox_k_norm, l0_fox_f_bias,
                                l0_gdn_conv, l0_gdn_A_log, l0_gdn_dt_bias, l0_gdn_o_norm,
                                l0_w_out)
        else:
            mix = hgrn2_mixer(h, l1_w_in, lower_bounds[l], l1_hgrn_o_norm, l1_w_out)
        x = x + mix.astype(x.dtype)
        x = x + squared_relu_mlp(rms_norm(x, p["ffn_norm"]), p["w_ff1"], p["w_ff2"]).astype(x.dtype)
    return x
```

```cpp
#include <hip/hip_runtime.h>
#include <hip/hip_cooperative_groups.h>
#include <cstdio>
#include <cstdint>
namespace cg = cooperative_groups;
__device__ __forceinline__ int lane_id_() { int l; asm volatile("v_mbcnt_lo_u32_b32 %0, -1, 0\n\tv_mbcnt_hi_u32_b32 %0, -1, %0" : "=v"(l)); return l; }
#define TIDX(wv_) ((wv_) * 64 + lane_id_())
namespace pg8 {
#define PG8_LAS __attribute__((address_space(3)))
typedef unsigned short bf16_t;
typedef short bf16x8 __attribute__((ext_vector_type(8)));
typedef float f32x4 __attribute__((ext_vector_type(4)));
typedef unsigned u32x4 __attribute__((ext_vector_type(4)));
constexpr int BM = 256, BK = 64, HALF = 128, HTB = HALF * BK * 2  , STAGE_BYTES = 8 * HTB, NXCD = 8, WGM = 8;

__host__ __device__ __forceinline__ int lds_byte(int r, int c) { const int st = (r >> 4) * 2 + (c >> 5), rr = r & 15, cc = c & 31, ob = rr * 64 + cc * 2; return st * 1024 + (ob ^ (((ob >> 9) & 1) << 5)); }
__host__ __device__ __forceinline__ void stage_rc(int b, int& R, int& C) { const int st = b / 1024, sb = b % 1024, swz = sb ^ (((sb >> 9) & 1) << 5); R = (st >> 1) * 16 + swz / 64; C = (st & 1) * 32 + (swz % 64) / 2; }
__host__ __device__ __forceinline__ int perm32(int rho) { const int n = rho >> 4, i = rho & 15; return 8 * (i >> 2) + 4 * n + (i & 3); }

struct Unit { int pm, pn; };
struct Gemm { const bf16_t* A; const bf16_t* Bt; int M, N, K; };

struct StaticOrder {
    int nM, nN, nwg, G, c, wgm;
    __host__ __device__ void init(int M, int N, int G_, int c_, int wgm_ = WGM) { nM = M / BM; nN = N / BM; nwg = nM * nN; G = G_; c = c_; wgm = wgm_; }
    __host__ __device__ bool next(int i, Unit& u) const {
        const long L = (long)i * G + c; if (L >= nwg) return false;
        int wgid = (int)L; { const int q = nwg / NXCD, r = nwg % NXCD, xcd = wgid % NXCD, off = wgid / NXCD; wgid = (xcd < r ? xcd * (q + 1) : r * (q + 1) + (xcd - r) * q) + off; }
        const int nig = wgm * nN, gid = wgid / nig, fm = gid * wgm, gsz = (nM - fm) < wgm ? (nM - fm) : wgm;
        u.pm = fm + ((wgid % nig) % gsz); u.pn = (wgid % nig) / gsz; return true;
    }
    __device__ __forceinline__ void a_ready(const Unit&) const {}
    __device__ __forceinline__ void done(const Unit&) const {}
};

__device__ __forceinline__ unsigned cvt_pk_bf16_unused(float lo, float hi) { return 0; }
template <class Epi, class Sched, bool ALIGN_EPI = false, bool SP2 = false>
__device__ __forceinline__ void gemm_phase(PG8_LAS unsigned char* lds, const Gemm g, const Sched& S, const Epi& E, const int wv_) {
    int tid_ = TIDX(wv_); asm volatile("" : "+v"(tid_)); const int tid = tid_, wid = __builtin_amdgcn_readfirstlane(tid >> 6), lane = tid & 63, wr = wid >> 2, wc = wid & 3, fr = lane & 15, fq = lane >> 4;
    const int K = g.K, nt = K / BK;
    unsigned voffA[2], voffB[2];
#pragma unroll
    for (int i = 0; i < 2; ++i) { int R, C; stage_rc(tid * 16 + i * 8192, R, C); const int Rb = Epi::PERM ? ((R & ~31) + perm32(R & 31)) : R;
        voffA[i] = (unsigned)(R * K + C) * 2u; voffB[i] = (unsigned)(Rb * K + C) * 2u; }
    const size_t kstep = (size_t)(BK * 2);
    const size_t hstep = (size_t)HALF * K * 2;
    const size_t tstep = 2 * hstep;
    const unsigned ldsw = (unsigned)wid * 1024u;
    const int aoff = lds_byte(wr * 64 + fr, fq * 8), boff = lds_byte(wc * 32 + fr, fq * 8);
#define PG8_SA(b, h) (((b) * 2 + (h)) * HTB)
#define PG8_SB(b, h) ((4 + (b) * 2 + (h)) * HTB)
#define PG8_STAGE(bufoff, gbase, voff) do { _Pragma("unroll") for (int _i = 0; _i < 2; ++_i) \
        __builtin_amdgcn_global_load_lds((const unsigned*)((const char*)(gbase) + (voff)[_i]), (PG8_LAS unsigned*)(lds + (bufoff) + ldsw + _i * 8192), 16, 0, 0); } while (0)
#define PG8_LDA(dst, b, h) do { _Pragma("unroll") for (int m = 0; m < 4; ++m) _Pragma("unroll") for (int k = 0; k < 2; ++k) dst[m][k] = *(const PG8_LAS bf16x8*)(lds + PG8_SA(b, h) + aoff + m * 2048 + k * 1024); } while (0)
#define PG8_LDB(dst, b, h) do { _Pragma("unroll") for (int n = 0; n < 2; ++n) _Pragma("unroll") for (int k = 0; k < 2; ++k) dst[n][k] = *(const PG8_LAS bf16x8*)(lds + PG8_SB(b, h) + boff + n * 2048 + k * 1024); } while (0)
#define PG8_MMA(ai, bj, At, Bt) do { __builtin_amdgcn_s_setprio(1); _Pragma("unroll") for (int m = 0; m < 4; ++m) _Pragma("unroll") for (int n = 0; n < 2; ++n) _Pragma("unroll") for (int k = 0; k < 2; ++k) \
        acc[ai][bj][m][n] = __builtin_amdgcn_mfma_f32_16x16x32_bf16(Bt[n][k], At[m][k], acc[ai][bj][m][n], 0, 0, 0); __builtin_amdgcn_s_setprio(0); } while (0)
#define PG8_WAIT_V(n) asm volatile("s_waitcnt vmcnt(" #n ")" ::: "memory")
#define PG8_WAIT_L(n) asm volatile("s_waitcnt lgkmcnt(" #n ")" ::: "memory")
#define PG8_BAR __builtin_amdgcn_s_barrier()
#define PG8_SCHED __builtin_amdgcn_sched_barrier(0)
    Unit cur, nxt; int ui = 0;
    if (!S.next(0, cur)) return;
    f32x4 acc[2][2][4][2];
#pragma unroll
    for (int a = 0; a < 2; ++a)
#pragma unroll
        for (int b = 0; b < 2; ++b)
#pragma unroll
            for (int m = 0; m < 4; ++m)
#pragma unroll
                for (int n = 0; n < 2; ++n) acc[a][b][m][n] = (f32x4){0.f, 0.f, 0.f, 0.f};
    bf16x8 At[4][2], B0[2][2], B1[2][2];
    const char* cA = (const char*)g.A + (size_t)cur.pm * tstep; const char* cB = (const char*)g.Bt + (size_t)cur.pn * tstep;
    S.a_ready(cur);
    if constexpr (SP2) {
        PG8_STAGE(PG8_SB(0, 0), cB, voffB); PG8_STAGE(PG8_SB(0, 1), cB + hstep, voffB); PG8_STAGE(PG8_SA(0, 0), cA, voffA); PG8_STAGE(PG8_SA(0, 1), cA + hstep, voffA);
        if (wr == 1) PG8_BAR;
        PG8_WAIT_V(2); PG8_BAR;
        PG8_STAGE(PG8_SB(1, 0), cB + kstep, voffB); PG8_STAGE(PG8_SA(1, 0), cA + kstep, voffA); PG8_STAGE(PG8_SB(1, 1), cB + hstep + kstep, voffB);
        PG8_WAIT_V(6); PG8_BAR;
    } else {
        PG8_STAGE(PG8_SB(0, 0), cB, voffB); PG8_STAGE(PG8_SA(0, 0), cA, voffA); PG8_STAGE(PG8_SB(0, 1), cB + hstep, voffB); PG8_STAGE(PG8_SA(0, 1), cA + hstep, voffA);
        if (wr == 1) PG8_BAR;
        PG8_WAIT_V(4); PG8_BAR;
        PG8_STAGE(PG8_SB(1, 0), cB + kstep, voffB); PG8_STAGE(PG8_SA(1, 0), cA + kstep, voffA); PG8_STAGE(PG8_SB(1, 1), cB + hstep + kstep, voffB);
        PG8_WAIT_V(6); PG8_BAR;
    }
    for (;;) {
        const bool has_next = S.next(ui + 1, nxt);
        const char* nA = has_next ? (const char*)g.A + (size_t)nxt.pm * tstep : cA; const char* nB = has_next ? (const char*)g.Bt + (size_t)nxt.pn * tstep : cB;
        for (int t = 0; t < nt; t += 2) {
            const bool last = (t == nt - 2);
            const char* a1 = cA + (size_t)(t + 1) * kstep;
            const char* a2 = last ? nA : cA + (size_t)(t + 2) * kstep; const char* b2 = last ? nB : cB + (size_t)(t + 2) * kstep;
            const char* a3 = a2 + kstep; const char* b3 = b2 + kstep;
            if (last && has_next) S.a_ready(nxt);
            if constexpr (SP2) {
            PG8_LDB(B0, 0, 0); PG8_LDB(B1, 0, 1); PG8_SCHED; PG8_LDA(At, 0, 0); PG8_STAGE(PG8_SA(1, 1), a1 + hstep, voffA);
            PG8_WAIT_V(8); PG8_WAIT_L(0); PG8_BAR; PG8_MMA(0, 0, At, B0); PG8_MMA(0, 1, At, B1); PG8_BAR; PG8_SCHED;
            PG8_LDA(At, 0, 1); PG8_STAGE(PG8_SB(0, 0), b2, voffB); PG8_STAGE(PG8_SB(0, 1), b2 + hstep, voffB); PG8_STAGE(PG8_SA(0, 0), a2, voffA);
            PG8_WAIT_V(8); PG8_WAIT_L(0); PG8_BAR; PG8_MMA(1, 0, At, B0); PG8_MMA(1, 1, At, B1); PG8_BAR; PG8_SCHED;
            PG8_LDB(B0, 1, 0); PG8_LDB(B1, 1, 1); PG8_SCHED; PG8_LDA(At, 1, 0); PG8_STAGE(PG8_SA(0, 1), a2 + hstep, voffA);
            PG8_WAIT_V(8); PG8_WAIT_L(0); PG8_BAR; PG8_MMA(0, 0, At, B0); PG8_MMA(0, 1, At, B1); PG8_BAR; PG8_SCHED;
            PG8_LDA(At, 1, 1); PG8_STAGE(PG8_SB(1, 0), b3, voffB); PG8_STAGE(PG8_SB(1, 1), b3 + hstep, voffB); PG8_STAGE(PG8_SA(1, 0), a3, voffA);
            PG8_WAIT_V(8); PG8_WAIT_L(0); PG8_BAR; PG8_MMA(1, 0, At, B0); PG8_MMA(1, 1, At, B1); PG8_BAR; PG8_SCHED;
            } else {
            PG8_LDB(B0, 0, 0); PG8_SCHED; PG8_LDA(At, 0, 0); PG8_STAGE(PG8_SA(1, 1), a1 + hstep, voffA);
            PG8_WAIT_L(8); PG8_BAR; PG8_WAIT_L(0); PG8_MMA(0, 0, At, B0); PG8_BAR; PG8_SCHED;
            PG8_LDB(B1, 0, 1); PG8_STAGE(PG8_SB(0, 0), b2, voffB);
            PG8_BAR; PG8_WAIT_L(0); PG8_MMA(0, 1, At, B1); PG8_BAR;
            PG8_LDA(At, 0, 1); PG8_STAGE(PG8_SA(0, 0), a2, voffA);
            PG8_BAR; PG8_WAIT_L(0); PG8_MMA(1, 0, At, B0); PG8_BAR; PG8_SCHED;
            PG8_STAGE(PG8_SB(0, 1), b2 + hstep, voffB);
            PG8_WAIT_V(6); PG8_BAR; PG8_MMA(1, 1, At, B1); PG8_BAR;
            PG8_LDB(B0, 1, 0); PG8_SCHED; PG8_LDA(At, 1, 0); PG8_STAGE(PG8_SA(0, 1), a2 + hstep, voffA);
            PG8_WAIT_L(8); PG8_BAR; PG8_WAIT_L(0); PG8_MMA(0, 0, At, B0); PG8_BAR; PG8_SCHED;
            PG8_LDB(B1, 1, 1); PG8_STAGE(PG8_SB(1, 0), b3, voffB);
            PG8_BAR; PG8_WAIT_L(0); PG8_MMA(0, 1, At, B1); PG8_BAR;
            PG8_LDA(At, 1, 1); PG8_STAGE(PG8_SA(1, 0), a3, voffA);
            PG8_BAR; PG8_WAIT_L(0); PG8_MMA(1, 0, At, B0); PG8_BAR; PG8_SCHED;
            PG8_STAGE(PG8_SB(1, 1), b3 + hstep, voffB);
            PG8_WAIT_V(6); PG8_BAR; PG8_MMA(1, 1, At, B1); PG8_BAR;
            }
        }
        if constexpr (ALIGN_EPI) { if (wr == 0) PG8_BAR; }
        if constexpr (!Epi::AFTER_DRAIN) { E(acc, cur, wr, wc, fr, fq); S.done(cur); }
        if (!has_next) break;
#pragma unroll
        for (int a = 0; a < 2; ++a)
#pragma unroll
            for (int b = 0; b < 2; ++b)
#pragma unroll
                for (int m = 0; m < 4; ++m)
#pragma unroll
                    for (int n = 0; n < 2; ++n) acc[a][b][m][n] = (f32x4){0.f, 0.f, 0.f, 0.f};
        cur = nxt; cA = nA; cB = nB; ++ui;
        if constexpr (ALIGN_EPI) { if (wr == 1) PG8_BAR; }
    }
    PG8_WAIT_V(0);
    if constexpr (!ALIGN_EPI) { if (wr == 0) PG8_BAR; }
    PG8_BAR;
    if constexpr (Epi::AFTER_DRAIN) { E.fused(acc, cur, wr, wc, fr, fq, lds, wid, lane); S.done(cur); }
#undef PG8_SA
#undef PG8_SB
#undef PG8_STAGE
#undef PG8_LDA
#undef PG8_LDB
#undef PG8_MMA
#undef PG8_WAIT_V
#undef PG8_WAIT_L
#undef PG8_BAR
#undef PG8_SCHED
}
}
#define DI __device__ __forceinline__
typedef __attribute__((address_space(3))) float lds_f32_t;
typedef unsigned short bf16;
typedef float f32x4 __attribute__((ext_vector_type(4)));
typedef float f32x2 __attribute__((ext_vector_type(2)));
typedef float f32x16 __attribute__((ext_vector_type(16)));
typedef short bf16x8 __attribute__((ext_vector_type(8)));
typedef short s16x4 __attribute__((ext_vector_type(4)));
typedef unsigned u32x4 __attribute__((ext_vector_type(4)));
typedef __bf16 bf16x2_t __attribute__((ext_vector_type(2)));
#define MFMA32(a, b, c) __builtin_amdgcn_mfma_f32_32x32x16_bf16((a), (b), (c), 0, 0, 0)
#define LDS_FENCE() asm volatile("s_waitcnt lgkmcnt(0)" ::: "memory")

DI unsigned pk2(float lo, float hi) { f32x2 v = {lo, hi}; bf16x2_t b = __builtin_convertvector(v, bf16x2_t); return __builtin_bit_cast(unsigned, b); }
DI float bflo(unsigned u) { return __uint_as_float(u << 16); }
DI float bfhi(unsigned u) { return __uint_as_float(u & 0xffff0000u); }
DI float bf2f(bf16 h) { return __uint_as_float((unsigned)h << 16); }
DI float wave_sum(float v) {
#pragma unroll
    for (int o = 1; o < 64; o <<= 1) v += __shfl_xor(v, o);
    return v;
}
DI float sigmoid_(float x) { return 1.f / (1.f + __expf(-x)); }
DI float silu_(float x) { return x / (1.f + __expf(-x)); }
DI float softplus_(float x) { return x > 20.f ? x : __logf(1.0f + __expf(x)); }
DI int crow(int reg, int h) { return (reg & 3) + 8 * (reg >> 2) + 4 * h; }

constexpr int BATCH = 16, SEQ = 2048, DM = 1024, M = BATCH * SEQ, FF = 4096, N0 = 3840;
constexpr float EPS = 1e-6f, LOG2E = 1.4426950408889634f;
constexpr size_t MiB = 1u << 20;
constexpr size_t WS_W0IN = 0, WS_W0OUT = 8 * MiB, WS_W0F1 = 10 * MiB, WS_W0F2 = 18 * MiB, WS_W1IN = 26 * MiB, WS_W1OUT = 34 * MiB, WS_W1F1 = 36 * MiB, WS_W1F2 = 44 * MiB;
constexpr size_t WS_MIX = 52 * MiB, WS_ZH = 116 * MiB, WS_SS = 372 * MiB, WS_C2 = 380 * MiB, WS_XB = 384 * MiB, WS_END = 512 * MiB;
constexpr size_t WS_PAR = 381 * MiB;
constexpr int P_QN = 0, P_KN = 64, P_FB = 128, P_CONV = 256, P_ALOG = 6400, P_DTB = 6404, P_GON = 6528, P_HON = 6656, P_LB = 6784, P_END = 8832;
constexpr size_t WS_BAR = 381 * MiB + 131072;
constexpr size_t SS_STRIDE = (size_t)M * 16;
constexpr int LDS_BYTES = 147456;
#ifndef WGM_WIDE
#define WGM_WIDE 4
#endif

constexpr int RS_OFF = 131072;
template <int ACT> struct EpiAct {
    static constexpr bool PERM = true, AFTER_DRAIN = false;
    bf16* O; int ldc; const float* par; const lds_f32_t* rs; mutable int ui;
    DI void operator()(const f32x4 (&acc)[2][2][4][2], const pg8::Unit& u, int wr, int wc, int fr, int fq) const {
        const int row0 = u.pm * 256 + wr * 64 + fr, col0 = u.pn * 256 + wc * 32 + 8 * fq;
        float rsv[2][4];
#pragma unroll
        for (int ai = 0; ai < 2; ++ai)
#pragma unroll
            for (int m = 0; m < 4; ++m) rsv[ai][m] = rs[ui * 256 + ai * 128 + wr * 64 + m * 16 + fr];
        ++ui;
#pragma unroll
        for (int ai = 0; ai < 2; ++ai)
#pragma unroll
            for (int m = 0; m < 4; ++m) {
                const int row = row0 + ai * 128 + m * 16;
                const float r = rsv[ai][m];
                bf16* rowp = O + (size_t)row * ldc + col0;
                if (ACT == 2 && u.pn < 4) {
                    float ssq = 0.f;
#pragma unroll
                    for (int bj = 0; bj < 2; ++bj)
#pragma unroll
                        for (int n = 0; n < 2; ++n) { const f32x4 t = acc[ai][bj][m][n]; ssq += (t[0] * t[0] + t[1] * t[1]) + (t[2] * t[2] + t[3] * t[3]); }
                    ssq += __shfl_xor(ssq, 16); ssq += __shfl_xor(ssq, 32);
                    const float rn = r * rsqrtf(ssq * r * r * (1.0f / 64.0f) + EPS) * (u.pn < 2 ? 0.125f * LOG2E : 1.0f);
                    int fql = fq; asm volatile("" : "+v"(fql));
                    const float* gq = par + (u.pn < 2 ? P_QN : P_KN) + 8 * fql;
#pragma unroll
                    for (int bj = 0; bj < 2; ++bj) {
                        const f32x4 g0 = *(const f32x4*)(gq + bj * 32), g1 = *(const f32x4*)(gq + bj * 32 + 4);
                        const f32x4 v0 = acc[ai][bj][m][0] * rn * g0, v1 = acc[ai][bj][m][1] * rn * g1;
                        u32x4 w; w.x = pk2(v0[0], v0[1]); w.y = pk2(v0[2], v0[3]); w.z = pk2(v1[0], v1[1]); w.w = pk2(v1[2], v1[3]);
                        *(u32x4*)(rowp + bj * 128) = w;
                    }
                    continue;
                }
#pragma unroll
                for (int bj = 0; bj < 2; ++bj) {
                    f32x4 v0 = acc[ai][bj][m][0] * r, v1 = acc[ai][bj][m][1] * r;
                    if (ACT == 1) {
#pragma unroll
                        for (int e = 0; e < 4; ++e) { const float x0 = fmaxf(v0[e], 0.f), x1 = fmaxf(v1[e], 0.f); v0[e] = x0 * x0; v1[e] = x1 * x1; }
                    }
                    u32x4 w; w.x = pk2(v0[0], v0[1]); w.y = pk2(v0[2], v0[3]); w.z = pk2(v1[0], v1[1]); w.w = pk2(v1[2], v1[3]);
                    *(u32x4*)(rowp + bj * 128) = w;
                }
            }
    }
};
template <bool FINISHED, class Sched> DI void rs_table_build(unsigned char* lds, const float* ss, const Sched& S, const int wv_) {
    int tid = TIDX(wv_); asm volatile("" : "+v"(tid));
    float* rs = (float*)(lds + RS_OFF);
    const int r = tid & 255, par = tid >> 8;
    pg8::Unit u; bool ok[4]; int rowk[4];
#pragma unroll
    for (int k = 0; k < 4; ++k) { ok[k] = S.next(2 * k + par, u); rowk[k] = (ok[k] ? u.pm : 0) * 256 + r; }
    if (FINISHED) {
        float v[4];
#pragma unroll
        for (int k = 0; k < 4; ++k) v[k] = ss[rowk[k]];
#pragma unroll
        for (int k = 0; k < 4; ++k) if (ok[k]) rs[(2 * k + par) * 256 + r] = v[k];
    } else {
        f32x4 p4[4][4];
#pragma unroll
        for (int k = 0; k < 4; ++k) { const f32x4* p = (const f32x4*)(ss + (size_t)rowk[k] * 16); p4[k][0] = p[0]; p4[k][1] = p[1]; p4[k][2] = p[2]; p4[k][3] = p[3]; }
#pragma unroll
        for (int k = 0; k < 4; ++k) {
            const f32x4 a = p4[k][0], b = p4[k][1], c = p4[k][2], d = p4[k][3];
            const float sm = ((a.x + a.y) + (a.z + a.w)) + ((b.x + b.y) + (b.z + b.w)) + ((c.x + c.y) + (c.z + c.w)) + ((d.x + d.y) + (d.z + d.w));
            if (ok[k]) rs[(2 * k + par) * 256 + r] = rsqrtf(sm * (1.0f / 1024.0f) + EPS);
        }
    }
    __syncthreads();
}
template <bool BASE_BF16, bool OUT_F32> struct EpiRes {
    static constexpr bool PERM = true, AFTER_DRAIN = false;
    const void* base; float* out; bf16* xb; float* ss_out;
    DI void operator()(const f32x4 (&acc)[2][2][4][2], const pg8::Unit& u, int wr, int wc, int fr, int fq) const {
        const int row0 = u.pm * 256 + wr * 64 + fr, col0 = u.pn * 256 + wc * 32 + 8 * fq;
#pragma unroll
        for (int ai = 0; ai < 2; ++ai) {
            f32x4 bb[4][2][2];
#pragma unroll
            for (int m = 0; m < 4; ++m)
#pragma unroll
                for (int bj = 0; bj < 2; ++bj) {
                    const size_t off = (size_t)(row0 + ai * 128 + m * 16) * 1024 + col0 + bj * 128;
                    if (BASE_BF16) {
                        const u32x4 w = *(const u32x4*)((const bf16*)base + off);
                        bb[m][bj][0] = (f32x4){bflo(w[0]), bfhi(w[0]), bflo(w[1]), bfhi(w[1])}; bb[m][bj][1] = (f32x4){bflo(w[2]), bfhi(w[2]), bflo(w[3]), bfhi(w[3])};
                    } else {
                        bb[m][bj][0] = *(const f32x4*)((const float*)base + off); bb[m][bj][1] = *(const f32x4*)((const float*)base + off + 4);
                    }
                }
            __builtin_amdgcn_sched_barrier(0);
#pragma unroll
            for (int m = 0; m < 4; ++m) {
                const int row = row0 + ai * 128 + m * 16;
                float s = 0.f;
#pragma unroll
                for (int bj = 0; bj < 2; ++bj) {
                    const size_t off = (size_t)row * 1024 + col0 + bj * 128;
                    const f32x4 v0 = acc[ai][bj][m][0] + bb[m][bj][0], v1 = acc[ai][bj][m][1] + bb[m][bj][1];
                    if (OUT_F32) { *(f32x4*)(out + off) = v0; *(f32x4*)(out + off + 4) = v1; }
                    else {
                        s += ((v0[0] * v0[0] + v0[1] * v0[1]) + (v0[2] * v0[2] + v0[3] * v0[3])) + ((v1[0] * v1[0] + v1[1] * v1[1]) + (v1[2] * v1[2] + v1[3] * v1[3]));
                        u32x4 w; w.x = pk2(v0[0], v0[1]); w.y = pk2(v0[2], v0[3]); w.z = pk2(v1[0], v1[1]); w.w = pk2(v1[2], v1[3]); *(u32x4*)(xb + off) = w;
                    }
                }
                if (!OUT_F32) { s += __shfl_xor(s, 16); s += __shfl_xor(s, 32); if (fq == 0) ss_out[(size_t)row * 16 + u.pn * 4 + wc] = s; }
            }
            __builtin_amdgcn_sched_barrier(0);
        }
    }
};

DI int src_col0(int n) {
    if (n < 1024) { const int tile = n >> 8, c = n & 255, half = c >> 7, wc = (c >> 5) & 3, dl = c & 31; return (tile >> 1) * 512 + ((tile & 1) * 4 + wc) * 64 + half * 32 + dl; }
    return n < 1536 ? n : n < 3072 ? n + 8 : n < 3584 ? n + 16 : n < 3592 ? n - 3584 + 1536 : n < 3600 ? n - 3592 + 3080 : -1;
}
DI int fox_col(int which, int h, int d) { return which * 512 + 256 * (h >> 2) + (d >> 5) * 128 + 32 * (h & 3) + (d & 31); }
template <bool MAP> DI void transpose_item(const float* __restrict__ W, int K, int Nsrc, int Ndst, const float* __restrict__ gain, bf16* __restrict__ WT, float* scr, int item, int lane) {
    const int nblk = Ndst / 32, kb = item / nblk, nb = item % nblk, k0 = 64 * kb, n0 = 32 * nb;
    const int n = n0 + (lane & 31), sc = MAP ? src_col0(n) : n;
    float vals[32];
#pragma unroll
    for (int i = 0; i < 32; ++i) {
        const int kk = 2 * i + (lane >> 5); float v = 0.f;
        if (sc >= 0) v = W[(size_t)(k0 + kk) * Nsrc + sc];
        vals[i] = v;
    }
#pragma unroll
    for (int i = 0; i < 32; ++i) {
        const int kk = 2 * i + (lane >> 5); float v = vals[i];
        if (gain) v *= gain[k0 + kk];
        scr[kk * 33 + (lane & 31)] = v;
    }
    LDS_FENCE();
    const int c = lane & 7;
#pragma unroll
    for (int j = 0; j < 4; ++j) {
        const int nn = (lane >> 3) + 8 * j; const float* s = scr + (8 * c) * 33 + nn;
        u32x4 o; o.x = pk2(s[0 * 33], s[1 * 33]); o.y = pk2(s[2 * 33], s[3 * 33]); o.z = pk2(s[4 * 33], s[5 * 33]); o.w = pk2(s[6 * 33], s[7 * 33]);
        *(u32x4*)(WT + (size_t)(n0 + nn) * K + k0 + 8 * c) = o;
    }
    LDS_FENCE();
}

struct Args { const float* in[22]; float* out; unsigned char* ws; };

DI void p0_prologue(const Args& a, unsigned char* lds, const int wv_) {
    int tid = TIDX(wv_); asm volatile("" : "+v"(tid)); const int lane = tid & 63, wave = __builtin_amdgcn_readfirstlane(tid >> 6), gw = blockIdx.x * 8 + wave, NGW = gridDim.x * 8;
    float* scr = (float*)(lds + wave * 16384);
    unsigned char* ws = a.ws;
    constexpr int I0 = 16 * (N0 / 32), I_O = 16 * 32, I_1 = 16 * 128, I_2 = 64 * 32;
    constexpr int NITEMS = I0 + I_O + I_1 + I_2 + I_1 + I_O + I_1 + I_2;
    for (int it = gw; it < NITEMS; it += NGW) {
        int r = it;
        if (r < I0) { transpose_item<true>(a.in[2], 1024, 3600, N0, a.in[1], (bf16*)(ws + WS_W0IN), scr, r, lane); continue; } r -= I0;
        if (r < I_O) { transpose_item<false>(a.in[10], 1024, 1024, 1024, nullptr, (bf16*)(ws + WS_W0OUT), scr, r, lane); continue; } r -= I_O;
        if (r < I_1) { transpose_item<false>(a.in[12], 1024, 4096, 4096, a.in[11], (bf16*)(ws + WS_W0F1), scr, r, lane); continue; } r -= I_1;
        if (r < I_2) { transpose_item<false>(a.in[13], 4096, 1024, 1024, nullptr, (bf16*)(ws + WS_W0F2), scr, r, lane); continue; } r -= I_2;
        if (r < I_1) { transpose_item<false>(a.in[15], 1024, 4096, 4096, a.in[14], (bf16*)(ws + WS_W1IN), scr, r, lane); continue; } r -= I_1;
        if (r < I_O) { transpose_item<false>(a.in[17], 1024, 1024, 1024, nullptr, (bf16*)(ws + WS_W1OUT), scr, r, lane); continue; } r -= I_O;
        if (r < I_1) { transpose_item<false>(a.in[19], 1024, 4096, 4096, a.in[18], (bf16*)(ws + WS_W1F1), scr, r, lane); continue; } r -= I_1;
        transpose_item<false>(a.in[20], 4096, 1024, 1024, nullptr, (bf16*)(ws + WS_W1F2), scr, r, lane);
    }
    if (blockIdx.x == 0) {
        float* P = (float*)(ws + WS_PAR);
        for (int i = tid; i < P_END; i += 512) {
            float v = 0.f;
            if (i < 64) v = a.in[3][i]; else if (i < 128) v = a.in[4][i - 64]; else if (i < 136) v = a.in[5][i - 128];
            else if (i >= P_CONV && i < P_CONV + 6144) v = a.in[6][i - P_CONV];
            else if (i >= P_ALOG && i < P_ALOG + 4) v = a.in[7][i - P_ALOG]; else if (i >= P_DTB && i < P_DTB + 4) v = a.in[8][i - P_DTB];
            else if (i >= P_GON && i < P_GON + 128) v = a.in[9][i - P_GON]; else if (i >= P_HON && i < P_HON + 128) v = a.in[16][i - P_HON];
            else if (i >= P_LB) v = a.in[21][i - P_LB];
            P[i] = v;
        }
    }
    const float* x = a.in[0]; bf16* XB = (bf16*)(ws + WS_XB); float* SS = (float*)(ws + WS_SS);
    for (int m0 = gw; m0 < M; m0 += 2 * NGW) {
        const int m1 = m0 + NGW; const bool has1 = m1 < M;
        const f32x4* xr0 = (const f32x4*)(x + (size_t)m0 * DM) + lane; const f32x4* xr1 = (const f32x4*)(x + (size_t)(has1 ? m1 : m0) * DM) + lane;
        f32x4 v0[4], v1[4]; float s0 = 0.f, s1 = 0.f;
#pragma unroll
        for (int j = 0; j < 4; ++j) { v0[j] = xr0[64 * j]; v1[j] = xr1[64 * j]; }
#pragma unroll
        for (int j = 0; j < 4; ++j) {
            s0 += (v0[j].x * v0[j].x + v0[j].y * v0[j].y) + (v0[j].z * v0[j].z + v0[j].w * v0[j].w);
            s1 += (v1[j].x * v1[j].x + v1[j].y * v1[j].y) + (v1[j].z * v1[j].z + v1[j].w * v1[j].w);
        }
#pragma unroll
        for (int o = 1; o < 64; o <<= 1) { s0 += __shfl_xor(s0, o); s1 += __shfl_xor(s1, o); }
        unsigned long long* o80 = (unsigned long long*)(XB + (size_t)m0 * DM) + lane;
#pragma unroll
        for (int j = 0; j < 4; ++j) o80[64 * j] = (unsigned long long)pk2(v0[j].x, v0[j].y) | ((unsigned long long)pk2(v0[j].z, v0[j].w) << 32);
        if (lane == 0) SS[m0] = rsqrtf(s0 * (1.0f / 1024.0f) + EPS);
        if (has1) {
            unsigned long long* o81 = (unsigned long long*)(XB + (size_t)m1 * DM) + lane;
#pragma unroll
            for (int j = 0; j < 4; ++j) o81[64 * j] = (unsigned long long)pk2(v1[j].x, v1[j].y) | ((unsigned long long)pk2(v1[j].z, v1[j].w) << 32);
            if (lane == 0) SS[m1] = rsqrtf(s1 * (1.0f / 1024.0f) + EPS);
        }
    }
}

DI void fox_prep(const Args& a, const int wv_) {
    int tid = TIDX(wv_); asm volatile("" : "+v"(tid)); const int lane = tid & 63, wave = __builtin_amdgcn_readfirstlane(tid >> 6), gw = blockIdx.x * 8 + wave, NGW = gridDim.x * 8;
    bf16* Z = (bf16*)(a.ws + WS_ZH); float* C2 = (float*)(a.ws + WS_C2);
    for (int it = gw; it < 128; it += NGW) {
        const int b = it >> 3, h = it & 7; const float bias = ((const float*)(a.ws + WS_PAR))[P_FB + h];
        float loc[32]; float run = 0.f;
#pragma unroll
        for (int i = 0; i < 32; ++i) {
            const int t = 32 * lane + i; const float x = bf2f(Z[((size_t)b * SEQ + t) * N0 + 3584 + h]) + bias;
            const float ls = fminf(x, 0.f) - __logf(1.0f + __expf(-fabsf(x))); run += ls; loc[i] = run;
        }
        float incl = run;
#pragma unroll
        for (int o = 1; o < 64; o <<= 1) { const float y = __shfl_up(incl, o); if (lane >= o) incl += y; }
        const float excl = incl - run;
#pragma unroll
        for (int i = 0; i < 32; ++i) C2[(size_t)it * SEQ + 32 * lane + i] = (loc[i] + excl) * LOG2E;
    }
}

constexpr int LDK = 72;
DI void fox_unit(const bf16* __restrict__ Z, const float* __restrict__ C2, bf16* __restrict__ MIX, int b, int h, int qb, unsigned char* lds, const int wv_) {
    int tid = TIDX(wv_); asm volatile("" : "+v"(tid)); const int lane = tid & 63, r = lane & 31, hh = lane >> 5, w = tid >> 6;
    bf16* Ks0 = (bf16*)lds; bf16* Vt0 = (bf16*)(lds + 18432); float* C2s = (float*)(lds + 36864); float* AS = (float*)(lds + 45056) + w * 32;
    const int q0 = qb * 256, nT = (q0 + 256) / 64;
    const size_t rowbase = (size_t)b * SEQ;
    const float* c2g = C2 + (size_t)(b * 8 + h) * SEQ;
    {
        float cv[4];
#pragma unroll
        for (int k = 0; k < 4; ++k) { const int i = tid + 512 * k; cv[k] = i < q0 + 256 ? c2g[i] : 0.f; }
#pragma unroll
        for (int k = 0; k < 4; ++k) { const int i = tid + 512 * k; if (i < q0 + 256) C2s[i] = -cv[k]; }
    }
    const int qrow = q0 + 32 * w + r;
    bf16x8 qr[4];
#pragma unroll
    for (int ks = 0; ks < 4; ++ks) qr[ks] = *(const bf16x8*)(Z + (rowbase + qrow) * N0 + fox_col(0, h, ks * 16 + hh * 8));
    float m_run = -INFINITY, l_run = 0.f;
    f32x16 o0, o1;
#pragma unroll
    for (int i = 0; i < 16; ++i) { o0[i] = 0.f; o1[i] = 0.f; }
    const int kr = tid >> 3, ch = tid & 7;
    const bf16* kvp = Z + (rowbase + kr) * N0 + fox_col(1, h, ch * 8);
    const int voff = 1024 + h * 64 + ch * 8 - fox_col(1, h, ch * 8);
    u32x4 kv = *(const u32x4*)kvp, vv = *(const u32x4*)(kvp + voff);
    {
        *(u32x4*)(Ks0 + kr * LDK + ch * 8) = kv;
#pragma unroll
        for (int e = 0; e < 8; ++e) Vt0[(ch * 8 + e) * LDK + (kr ^ (ch << 3))] = (bf16)(vv[e >> 1] >> (16 * (e & 1)));
        if (1 < nT) { const bf16* np = kvp + (size_t)64 * N0; kv = *(const u32x4*)np; vv = *(const u32x4*)(np + voff); }
    }
    __syncthreads();
    for (int jt = 0; jt < nT; ++jt) {
        const bf16* Ks = Ks0 + (jt & 1) * 4608; const bf16* Vt = Vt0 + (jt & 1) * 4608;
        if (jt + 1 < nT) {
            bf16* Kn = Ks0 + ((jt + 1) & 1) * 4608; bf16* Vn = Vt0 + ((jt + 1) & 1) * 4608;
            *(u32x4*)(Kn + kr * LDK + ch * 8) = kv;
#pragma unroll
            for (int e = 0; e < 8; ++e) Vn[(ch * 8 + e) * LDK + (kr ^ (ch << 3))] = (bf16)(vv[e >> 1] >> (16 * (e & 1)));
            if (jt + 2 < nT) { const bf16* np = kvp + (size_t)(jt + 2) * 64 * N0; kv = *(const u32x4*)np; vv = *(const u32x4*)(np + voff); }
        }
        const int kv0 = jt * 64;
        if (kv0 <= q0 + 32 * w + 31) {
            f32x16 p0, p1;
#pragma unroll
            for (int g = 0; g < 4; ++g) {
                const f32x4 c0v = *(const f32x4*)(C2s + kv0 + 8 * g + 4 * hh), c1v = *(const f32x4*)(C2s + kv0 + 32 + 8 * g + 4 * hh);
#pragma unroll
                for (int e = 0; e < 4; ++e) { p0[4 * g + e] = c0v[e]; p1[4 * g + e] = c1v[e]; }
            }
#pragma unroll
            for (int ks = 0; ks < 4; ++ks) {
                const bf16x8 a0 = *(const bf16x8*)(Ks + r * LDK + ks * 16 + hh * 8);
                const bf16x8 a1 = *(const bf16x8*)(Ks + (32 + r) * LDK + ks * 16 + hh * 8);
                p0 = MFMA32(a0, qr[ks], p0); p1 = MFMA32(a1, qr[ks], p1);
            }
            float mt = -INFINITY;
            const bool need_mask = kv0 + 63 > q0 + 32 * w;
#pragma unroll
            for (int g = 0; g < 4; ++g) {
#pragma unroll
                for (int e = 0; e < 4; ++e) {
                    const int i = 4 * g + e, kvi = kv0 + 8 * g + 4 * hh + e;
                    float s0 = p0[i], s1 = p1[i];
                    if (need_mask) { if (kvi > qrow) s0 = -INFINITY; if (kvi + 32 > qrow) s1 = -INFINITY; }
                    p0[i] = s0; p1[i] = s1; mt = fmaxf(mt, fmaxf(s0, s1));
                }
            }
            mt = fmaxf(mt, __shfl_xor(mt, 32));
            const float m_new = fmaxf(m_run, mt);
            const float alpha = __builtin_amdgcn_exp2f(m_run - m_new);
            m_run = m_new;
            float ps = 0.f;
#pragma unroll
            for (int i = 0; i < 16; ++i) { p0[i] = __builtin_amdgcn_exp2f(p0[i] - m_new); p1[i] = __builtin_amdgcn_exp2f(p1[i] - m_new); ps += p0[i] + p1[i]; }
            l_run = l_run * alpha + ps;
            if (hh == 0) AS[r] = alpha;
            LDS_FENCE();
#pragma unroll
            for (int i = 0; i < 16; ++i) { const float al = AS[crow(i, hh)]; o0[i] *= al; o1[i] *= al; }
            bf16x8 pa[4];
#pragma unroll
            for (int s = 0; s < 2; ++s) {
                u32x4 t0, t1;
#pragma unroll
                for (int e = 0; e < 4; ++e) { t0[e] = pk2(p0[8 * s + 2 * e], p0[8 * s + 2 * e + 1]); t1[e] = pk2(p1[8 * s + 2 * e], p1[8 * s + 2 * e + 1]); }
                pa[s] = __builtin_bit_cast(bf16x8, t0); pa[2 + s] = __builtin_bit_cast(bf16x8, t1);
            }
#pragma unroll
            for (int k4 = 0; k4 < 4; ++k4) {
                const int half = k4 >> 1, s = k4 & 1;
                const int ca = 32 * half + 16 * s + 4 * hh, cb = ca + 8, sw0 = (r >> 3) << 3, sw1 = (4 + (r >> 3)) << 3;
                const bf16* vr0 = Vt + r * LDK; const bf16* vr1 = Vt + (32 + r) * LDK;
                const s16x4 lo0 = *(const s16x4*)(vr0 + (ca ^ sw0)), hi0 = *(const s16x4*)(vr0 + (cb ^ sw0));
                const s16x4 lo1 = *(const s16x4*)(vr1 + (ca ^ sw1)), hi1 = *(const s16x4*)(vr1 + (cb ^ sw1));
                const bf16x8 vf0 = __builtin_shufflevector(lo0, hi0, 0, 1, 2, 3, 4, 5, 6, 7);
                const bf16x8 vf1 = __builtin_shufflevector(lo1, hi1, 0, 1, 2, 3, 4, 5, 6, 7);
                o0 = MFMA32(pa[k4], vf0, o0); o1 = MFMA32(pa[k4], vf1, o1);
            }
            LDS_FENCE();
        }
        __syncthreads();
    }
    const float l_tot = l_run + __shfl_xor(l_run, 32);
    if (hh == 0) AS[r] = 1.0f / l_tot;
    LDS_FENCE();
#pragma unroll
    for (int i = 0; i < 16; ++i) {
        const float inv = AS[crow(i, hh)]; const size_t row = rowbase + q0 + 32 * w + crow(i, hh);
        bf16* op = MIX + row * 1024 + h * 64 + r;
        op[0] = (bf16)(pk2(o0[i] * inv, 0.f) & 0xffffu); op[32] = (bf16)(pk2(o1[i] * inv, 0.f) & 0xffffu);
    }
    __syncthreads();
}


typedef __attribute__((address_space(3))) unsigned char lds_u8;
typedef __attribute__((address_space(3))) float lds_f32;
DI void norm_gate_store(const float* Of, const float* gain, const bf16* gate_row0, size_t gate_pitch, bf16* out_row0, int tid) {
    const int t = tid >> 3, seg = tid & 7;
    const f32x4* op = (const f32x4*)(Of + t * 128 + seg * 16);
    f32x4 o[4]; float ss = 0.f;
#pragma unroll
    for (int q = 0; q < 4; ++q) { o[q] = op[q]; ss += (o[q][0] * o[q][0] + o[q][1] * o[q][1]) + (o[q][2] * o[q][2] + o[q][3] * o[q][3]); }
    ss += __shfl_xor(ss, 1); ss += __shfl_xor(ss, 2); ss += __shfl_xor(ss, 4);
    const float rn = rsqrtf(ss * (1.0f / 128.0f) + EPS);
    const u32x4* gp = (const u32x4*)(gate_row0 + (size_t)t * gate_pitch + seg * 16);
    const u32x4 ga = gp[0], gb = gp[1];
    const f32x4* gn = (const f32x4*)(gain + seg * 16);
    u32x4 w0, w1;
#pragma unroll
    for (int q = 0; q < 4; ++q) {
        const f32x4 g4 = gn[q];
        const unsigned gw0 = q < 2 ? ga[2 * q] : gb[2 * q - 4], gw1 = q < 2 ? ga[2 * q + 1] : gb[2 * q - 3];
        const float y0 = o[q][0] * rn * g4[0] * silu_(bflo(gw0)), y1 = o[q][1] * rn * g4[1] * silu_(bfhi(gw0));
        const float y2 = o[q][2] * rn * g4[2] * silu_(bflo(gw1)), y3 = o[q][3] * rn * g4[3] * silu_(bfhi(gw1));
        if (q < 2) { w0[2 * q] = pk2(y0, y1); w0[2 * q + 1] = pk2(y2, y3); } else { w1[2 * q - 4] = pk2(y0, y1); w1[2 * q - 3] = pk2(y2, y3); }
    }
    u32x4* dst = (u32x4*)(out_row0 + (size_t)t * 1024 + seg * 16);
    dst[0] = w0; dst[1] = w1;
}

#define MFMA16(a, b, c) __builtin_amdgcn_mfma_f32_16x16x32_bf16((a), (b), (c), 0, 0, 0)
constexpr int LDH = 136, LDW = 68;
constexpr int G_QH = 0, G_KH = 17408, G_U = 0, G_VH = 34816, G_WT = 34816, G_A = 52224, G_NW = 68608, G_QD = 84992, G_KD = 101376, G_AI = 117760, G_SM = 125952;
DI bf16 f2bf(float x) { return (bf16)(pk2(x, 0.f) & 0xffffu); }
DI float dpp_xor1(float v) { return __int_as_float(__builtin_amdgcn_update_dpp(0, __float_as_int(v), 0xB1, 0xF, 0xF, true)); }
DI void norm_gate_store_pre(const float* Of, const f32x4 (&gn)[4], u32x4 ga, u32x4 gb, bf16* out_row0, int tid) {
    const int t = tid >> 3, seg = tid & 7;
    const f32x4* op = (const f32x4*)(Of + t * 128 + seg * 16);
    f32x4 o[4]; float ss = 0.f;
#pragma unroll
    for (int q = 0; q < 4; ++q) { o[q] = op[q]; ss += (o[q][0] * o[q][0] + o[q][1] * o[q][1]) + (o[q][2] * o[q][2] + o[q][3] * o[q][3]); }
    ss += __shfl_xor(ss, 1); ss += __shfl_xor(ss, 2); ss += __shfl_xor(ss, 4);
    const float rn = rsqrtf(ss * (1.0f / 128.0f) + EPS);
    u32x4 w0, w1;
#pragma unroll
    for (int q = 0; q < 4; ++q) {
        const f32x4 g4 = gn[q];
        const unsigned gw0 = q < 2 ? ga[2 * q] : gb[2 * q - 4], gw1 = q < 2 ? ga[2 * q + 1] : gb[2 * q - 3];
        const float y0 = o[q][0] * rn * g4[0] * silu_(bflo(gw0)), y1 = o[q][1] * rn * g4[1] * silu_(bfhi(gw0));
        const float y2 = o[q][2] * rn * g4[2] * silu_(bflo(gw1)), y3 = o[q][3] * rn * g4[3] * silu_(bfhi(gw1));
        if (q < 2) { w0[2 * q] = pk2(y0, y1); w0[2 * q + 1] = pk2(y2, y3); } else { w1[2 * q - 4] = pk2(y0, y1); w1[2 * q - 3] = pk2(y2, y3); }
    }
    u32x4* dst = (u32x4*)(out_row0 + (size_t)t * 1024 + seg * 16);
    dst[0] = w0; dst[1] = w1;
}
constexpr int SL_NW = 0, SL_QD = 16384, SL_KD = 32768, SL_AI = 49152, SL_UB = 55296, SL_BYTES = 71680, SL_FIRST = 1872;
DI unsigned char* gdn_slot(unsigned char* ws, int idx) { return idx < SL_FIRST ? ws + WS_XB + (size_t)idx * SL_BYTES : ws + WS_ZH + 240 * MiB + (size_t)(idx - SL_FIRST) * SL_BYTES; }
constexpr size_t WS_EGL = 381 * MiB + 262144;

DI void gdn_prep_unit(const Args& a, int idx, unsigned char* lds, const int wv_) {
    const int ch = idx & 31, h = (idx >> 5) & 3, b = idx >> 7, t0 = ch * 64;
    const bf16* Z = (const bf16*)(a.ws + WS_ZH);
    bf16* QH = (bf16*)(lds + G_QH); bf16* KH = (bf16*)(lds + G_KH); bf16* VH = (bf16*)(lds + G_VH); bf16* WT = (bf16*)(lds + G_WT); float* U = (float*)(lds + G_U); float* Am = (float*)(lds + G_A);
    unsigned char* NW = lds + G_NW; unsigned char* QD = lds + G_QD; unsigned char* KD = lds + G_KD; unsigned char* AI = lds + G_AI;
    float* Gs = (float*)(lds + G_SM); float* BETA = Gs + 64; float* EG = Gs + 128; float* BE = Gs + 192;
    int tl = TIDX(wv_); asm volatile("" : "+v"(tl));
    const int lane = tl & 63, w = tl >> 6, c0 = 2 * lane;
    const float* PAR = (const float*)(a.ws + WS_PAR); const float* convw = PAR + P_CONV;
    const float negA = -__expf(PAR[P_ALOG + h]), dtb = PAR[P_DTB + h];
    float qn[8][2], kn[8][2];
    float cwa[3][4][2];
#pragma unroll
    for (int ten = 0; ten < 3; ++ten)
#pragma unroll
        for (int jj = 0; jj < 4; ++jj) { cwa[ten][jj][0] = convw[jj * 1536 + ten * 512 + h * 128 + c0]; cwa[ten][jj][1] = convw[jj * 1536 + ten * 512 + h * 128 + c0 + 1]; }
#pragma unroll
    for (int ten = 0; ten < 3; ++ten) {
        float cw[4][2];
#pragma unroll
        for (int jj = 0; jj < 4; ++jj) { cw[jj][0] = cwa[ten][jj][0]; cw[jj][1] = cwa[ten][jj][1]; }
        unsigned pre[11];
#pragma unroll
        for (int rr = 0; rr < 11; ++rr) {
            const int t = t0 + 8 * w - 3 + rr; const int tc = t < 0 ? 0 : t;
            const unsigned u = *(const unsigned*)(Z + ((size_t)b * SEQ + tc) * N0 + 1536 + ten * 512 + h * 128 + c0);
            pre[rr] = t < 0 ? 0u : u;
        }
#pragma unroll
        for (int rr = 0; rr < 8; ++rr) {
            float y0 = 0.f, y1 = 0.f;
#pragma unroll
            for (int jj = 0; jj < 4; ++jj) { y0 += cw[jj][0] * bflo(pre[rr + jj]); y1 += cw[jj][1] * bfhi(pre[rr + jj]); }
            y0 = silu_(y0); y1 = silu_(y1);
            const int t = 8 * w + rr;
            if (ten < 2) {
                const float ss = wave_sum(y0 * y0 + y1 * y1); float sc = rsqrtf(ss + EPS);
                if (ten == 0) sc *= 0.08838834764831845f;
                y0 *= sc; y1 *= sc;
                if (ten == 0) { qn[rr][0] = y0; qn[rr][1] = y1; *(unsigned*)(QH + t * LDH + c0) = pk2(y0, y1); }
                else { kn[rr][0] = y0; kn[rr][1] = y1; *(unsigned*)(KH + t * LDH + c0) = pk2(y0, y1); }
            } else {
                *(unsigned*)(VH + t * LDH + c0) = pk2(y0, y1);
            }
        }
    }
    if (w == 0) {
        const size_t m = (size_t)b * SEQ + t0 + lane;
        const float gb = bf2f(Z[m * N0 + 3592 + h]), ga = bf2f(Z[m * N0 + 3596 + h]);
        float la = negA * softplus_(ga + dtb);
#pragma unroll
        for (int o = 1; o < 64; o <<= 1) { const float y = __shfl_up(la, o); if (lane >= o) la += y; }
        const float be = sigmoid_(gb), eg = __expf(la);
        Gs[lane] = la; BETA[lane] = be; EG[lane] = eg; BE[lane] = be * eg;
        if (lane == 63) ((float*)(a.ws + WS_EGL))[idx] = eg;
    }
    __syncthreads();
    {
        const int fr = lane & 15, fq = lane >> 4, tb = w >> 1;
#pragma unroll
        for (int si = 0; si < 2; ++si) {
            const int sb = 2 * (w & 1) + si; f32x4 akk = {0.f, 0.f, 0.f, 0.f}, aqk = {0.f, 0.f, 0.f, 0.f};
#pragma unroll
            for (int kk = 0; kk < 4; ++kk) {
                const bf16x8 kt = *(const bf16x8*)(KH + (16 * tb + fr) * LDH + kk * 32 + fq * 8);
                const bf16x8 qt = *(const bf16x8*)(QH + (16 * tb + fr) * LDH + kk * 32 + fq * 8);
                const bf16x8 ks_ = *(const bf16x8*)(KH + (16 * sb + fr) * LDH + kk * 32 + fq * 8);
                akk = MFMA16(kt, ks_, akk); aqk = MFMA16(qt, ks_, aqk);
            }
#pragma unroll
            for (int jj = 0; jj < 4; ++jj) {
                const int t = 16 * tb + 4 * fq + jj, s2 = 16 * sb + fr;
                const float dec = __expf(fminf(Gs[t] - Gs[s2], 0.f));
                Am[(s2 & 1) * 2048 + t * 32 + (s2 >> 1)] = s2 < t ? BETA[t] * akk[jj] * dec : 0.f;
                const float qkv = s2 <= t ? aqk[jj] * dec : 0.f;
                const int x = s2 & 15, hp = (x >> 2) & 1, j = ((x >> 3) << 2) | (x & 3);
                const int off = ((((t >> 5) * 4 + (s2 >> 4)) * 64) + hp * 32 + (t & 31)) * 16 + j * 2;
                *(bf16*)(AI + off) = f2bf(qkv);
            }
        }
        const float gl = Gs[63];
#pragma unroll
        for (int rr = 0; rr < 8; ++rr) {
            const int t = 8 * w + rr; const float eg = EG[t], ekd = __expf(gl - Gs[t]);
            {
                const int ks = c0 >> 4, x = c0 & 15, hp = (x >> 2) & 1, j = ((x >> 3) << 2) | (x & 3);
                const int off = ((((t >> 5) * 8 + ks) * 64) + hp * 32 + (t & 31)) * 16 + j * 2;
                *(unsigned*)(QD + off) = pk2(qn[rr][0] * eg, qn[rr][1] * eg);
            }
#pragma unroll
            for (int e = 0; e < 2; ++e) {
                const int dk = c0 + e, x = t & 15, hp = (x >> 2) & 1, j = ((x >> 3) << 2) | (x & 3);
                const int off = ((((dk >> 5) * 4 + (t >> 4)) * 64) + hp * 32 + (dk & 31)) * 16 + j * 2;
                *(bf16*)(KD + off) = f2bf(kn[rr][e] * ekd);
            }
        }
    }
    __syncthreads();
    unsigned char* slot = gdn_slot(a.ws, idx);
    {
#pragma unroll
        for (int k2 = 0; k2 < 2; ++k2) {
            const int q = tl + 512 * k2;
            *(u32x4*)(slot + SL_QD + q * 16) = *(const u32x4*)(QD + q * 16);
            *(u32x4*)(slot + SL_KD + q * 16) = *(const u32x4*)(KD + q * 16);
        }
        if (tl < 384) { const int src_off = tl < 128 ? tl * 16 : 4096 + (tl - 128) * 16; *(u32x4*)(slot + SL_AI + tl * 16) = *(const u32x4*)(AI + src_off); }
    }
    {
        const int c = tl >> 1, p = tl & 1;
        const float* Ap = Am + p * 2048;
        const float* scl = c < 128 ? BETA : BE;
        const bf16* src = c < 128 ? VH + c : KH + (c - 128);
        float xm[32];
#pragma unroll
        for (int i = 0; i < 32; ++i) xm[i] = 0.f;
        f32x4 ab[2][8]; float rh[2];
        rh[0] = scl[0] * bf2f(src[0]);
#pragma unroll
        for (int t = 0; t < 64; ++t) {
            if (t + 1 < 64) {
#pragma unroll
                for (int i4 = 0; i4 < (((t + 2) / 2) + 3) / 4; ++i4) ab[(t + 1) & 1][i4] = *(const f32x4*)(Ap + (t + 1) * 32 + 4 * i4);
                rh[(t + 1) & 1] = scl[t + 1] * bf2f(src[(t + 1) * LDH]);
            }
            __builtin_amdgcn_sched_barrier(0);
            float acc0 = 0.f, acc1 = 0.f;
#pragma unroll
            for (int i4 = 0; i4 < (((t + 1) / 2) + 3) / 4; ++i4) {
                const f32x4 a4 = ab[t & 1][i4];
                acc0 += a4[0] * xm[4 * i4];
                if (2 * (4 * i4 + 1) < t) acc1 += a4[1] * xm[4 * i4 + 1];
                if (2 * (4 * i4 + 2) < t) acc0 += a4[2] * xm[4 * i4 + 2];
                if (2 * (4 * i4 + 3) < t) acc1 += a4[3] * xm[4 * i4 + 3];
            }
            const float part = acc0 + acc1;
            const float xt = rh[t & 1] - (part + dpp_xor1(part));
            xm[t >> 1] = (p == (t & 1)) ? xt : xm[t >> 1];
            __builtin_amdgcn_sched_barrier(0);
        }
        __syncthreads();
        if (c < 128) {
#pragma unroll
            for (int i = 0; i < 32; ++i) U[(2 * i + p) * 128 + c] = xm[i];
        } else {
            const int dk = c - 128;
#pragma unroll
            for (int i = 0; i < 32; ++i) {
                const float other = dpp_xor1(xm[i]);
                const float lo = p ? other : xm[i], hi = p ? xm[i] : other;
                if ((i & 1) == 0) { if (p == 0) *(unsigned*)(WT + dk * LDW + 2 * i) = pk2(-lo, -hi); }
                else { if (p == 1) *(unsigned*)(WT + dk * LDW + 2 * i) = pk2(-lo, -hi); }
            }
        }
    }
    __syncthreads();
#pragma unroll
    for (int k2 = 0; k2 < 2; ++k2) {
        const int q = tl + 512 * k2, f = q >> 6, lp = q & 63, hp = lp >> 5, rp = lp & 31;
        const int t = 32 * (f >> 3) + rp, dkb = 16 * (f & 7) + 4 * hp;
        u32x4 o;
        o[0] = (unsigned)WT[(dkb + 0) * LDW + t] | ((unsigned)WT[(dkb + 1) * LDW + t] << 16);
        o[1] = (unsigned)WT[(dkb + 2) * LDW + t] | ((unsigned)WT[(dkb + 3) * LDW + t] << 16);
        o[2] = (unsigned)WT[(dkb + 8) * LDW + t] | ((unsigned)WT[(dkb + 9) * LDW + t] << 16);
        o[3] = (unsigned)WT[(dkb + 10) * LDW + t] | ((unsigned)WT[(dkb + 11) * LDW + t] << 16);
        *(u32x4*)(slot + SL_NW + q * 16) = o;
    }
    {
        const int dq = tl >> 7, tt = (tl >> 6) & 1, lp = tl & 63, hp = lp >> 5, rp = lp & 31;
        const float* ub = U + (32 * tt + 4 * hp) * 128 + 32 * dq + rp;
        u32x4 o0, o1;
#pragma unroll
        for (int e = 0; e < 4; ++e) {
            const int i0 = 2 * e, i1 = 2 * e + 1, i2 = 8 + 2 * e, i3 = 9 + 2 * e;
            o0[e] = pk2(ub[((i0 & 3) + 8 * (i0 >> 2)) * 128], ub[((i1 & 3) + 8 * (i1 >> 2)) * 128]);
            o1[e] = pk2(ub[((i2 & 3) + 8 * (i2 >> 2)) * 128], ub[((i3 & 3) + 8 * (i3 >> 2)) * 128]);
        }
        u32x4* dst = (u32x4*)(slot + SL_UB + tl * 32);
        dst[0] = o0; dst[1] = o1;
    }
    __syncthreads();
}

DI void gdn_scan_unit(const Args& a, int bh, unsigned char* lds, const int wv_) {
    const bf16* Z = (const bf16*)(a.ws + WS_ZH); bf16* MIX = (bf16*)(a.ws + WS_MIX);
    const float* PAR = (const float*)(a.ws + WS_PAR); const float* EGL = (const float*)(a.ws + WS_EGL);
    const int b = bh >> 2, h = bh & 3;
    int tid = TIDX(wv_); asm volatile("" : "+v"(tid));
    f32x16 S[4];
#pragma unroll
    for (int kb = 0; kb < 4; ++kb)
#pragma unroll
        for (int i = 0; i < 16; ++i) S[kb][i] = 0.f;
    {
        const unsigned char* sl = gdn_slot(a.ws, bh * 32);
        for (int q = tid; q < SL_BYTES / 16; q += 512) *(u32x4*)(lds + q * 16) = *(const u32x4*)(sl + q * 16);
    }
    __syncthreads();
    u32x4 gate_na, gate_nb; float egl_n;
    {
        const u32x4* gp0 = (const u32x4*)(Z + ((size_t)b * SEQ + (tid >> 3)) * N0 + 3072 + h * 128 + (tid & 7) * 16);
        gate_na = gp0[0]; gate_nb = gp0[1]; egl_n = EGL[bh * 32];
    }
#pragma unroll 1
    for (int ch = 0; ch < 32; ++ch) {
        int tl = tid; asm volatile("" : "+v"(tl));
        const int lane = tl & 63, w = tl >> 6, r = lane & 31, hh = lane >> 5, dq = w & 3;
        const int idx = bh * 32 + ch;
        const unsigned cur = (ch & 1) * SL_BYTES, nxt = ((ch + 1) & 1) * SL_BYTES;
        const u32x4 gate_a = gate_na, gate_b = gate_nb; const float egl = egl_n;
        f32x4 gng[4];
#pragma unroll
        for (int q = 0; q < 4; ++q) gng[q] = *(const f32x4*)(PAR + P_GON + (tl & 7) * 16 + 4 * q);
        f32x16 O0, O1;
        if (w >= 4) {
            if (ch < 31) {
                const unsigned char* sl = gdn_slot(a.ws, idx + 1) + (tl - 256) * 16;
                unsigned char* dl = lds + nxt + (tl - 256) * 16;
#pragma unroll
                for (int k0 = 0; k0 < 18; k0 += 6) {
                    u32x4 stage[6];
#pragma unroll
                    for (int k = 0; k < 6; ++k) { if (k0 + k < 17 || tl - 256 < 128) stage[k] = *(const u32x4*)(sl + (k0 + k) * 4096); }
#pragma unroll
                    for (int k = 0; k < 6; ++k) { if (k0 + k < 17 || tl - 256 < 128) *(u32x4*)(dl + (k0 + k) * 4096) = stage[k]; }
                }
            }
        } else {
            lds_u8* l3 = (lds_u8*)lds;
            unsigned fo = cur + lane * 16; asm volatile("" : "+v"(fo)); const lds_u8* fp = l3 + fo;
#define LFRAG(o_) (*(const __attribute__((address_space(3))) bf16x8*)(fp + (o_)))
            bf16x8 xs[8];
#pragma unroll
            for (int kb = 0; kb < 4; ++kb)
#pragma unroll
                for (int s2 = 0; s2 < 2; ++s2) {
                    u32x4 t4;
#pragma unroll
                    for (int e = 0; e < 4; ++e) t4[e] = pk2(S[kb][8 * s2 + 2 * e], S[kb][8 * s2 + 2 * e + 1]);
                    xs[2 * kb + s2] = __builtin_bit_cast(bf16x8, t4);
                }
            f32x16 V0, V1;
            {
                const __attribute__((address_space(3))) u32x4* up = (const __attribute__((address_space(3))) u32x4*)(l3 + cur + SL_UB + ((dq * 2) * 64 + lane) * 32);
                const u32x4 a0 = up[0], a1 = up[1], b0 = up[128], b1 = up[129];
#pragma unroll
                for (int e = 0; e < 4; ++e) {
                    V0[2 * e] = bflo(a0[e]); V0[2 * e + 1] = bfhi(a0[e]); V0[8 + 2 * e] = bflo(a1[e]); V0[9 + 2 * e] = bfhi(a1[e]);
                    V1[2 * e] = bflo(b0[e]); V1[2 * e + 1] = bfhi(b0[e]); V1[8 + 2 * e] = bflo(b1[e]); V1[9 + 2 * e] = bfhi(b1[e]);
                }
            }
#pragma unroll
            for (int i = 0; i < 16; ++i) { O0[i] = 0.f; O1[i] = 0.f; }
#pragma unroll
            for (int ks = 0; ks < 8; ++ks) {
                V0 = MFMA32(LFRAG(SL_NW + (0 * 8 + ks) * 1024), xs[ks], V0);
                V1 = MFMA32(LFRAG(SL_NW + (1 * 8 + ks) * 1024), xs[ks], V1);
                O0 = MFMA32(LFRAG(SL_QD + (0 * 8 + ks) * 1024), xs[ks], O0);
                O1 = MFMA32(LFRAG(SL_QD + (1 * 8 + ks) * 1024), xs[ks], O1);
            }
            bf16x8 vx[4];
#pragma unroll
            for (int s2 = 0; s2 < 2; ++s2) {
                u32x4 t4, t5;
#pragma unroll
                for (int e = 0; e < 4; ++e) { t4[e] = pk2(V0[8 * s2 + 2 * e], V0[8 * s2 + 2 * e + 1]); t5[e] = pk2(V1[8 * s2 + 2 * e], V1[8 * s2 + 2 * e + 1]); }
                vx[s2] = __builtin_bit_cast(bf16x8, t4); vx[2 + s2] = __builtin_bit_cast(bf16x8, t5);
            }
#pragma unroll
            for (int ks = 0; ks < 2; ++ks) O0 = MFMA32(LFRAG(SL_AI + ks * 1024), vx[ks], O0);
#pragma unroll
            for (int ks = 0; ks < 4; ++ks) O1 = MFMA32(LFRAG(SL_AI + 2048 + ks * 1024), vx[ks], O1);
#pragma unroll
            for (int kb = 0; kb < 4; ++kb) {
#pragma unroll
                for (int i = 0; i < 16; ++i) S[kb][i] *= egl;
#pragma unroll
                for (int ks = 0; ks < 4; ++ks) S[kb] = MFMA32(LFRAG(SL_KD + (kb * 4 + ks) * 1024), vx[ks], S[kb]);
            }
#undef LFRAG
        }
        __syncthreads();
        if (w < 4) {
            unsigned obo = cur + ((4 * hh) * 128 + 32 * dq + r) * 4; asm volatile("" : "+v"(obo)); lds_f32* ob = (lds_f32*)((lds_u8*)lds + obo);
#pragma unroll
            for (int i = 0; i < 16; ++i) { ob[((i & 3) + 8 * (i >> 2)) * 128] = O0[i]; ob[(32 + (i & 3) + 8 * (i >> 2)) * 128] = O1[i]; }
        }
        __syncthreads();
        {
            const int cn = ch < 31 ? ch + 1 : ch;
            const u32x4* gpn = (const u32x4*)(Z + ((size_t)b * SEQ + cn * 64 + (tl >> 3)) * N0 + 3072 + h * 128 + (tl & 7) * 16);
            gate_na = gpn[0]; gate_nb = gpn[1]; egl_n = EGL[bh * 32 + cn];
        }
        norm_gate_store_pre((const float*)(lds + cur), gng, gate_a, gate_b, MIX + ((size_t)b * SEQ + ch * 64) * 1024 + 512 + h * 128, tl);
        __syncthreads();
    }
}

constexpr int L_QD = 0, L_KD = 16384, L_AI = 32768, L_VF = 40960, L_DEC = 57344, L_BF = 57856, L_QH = 90624, L_KH = 108032;
DI void hgrn_unit(const Args& a, int b, int h, unsigned char* lds, const int wv_) {
    const bf16* Z = (const bf16*)(a.ws + WS_ZH); bf16* MIX = (bf16*)(a.ws + WS_MIX);
    unsigned char* QD = lds + L_QD; unsigned char* KD = lds + L_KD; unsigned char* AI = lds + L_AI; unsigned char* VF = lds + L_VF;
    float* DEC = (float*)(lds + L_DEC); float* Bf = (float*)(lds + L_BF); bf16* QH = (bf16*)(lds + L_QH); bf16* KH = (bf16*)(lds + L_KH);
    float* TOT = (float*)(lds + L_KH + 17408);
    int tid = TIDX(wv_); asm volatile("" : "+v"(tid));
    const float* PAR = (const float*)(a.ws + WS_PAR); const float* lbl = PAR + P_LB;
    f32x16 S[4];
#pragma unroll
    for (int kb = 0; kb < 4; ++kb)
#pragma unroll
        for (int i = 0; i < 16; ++i) S[kb][i] = 0.f;
    unsigned pq[8], pf[8], pi[8];
    float lb0, lb1;
    {
        const int lane = tid & 63, w = tid >> 6, cg0 = h * 128 + 2 * lane;
        lb0 = 1.0f / (1.0f + __expf(lbl[cg0] - lbl[1024 + cg0])); lb1 = 1.0f / (1.0f + __expf(lbl[cg0 + 1] - lbl[1024 + cg0 + 1]));
#pragma unroll
        for (int rr = 0; rr < 8; ++rr) {
            const bf16* zp = Z + ((size_t)b * SEQ + 8 * w + rr) * 4096 + cg0;
            pq[rr] = *(const unsigned*)zp; pf[rr] = *(const unsigned*)(zp + 1024); pi[rr] = *(const unsigned*)(zp + 2048);
        }
    }
#pragma unroll 1
    for (int ch = 0; ch < 32; ++ch) {
        const int t0 = ch * 64;
        int tl = tid; asm volatile("" : "+v"(tl));
        const int lane = tl & 63, w = tl >> 6, r = lane & 31, hh = lane >> 5, c0 = 2 * lane, cg0 = h * 128 + c0;
        float qv[8][2], kv[8][2], Bl[8][2];
        {
            float run0 = 0.f, run1 = 0.f;
#pragma unroll
            for (int rr = 0; rr < 8; ++rr) {
                const int t = 8 * w + rr;
                const unsigned uq = pq[rr], uf = pf[rr], ui = pi[rr];
                qv[rr][0] = silu_(bflo(uq)); qv[rr][1] = silu_(bfhi(uq));
                const float f0 = lb0 + (1.f - lb0) * sigmoid_(bflo(uf)), f1 = lb1 + (1.f - lb1) * sigmoid_(bfhi(uf));
                kv[rr][0] = 1.f - f0; kv[rr][1] = 1.f - f1;
                run0 += __logf(f0); run1 += __logf(f1);
                Bl[rr][0] = run0; Bl[rr][1] = run1;
#pragma unroll
                for (int e = 0; e < 2; ++e) {
                    const int dv = c0 + e; const int off = ((((dv >> 5) * 4 + (t >> 4)) * 64) + ((t >> 3) & 1) * 32 + (dv & 31)) * 16 + (t & 7) * 2;
                    *(bf16*)(VF + off) = (bf16)(e ? (ui >> 16) : (ui & 0xffffu));
                }
            }
            TOT[w * 128 + c0] = run0; TOT[w * 128 + c0 + 1] = run1;
        }
        {
            const int tn = (ch < 31 ? t0 + 64 : t0);
#pragma unroll
            for (int rr = 0; rr < 8; ++rr) {
                const bf16* zp = Z + ((size_t)b * SEQ + tn + 8 * w + rr) * 4096 + cg0;
                pq[rr] = *(const unsigned*)zp; pf[rr] = *(const unsigned*)(zp + 1024); pi[rr] = *(const unsigned*)(zp + 2048);
            }
        }
        const u32x4* gatep = (const u32x4*)(Z + ((size_t)b * SEQ + t0 + (tl >> 3)) * 4096 + 3072 + h * 128 + (tl & 7) * 16);
        const u32x4 gate_a = gatep[0], gate_b = gatep[1];

        __syncthreads();
        {
            float off0 = 0.f, off1 = 0.f, bm0 = 0.f, bm1 = 0.f, bl0 = 0.f, bl1 = 0.f;
#pragma unroll
            for (int ww = 0; ww < 8; ++ww) {
                const float t0v = TOT[ww * 128 + c0], t1v = TOT[ww * 128 + c0 + 1];
                if (ww < w) { off0 += t0v; off1 += t1v; }
                if (ww < 4) { bm0 += t0v; bm1 += t1v; }
                bl0 += t0v; bl1 += t1v;
            }
            if (w == 0) { DEC[c0] = __expf(bl0); DEC[c0 + 1] = __expf(bl1); }
#pragma unroll
            for (int rr = 0; rr < 8; ++rr) {
                const int t = 8 * w + rr;
                const float B0 = Bl[rr][0] + off0, B1 = Bl[rr][1] + off1;
                const float qd0 = qv[rr][0] * __expf(B0), qd1 = qv[rr][1] * __expf(B1);
                const float qh0 = qv[rr][0] * __expf(fminf(B0 - bm0, 80.f)), qh1 = qv[rr][1] * __expf(fminf(B1 - bm1, 80.f));
                const float kh0 = kv[rr][0] * __expf(fminf(bm0 - B0, 80.f)), kh1 = kv[rr][1] * __expf(fminf(bm1 - B1, 80.f));
                const float kd0 = kv[rr][0] * __expf(bl0 - B0), kd1 = kv[rr][1] * __expf(bl1 - B1);
                {
                    const int ks = c0 >> 4, x = c0 & 15, hp = (x >> 2) & 1, j = ((x >> 3) << 2) | (x & 3);
                    const int off = ((((t >> 5) * 8 + ks) * 64) + hp * 32 + (t & 31)) * 16 + j * 2;
                    *(unsigned*)(QD + off) = pk2(qd0, qd1);
                }
#pragma unroll
                for (int e = 0; e < 2; ++e) {
                    const int dk = c0 + e; const int off = ((((dk >> 5) * 4 + (t >> 4)) * 64) + ((t >> 3) & 1) * 32 + (dk & 31)) * 16 + (t & 7) * 2;
                    *(bf16*)(KD + off) = f2bf(e ? kd1 : kd0);
                }
                *(unsigned*)(QH + t * LDH + c0) = pk2(qh0, qh1);
                *(unsigned*)(KH + t * LDH + c0) = pk2(kh0, kh1);
            }
        }
        __syncthreads();
        {
            const int fr = lane & 15, fq = lane >> 4, tb = w >> 1;
#pragma unroll
            for (int si = 0; si < 2; ++si) {
                const int sb = 2 * (w & 1) + si; f32x4 acc = {0.f, 0.f, 0.f, 0.f};
#pragma unroll
                for (int kk = 0; kk < 4; ++kk) {
                    const bf16x8 av = *(const bf16x8*)(QH + (16 * tb + fr) * LDH + kk * 32 + fq * 8);
                    const bf16x8 bv = *(const bf16x8*)(KH + (16 * sb + fr) * LDH + kk * 32 + fq * 8);
                    acc = MFMA16(av, bv, acc);
                }
#pragma unroll
                for (int jj = 0; jj < 4; ++jj) {
                    const int t = 16 * tb + 4 * fq + jj, s2 = 16 * sb + fr;
                    const float val = s2 <= t ? acc[jj] : 0.f;
                    const int off = ((((t >> 5) * 4 + (s2 >> 4)) * 64) + ((s2 >> 3) & 1) * 32 + (t & 31)) * 16 + (s2 & 7) * 2;
                    *(bf16*)(AI + off) = f2bf(val);
                }
            }
        }
        __syncthreads();
        if (w < 4) {
            const int dq = w;
            bf16x8 xs[8];
#pragma unroll
            for (int kb = 0; kb < 4; ++kb)
#pragma unroll
                for (int s2 = 0; s2 < 2; ++s2) {
                    u32x4 t4;
#pragma unroll
                    for (int e = 0; e < 4; ++e) t4[e] = pk2(S[kb][8 * s2 + 2 * e], S[kb][8 * s2 + 2 * e + 1]);
                    xs[2 * kb + s2] = __builtin_bit_cast(bf16x8, t4);
                }
            f32x16 O0, O1;
            unsigned obo = L_BF + ((4 * hh) * 128 + 32 * dq + r) * 4; asm volatile("" : "+v"(obo)); lds_f32* ob = (lds_f32*)((lds_u8*)lds + obo);
#pragma unroll
            for (int i = 0; i < 16; ++i) { O0[i] = 0.f; O1[i] = 0.f; }
            lds_u8* l3 = (lds_u8*)lds; unsigned fo = lane * 16; asm volatile("" : "+v"(fo)); const lds_u8* fp = l3 + fo;
#define HF(o_) (*(const __attribute__((address_space(3))) bf16x8*)(fp + (o_)))
#define SB() __builtin_amdgcn_sched_barrier(0)
            bf16x8 ga[8], gb[8];
#pragma unroll
            for (int k = 0; k < 4; ++k) { ga[k] = HF(L_QD + (0 * 8 + k) * 1024); ga[4 + k] = HF(L_QD + (1 * 8 + k) * 1024); }
#pragma unroll
            for (int k = 0; k < 4; ++k) { gb[k] = HF(L_QD + (0 * 8 + 4 + k) * 1024); gb[4 + k] = HF(L_QD + (1 * 8 + 4 + k) * 1024); }
            SB();
#pragma unroll
            for (int k = 0; k < 4; ++k) { O0 = MFMA32(ga[k], xs[k], O0); O1 = MFMA32(ga[4 + k], xs[k], O1); }
            SB();
#pragma unroll
            for (int k = 0; k < 4; ++k) ga[k] = HF(L_VF + (dq * 4 + k) * 1024);
            ga[4] = HF(L_AI + (0 * 4 + 0) * 1024); ga[5] = HF(L_AI + (0 * 4 + 1) * 1024); ga[6] = HF(L_AI + (1 * 4 + 0) * 1024); ga[7] = HF(L_AI + (1 * 4 + 1) * 1024);
            SB();
#pragma unroll
            for (int k = 0; k < 4; ++k) { O0 = MFMA32(gb[k], xs[4 + k], O0); O1 = MFMA32(gb[4 + k], xs[4 + k], O1); }
            SB();
            gb[0] = HF(L_AI + (1 * 4 + 2) * 1024); gb[1] = HF(L_AI + (1 * 4 + 3) * 1024);
#pragma unroll
            for (int k = 0; k < 4; ++k) gb[2 + k] = HF(L_KD + (0 * 4 + k) * 1024);
            f32x4 dd[4];
#define LDD(kb_) do { _Pragma("unroll") for (int g = 0; g < 4; ++g) dd[g] = *(const f32x4*)(DEC + 32 * (kb_) + 8 * g + 4 * hh); } while (0)
#define MULD(kb_) do { _Pragma("unroll") for (int g = 0; g < 4; ++g) _Pragma("unroll") for (int e = 0; e < 4; ++e) S[kb_][4 * g + e] *= dd[g][e]; } while (0)
            LDD(0);
            SB();
            const bf16x8 vf0 = ga[0], vf1 = ga[1], vf2 = ga[2], vf3 = ga[3];
            O0 = MFMA32(ga[4], vf0, O0); O0 = MFMA32(ga[5], vf1, O0); O1 = MFMA32(ga[6], vf0, O1); O1 = MFMA32(ga[7], vf1, O1);
            SB();
#pragma unroll
            for (int k = 0; k < 4; ++k) ga[4 + k] = HF(L_KD + (1 * 4 + k) * 1024);
            SB();
            O1 = MFMA32(gb[0], vf2, O1); O1 = MFMA32(gb[1], vf3, O1);
            MULD(0);
            S[0] = MFMA32(gb[2], vf0, S[0]); S[0] = MFMA32(gb[3], vf1, S[0]); S[0] = MFMA32(gb[4], vf2, S[0]); S[0] = MFMA32(gb[5], vf3, S[0]);
            SB();
            LDD(1);
#pragma unroll
            for (int k = 0; k < 4; ++k) gb[k] = HF(L_KD + (2 * 4 + k) * 1024);
            SB();
            MULD(1);
            S[1] = MFMA32(ga[4], vf0, S[1]); S[1] = MFMA32(ga[5], vf1, S[1]); S[1] = MFMA32(ga[6], vf2, S[1]); S[1] = MFMA32(ga[7], vf3, S[1]);
            SB();
            LDD(2);
#pragma unroll
            for (int k = 0; k < 4; ++k) ga[4 + k] = HF(L_KD + (3 * 4 + k) * 1024);
            SB();
            MULD(2);
            S[2] = MFMA32(gb[0], vf0, S[2]); S[2] = MFMA32(gb[1], vf1, S[2]); S[2] = MFMA32(gb[2], vf2, S[2]); S[2] = MFMA32(gb[3], vf3, S[2]);
            SB();
            LDD(3);
            SB();
            MULD(3);
            S[3] = MFMA32(ga[4], vf0, S[3]); S[3] = MFMA32(ga[5], vf1, S[3]); S[3] = MFMA32(ga[6], vf2, S[3]); S[3] = MFMA32(ga[7], vf3, S[3]);
#undef LDD
#undef MULD
#undef HF
#undef SB
#pragma unroll
            for (int i = 0; i < 16; ++i) { ob[((i & 3) + 8 * (i >> 2)) * 128] = O0[i]; ob[(32 + (i & 3) + 8 * (i >> 2)) * 128] = O1[i]; }
        }
        f32x4 gnh[4];
#pragma unroll
        for (int q = 0; q < 4; ++q) gnh[q] = *(const f32x4*)(PAR + P_HON + (tl & 7) * 16 + 4 * q);
        __syncthreads();
        norm_gate_store_pre(Bf, gnh, gate_a, gate_b, MIX + ((size_t)b * SEQ + t0) * 1024 + h * 128, tl);
    }
    __syncthreads();
}

#define LAS __attribute__((address_space(3)))
#define XB_TMO      128
#define XB_XCNT(j)  (256  + 64 * (j))
#define XB_XSUB(j)  (1280 + 64 * (j))
#define XB_XGEN(j)  (2304 + 64 * (j))
#define XB_TOP      3328
#define XB_TOPGEN   3392
#define XCD_BAR_WORDS 3456
#define XB_SPIN_CAP (1u << 18)

__device__ __forceinline__ unsigned xb_ld(unsigned* p)              { return __hip_atomic_load(p, __ATOMIC_RELAXED, __HIP_MEMORY_SCOPE_AGENT); }
__device__ __forceinline__ unsigned xb_add(unsigned* p, unsigned v) { return __hip_atomic_fetch_add(p, v, __ATOMIC_RELAXED, __HIP_MEMORY_SCOPE_AGENT); }
__device__ __forceinline__ unsigned xb_xcc_id() { return (unsigned)__builtin_amdgcn_s_getreg((3 << 11) | 20) & 0xFu; }
#define XB_SPIN(cond, bar) do { unsigned _sp = 0; while (cond) { __builtin_amdgcn_s_sleep(1); \
    if ((++_sp & 255u) == 0u) { if (xb_ld(&(bar)[XB_TMO])) break; if (_sp > XB_SPIN_CAP) { atomicAdd(&(bar)[XB_TMO], 1u); break; } } } } while (0)

struct XcdBarrier {
    unsigned* bar; unsigned x;
    volatile LAS unsigned* st;
};

__device__ __forceinline__ XcdBarrier xcd_barrier_post(unsigned* bar, volatile LAS unsigned* st, const bool t0_) {
    XcdBarrier b; b.bar = bar; b.x = xb_xcc_id(); b.st = st;
    if (t0_) (void)xb_add(&bar[XB_XCNT(b.x)], 1u);
    return b;
}
__device__ __forceinline__ void xcd_barrier_complete(unsigned* bar, unsigned x, unsigned& nloc, unsigned& nx) {
    const unsigned G = gridDim.x * gridDim.y * gridDim.z;
    unsigned sum, cnt, mine, sp = 0u;
    for (;;) {
        sum = 0u; cnt = 0u; mine = 0u;
#pragma unroll
        for (unsigned j = 0; j < 16; ++j) { const unsigned c = xb_ld(&bar[XB_XCNT(j)]); sum += c; cnt += (c > 0u) ? 1u : 0u; mine = (j == x) ? c : mine; }
        if (sum == G) break;
        __builtin_amdgcn_s_sleep(1);
        if ((++sp & 255u) == 0u) { if (xb_ld(&bar[XB_TMO])) break; if (sp > XB_SPIN_CAP) { atomicAdd(&bar[XB_TMO], 1u); break; } }
    }
    nloc = mine > 0u ? mine : 1u; nx = cnt > 0u ? cnt : 1u;
}

__device__ __forceinline__ void xcd_barrier(const XcdBarrier& b, const bool t0_) {
    asm volatile("s_waitcnt vmcnt(0)" ::: "memory");
    __syncthreads();
    if (t0_) {
        unsigned* bar = b.bar;
        __builtin_amdgcn_s_waitcnt(0);
        unsigned nloc = b.st[0], nx = b.st[1];
        if (nloc == 0u) { xcd_barrier_complete(bar, b.x, nloc, nx); b.st[0] = nloc; b.st[1] = nx; }
        const unsigned old = xb_add(&bar[XB_XSUB(b.x)], 1u);
        const unsigned gen = old / nloc;
        if (old + 1u == (gen + 1u) * nloc) {
            __builtin_amdgcn_fence(__ATOMIC_RELEASE, "agent");
            asm volatile("s_waitcnt vmcnt(0)" ::: "memory");
            const unsigned og = xb_add(&bar[XB_TOP], 1u);
            const unsigned tg = og / nx;
            if (og + 1u == (tg + 1u) * nx) xb_add(&bar[XB_TOPGEN], 1u);
            else XB_SPIN(xb_ld(&bar[XB_TOPGEN]) == tg, bar);
            __builtin_amdgcn_fence(__ATOMIC_ACQUIRE, "agent");
            xb_add(&bar[XB_XGEN(b.x)], 1u);
            asm volatile("s_waitcnt vmcnt(0)" ::: "memory");
        } else {
            XB_SPIN(xb_ld(&bar[XB_XGEN(b.x)]) == gen, bar);
            __builtin_amdgcn_fence(__ATOMIC_ACQUIRE, "agent");
            asm volatile("s_waitcnt vmcnt(0)" ::: "memory");
        }
    }
    __syncthreads();
}

__global__ void __launch_bounds__(512, 2) trunk_fwd(Args a) {
    extern __shared__ __attribute__((aligned(16))) unsigned char lds[];
    __builtin_assume(__builtin_amdgcn_workitem_id_y() == 0); __builtin_assume(__builtin_amdgcn_workitem_id_z() == 0);
    cg::grid_group grid = cg::this_grid();
    const int G = gridDim.x, blk = blockIdx.x;
    unsigned char* ws = a.ws;
    PG8_LAS unsigned char* lds3 = (PG8_LAS unsigned char*)lds;
    bf16* XB = (bf16*)(ws + WS_XB); bf16* MIX = (bf16*)(ws + WS_MIX); bf16* ZH = (bf16*)(ws + WS_ZH); float* SS = (float*)(ws + WS_SS);

    volatile LAS unsigned* bst = (volatile LAS unsigned*)((LAS unsigned char*)lds + (LDS_BYTES - 64));
    const int WV = __builtin_amdgcn_readfirstlane((int)(threadIdx.x >> 6));
    if (WV == 0 && lane_id_() == 0) { bst[0] = 0u; bst[1] = 0u; }
    __syncthreads();
    (void)xcd_barrier_post((unsigned*)(ws + WS_BAR), bst, WV == 0 && lane_id_() == 0);
#define GRID_BAR() do { unsigned char* wsl_ = a.ws; asm volatile("" : "+s"(wsl_)); XcdBarrier xb_; xb_.bar = (unsigned*)(wsl_ + WS_BAR); xb_.x = xb_xcc_id(); xb_.st = (volatile LAS unsigned*)((LAS unsigned char*)lds + (LDS_BYTES - 64)); xcd_barrier(xb_, WV == 0 && lane_id_() == 0); } while (0)
    p0_prologue(a, lds, WV);
    if (a.ws == nullptr) grid.sync();
    GRID_BAR();
    _Pragma("unroll") for (int layer = 0; layer < 2; ++layer) {
        const int NIN = layer == 0 ? N0 : 4096;
        if (layer == 0) {
            pg8::Gemm g{XB, (const bf16*)(ws + WS_W0IN), M, N0, 1024}; int blkl = blk; asm volatile("" : "+s"(blkl)); pg8::StaticOrder S; S.init(M, N0, G, blkl, WGM_WIDE);
            rs_table_build<true>(lds, SS, S, WV);
            EpiAct<2> E{ZH, N0, (const float*)(ws + WS_PAR), (const lds_f32_t*)((PG8_LAS unsigned char*)lds + RS_OFF), 0};
            pg8::gemm_phase<EpiAct<2>, pg8::StaticOrder, true, true>(lds3, g, S, E, WV);
        } else {
            pg8::Gemm g{XB, (const bf16*)(ws + WS_W1IN), M, 4096, 1024}; int blkl = blk; asm volatile("" : "+s"(blkl)); pg8::StaticOrder S; S.init(M, 4096, G, blkl, WGM_WIDE);
            rs_table_build<false>(lds, SS + (size_t)2 * SS_STRIDE, S, WV);
            EpiAct<0> E{ZH, 4096, nullptr, (const lds_f32_t*)((PG8_LAS unsigned char*)lds + RS_OFF), 0};
            pg8::gemm_phase<EpiAct<0>, pg8::StaticOrder, true, true>(lds3, g, S, E, WV);
        }
        GRID_BAR();
        if (layer == 0) {
            fox_prep(a, WV);
            for (int u = blk; u < 2048; u += G) gdn_prep_unit(a, u, lds, WV);
            GRID_BAR();
            const float* C2g = (const float*)(ws + WS_C2);
            int Gl = G; asm volatile("" : "+s"(Gl));
            const bool bal = (Gl == 256); const int sstride = bal ? 64 : Gl;
            if (blk < sstride) for (int u = blk; u < 64; u += sstride) gdn_scan_unit(a, u, lds, WV);
            const int nk = bal ? 4 : (1024 + Gl - 1) / Gl;
#pragma unroll 1
            for (int k = 0; k < nk; ++k) {
                const int i = blk - 64;
                const int u = bal ? (blk < 64 ? 768 + 64 * k + blk : 192 * k + ((k & 1) ? 191 - i : i)) : blk + Gl * k;
                if (u < 1024) { const int qb = 7 - (u >> 7), bh = u & 127; fox_unit(ZH, C2g, MIX, bh >> 3, bh & 7, qb, lds, WV); }
            }
        } else {
            for (int u = blk; u < 128; u += G) hgrn_unit(a, u >> 3, u & 7, lds, WV);
        }
        GRID_BAR();
        if (layer == 0) {
            pg8::Gemm g{MIX, (const bf16*)(ws + WS_W0OUT), M, 1024, 1024}; int blkl = blk; asm volatile("" : "+s"(blkl)); pg8::StaticOrder S; S.init(M, 1024, G, blkl);
            EpiRes<false, false> E{a.in[0], nullptr, XB, SS + (size_t)1 * SS_STRIDE};
            pg8::gemm_phase<EpiRes<false, false>, pg8::StaticOrder, true, true>(lds3, g, S, E, WV);
        } else {
            pg8::Gemm g{MIX, (const bf16*)(ws + WS_W1OUT), M, 1024, 1024}; int blkl = blk; asm volatile("" : "+s"(blkl)); pg8::StaticOrder S; S.init(M, 1024, G, blkl);
            EpiRes<true, false> E{XB, nullptr, XB, SS + (size_t)3 * SS_STRIDE};
            pg8::gemm_phase<EpiRes<true, false>, pg8::StaticOrder, true, true>(lds3, g, S, E, WV);
        }
        GRID_BAR();
        {
            pg8::Gemm g{XB, (const bf16*)(ws + (layer == 0 ? WS_W0F1 : WS_W1F1)), M, 4096, 1024}; int blkl = blk; asm volatile("" : "+s"(blkl)); pg8::StaticOrder S; S.init(M, 4096, G, blkl, WGM_WIDE);
            rs_table_build<false>(lds, SS + (size_t)(2 * layer + 1) * SS_STRIDE, S, WV);
            EpiAct<1> E{ZH, 4096, nullptr, (const lds_f32_t*)((PG8_LAS unsigned char*)lds + RS_OFF), 0};
            pg8::gemm_phase<EpiAct<1>, pg8::StaticOrder, true, true>(lds3, g, S, E, WV);
        }
        GRID_BAR();
        if (layer == 0) {
            pg8::Gemm g{ZH, (const bf16*)(ws + WS_W0F2), M, 1024, 4096}; int blkl = blk; asm volatile("" : "+s"(blkl)); pg8::StaticOrder S; S.init(M, 1024, G, blkl);
            EpiRes<true, false> E{XB, nullptr, XB, SS + 2 * SS_STRIDE};
            pg8::gemm_phase<EpiRes<true, false>, pg8::StaticOrder, true, true>(lds3, g, S, E, WV);
        } else {
            pg8::Gemm g{ZH, (const bf16*)(ws + WS_W1F2), M, 1024, 4096}; int blkl = blk; asm volatile("" : "+s"(blkl)); pg8::StaticOrder S; S.init(M, 1024, G, blkl);
            EpiRes<true, true> E{XB, a.out, nullptr, nullptr};
            pg8::gemm_phase<EpiRes<true, true>, pg8::StaticOrder, true, true>(lds3, g, S, E, WV);
        }
        if (layer == 0) GRID_BAR();
    }
}

extern "C" void kernel_launch(void* const* d_in, const int* in_sizes, int n_in, void* d_out, int out_size, void* d_ws, size_t ws_size, hipStream_t stream) {
    static int grid = 0;
    if (grid == 0) {
        if (n_in != 22 || out_size != M * DM || ws_size < WS_END) { fprintf(stderr, "kernel_launch: unexpected problem (n_in %d out %d ws %zu)\n", n_in, out_size, ws_size); grid = -1; return; }
        int dev = 0, cus = 0, per_cu = 0;
        (void)hipGetDevice(&dev);
        (void)hipDeviceGetAttribute(&cus, hipDeviceAttributeMultiprocessorCount, dev);
        (void)hipFuncSetAttribute((const void*)trunk_fwd, hipFuncAttributeMaxDynamicSharedMemorySize, LDS_BYTES);
        (void)hipOccupancyMaxActiveBlocksPerMultiprocessor(&per_cu, (const void*)trunk_fwd, 512, LDS_BYTES);
        if (per_cu < 1) per_cu = 1;
        grid = cus * per_cu;
        fprintf(stderr, "kernel_launch: grid %d (cus %d x %d)\n", grid, cus, per_cu);
    }
    if (grid < 0) return;
    Args a{};
    for (int i = 0; i < 22; ++i) a.in[i] = (const float*)d_in[i];
    a.out = (float*)d_out; a.ws = (unsigned char*)d_ws;
    (void)hipMemsetAsync((unsigned char*)d_ws + WS_BAR, 0, 16384, stream);
    void* args[] = {&a};
    hipError_t e = hipLaunchCooperativeKernel((const void*)trunk_fwd, dim3(grid), dim3(512), args, LDS_BYTES, stream);
    if (e != hipSuccess) fprintf(stderr, "kernel_launch: cooperative launch failed: %s (grid %d)\n", hipGetErrorString(e), grid);
}
```

```cpp
#include <hip/hip_runtime.h>
#include <hip/hip_cooperative_groups.h>
#include <cstdio>
#include <cstdint>
namespace cg = cooperative_groups;
__device__ __forceinline__ int lane_id_() { int l; asm volatile("v_mbcnt_lo_u32_b32 %0, -1, 0\n\tv_mbcnt_hi_u32_b32 %0, -1, %0" : "=v"(l)); return l; }
#define TIDX(wv_) ((wv_) * 64 + lane_id_())
namespace pg8 {
#define PG8_LAS __attribute__((address_space(3)))
typedef unsigned short bf16_t;
typedef short bf16x8 __attribute__((ext_vector_type(8)));
typedef float f32x4 __attribute__((ext_vector_type(4)));
typedef unsigned u32x4 __attribute__((ext_vector_type(4)));
constexpr int BM = 256, BK = 64, HALF = 128, HTB = HALF * BK * 2  , STAGE_BYTES = 8 * HTB, NXCD = 8, WGM = 8;

__host__ __device__ __forceinline__ int lds_byte(int r, int c) { const int st = (r >> 4) * 2 + (c >> 5), rr = r & 15, cc = c & 31, ob = rr * 64 + cc * 2; return st * 1024 + (ob ^ (((ob >> 9) & 1) << 5)); }
__host__ __device__ __forceinline__ void stage_rc(int b, int& R, int& C) { const int st = b / 1024, sb = b % 1024, swz = sb ^ (((sb >> 9) & 1) << 5); R = (st >> 1) * 16 + swz / 64; C = (st & 1) * 32 + (swz % 64) / 2; }
__host__ __device__ __forceinline__ int perm32(int rho) { const int n = rho >> 4, i = rho & 15; return 8 * (i >> 2) + 4 * n + (i & 3); }

struct Unit { int pm, pn; };
struct Gemm { const bf16_t* A; const bf16_t* Bt; int M, N, K; };

struct StaticOrder {
    int nM, nN, nwg, G, c, wgm;
    __host__ __device__ void init(int M, int N, int G_, int c_, int wgm_ = WGM) { nM = M / BM; nN = N / BM; nwg = nM * nN; G = G_; c = c_; wgm = wgm_; }
    __host__ __device__ bool next(int i, Unit& u) const {
        const long L = (long)i * G + c; if (L >= nwg) return false;
        int wgid = (int)L; { const int q = nwg / NXCD, r = nwg % NXCD, xcd = wgid % NXCD, off = wgid / NXCD; wgid = (xcd < r ? xcd * (q + 1) : r * (q + 1) + (xcd - r) * q) + off; }
        const int nig = wgm * nN, gid = wgid / nig, fm = gid * wgm, gsz = (nM - fm) < wgm ? (nM - fm) : wgm;
        u.pm = fm + ((wgid % nig) % gsz); u.pn = (wgid % nig) / gsz; return true;
    }
    __device__ __forceinline__ void a_ready(const Unit&) const {}
    __device__ __forceinline__ void done(const Unit&) const {}
};

__device__ __forceinline__ unsigned cvt_pk_bf16_unused(float lo, float hi) { return 0; }
template <class Epi, class Sched, bool ALIGN_EPI = false, bool SP2 = false>
__device__ __forceinline__ void gemm_phase(PG8_LAS unsigned char* lds, const Gemm g, const Sched& S, const Epi& E, const int wv_) {
    int tid_ = TIDX(wv_); asm volatile("" : "+v"(tid_)); const int tid = tid_, wid = __builtin_amdgcn_readfirstlane(tid >> 6), lane = tid & 63, wr = wid >> 2, wc = wid & 3, fr = lane & 15, fq = lane >> 4;
    const int K = g.K, nt = K / BK;
    unsigned voffA[2], voffB[2];
#pragma unroll
    for (int i = 0; i < 2; ++i) { int R, C; stage_rc(tid * 16 + i * 8192, R, C); const int Rb = Epi::PERM ? ((R & ~31) + perm32(R & 31)) : R;
        voffA[i] = (unsigned)(R * K + C) * 2u; voffB[i] = (unsigned)(Rb * K + C) * 2u; }
    const size_t kstep = (size_t)(BK * 2);
    const size_t hstep = (size_t)HALF * K * 2;
    const size_t tstep = 2 * hstep;
    const unsigned ldsw = (unsigned)wid * 1024u;
    const int aoff = lds_byte(wr * 64 + fr, fq * 8), boff = lds_byte(wc * 32 + fr, fq * 8);
#define PG8_SA(b, h) (((b) * 2 + (h)) * HTB)
#define PG8_SB(b, h) ((4 + (b) * 2 + (h)) * HTB)
#define PG8_STAGE(bufoff, gbase, voff) do { _Pragma("unroll") for (int _i = 0; _i < 2; ++_i) \
        __builtin_amdgcn_global_load_lds((const unsigned*)((const char*)(gbase) + (voff)[_i]), (PG8_LAS unsigned*)(lds + (bufoff) + ldsw + _i * 8192), 16, 0, 0); } while (0)
#define PG8_LDA(dst, b, h) do { _Pragma("unroll") for (int m = 0; m < 4; ++m) _Pragma("unroll") for (int k = 0; k < 2; ++k) dst[m][k] = *(const PG8_LAS bf16x8*)(lds + PG8_SA(b, h) + aoff + m * 2048 + k * 1024); } while (0)
#define PG8_LDB(dst, b, h) do { _Pragma("unroll") for (int n = 0; n < 2; ++n) _Pragma("unroll") for (int k = 0; k < 2; ++k) dst[n][k] = *(const PG8_LAS bf16x8*)(lds + PG8_SB(b, h) + boff + n * 2048 + k * 1024); } while (0)
#define PG8_MMA(ai, bj, At, Bt) do { __builtin_amdgcn_s_setprio(1); _Pragma("unroll") for (int m = 0; m < 4; ++m) _Pragma("unroll") for (int n = 0; n < 2; ++n) _Pragma("unroll") for (int k = 0; k < 2; ++k) \
        acc[ai][bj][m][n] = __builtin_amdgcn_mfma_f32_16x16x32_bf16(Bt[n][k], At[m][k], acc[ai][bj][m][n], 0, 0, 0); __builtin_amdgcn_s_setprio(0); } while (0)
#define PG8_WAIT_V(n) asm volatile("s_waitcnt vmcnt(" #n ")" ::: "memory")
#define PG8_WAIT_L(n) asm volatile("s_waitcnt lgkmcnt(" #n ")" ::: "memory")
#define PG8_BAR __builtin_amdgcn_s_barrier()
#define PG8_SCHED __builtin_amdgcn_sched_barrier(0)
    Unit cur, nxt; int ui = 0;
    if (!S.next(0, cur)) return;
    f32x4 acc[2][2][4][2];
#pragma unroll
    for (int a = 0; a < 2; ++a)
#pragma unroll
        for (int b = 0; b < 2; ++b)
#pragma unroll
            for (int m = 0; m < 4; ++m)
#pragma unroll
                for (int n = 0; n < 2; ++n) acc[a][b][m][n] = (f32x4){0.f, 0.f, 0.f, 0.f};
    bf16x8 At[4][2], B0[2][2], B1[2][2];
    const char* cA = (const char*)g.A + (size_t)cur.pm * tstep; const char* cB = (const char*)g.Bt + (size_t)cur.pn * tstep;
    S.a_ready(cur);
    if constexpr (SP2) {
        PG8_STAGE(PG8_SB(0, 0), cB, voffB); PG8_STAGE(PG8_SB(0, 1), cB + hstep, voffB); PG8_STAGE(PG8_SA(0, 0), cA, voffA); PG8_STAGE(PG8_SA(0, 1), cA + hstep, voffA);
        if (wr == 1) PG8_BAR;
        PG8_WAIT_V(2); PG8_BAR;
        PG8_STAGE(PG8_SB(1, 0), cB + kstep, voffB); PG8_STAGE(PG8_SA(1, 0), cA + kstep, voffA); PG8_STAGE(PG8_SB(1, 1), cB + hstep + kstep, voffB);
        PG8_WAIT_V(6); PG8_BAR;
    } else {
        PG8_STAGE(PG8_SB(0, 0), cB, voffB); PG8_STAGE(PG8_SA(0, 0), cA, voffA); PG8_STAGE(PG8_SB(0, 1), cB + hstep, voffB); PG8_STAGE(PG8_SA(0, 1), cA + hstep, voffA);
        if (wr == 1) PG8_BAR;
        PG8_WAIT_V(4); PG8_BAR;
        PG8_STAGE(PG8_SB(1, 0), cB + kstep, voffB); PG8_STAGE(PG8_SA(1, 0), cA + kstep, voffA); PG8_STAGE(PG8_SB(1, 1), cB + hstep + kstep, voffB);
        PG8_WAIT_V(6); PG8_BAR;
    }
    for (;;) {
        const bool has_next = S.next(ui + 1, nxt);
        const char* nA = has_next ? (const char*)g.A + (size_t)nxt.pm * tstep : cA; const char* nB = has_next ? (const char*)g.Bt + (size_t)nxt.pn * tstep : cB;
        for (int t = 0; t < nt; t += 2) {
            const bool last = (t == nt - 2);
            const char* a1 = cA + (size_t)(t + 1) * kstep;
            const char* a2 = last ? nA : cA + (size_t)(t + 2) * kstep; const char* b2 = last ? nB : cB + (size_t)(t + 2) * kstep;
            const char* a3 = a2 + kstep; const char* b3 = b2 + kstep;
            if (last && has_next) S.a_ready(nxt);
            if constexpr (SP2) {
            PG8_LDB(B0, 0, 0); PG8_LDB(B1, 0, 1); PG8_SCHED; PG8_LDA(At, 0, 0); PG8_STAGE(PG8_SA(1, 1), a1 + hstep, voffA);
            PG8_WAIT_V(8); PG8_WAIT_L(0); PG8_BAR; PG8_MMA(0, 0, At, B0); PG8_MMA(0, 1, At, B1); PG8_BAR; PG8_SCHED;
            PG8_LDA(At, 0, 1); PG8_STAGE(PG8_SB(0, 0), b2, voffB); PG8_STAGE(PG8_SB(0, 1), b2 + hstep, voffB); PG8_STAGE(PG8_SA(0, 0), a2, voffA);
            PG8_WAIT_V(8); PG8_WAIT_L(0); PG8_BAR; PG8_MMA(1, 0, At, B0); PG8_MMA(1, 1, At, B1); PG8_BAR; PG8_SCHED;
            PG8_LDB(B0, 1, 0); PG8_LDB(B1, 1, 1); PG8_SCHED; PG8_LDA(At, 1, 0); PG8_STAGE(PG8_SA(0, 1), a2 + hstep, voffA);
            PG8_WAIT_V(8); PG8_WAIT_L(0); PG8_BAR; PG8_MMA(0, 0, At, B0); PG8_MMA(0, 1, At, B1); PG8_BAR; PG8_SCHED;
            PG8_LDA(At, 1, 1); PG8_STAGE(PG8_SB(1, 0), b3, voffB); PG8_STAGE(PG8_SB(1, 1), b3 + hstep, voffB); PG8_STAGE(PG8_SA(1, 0), a3, voffA);
            PG8_WAIT_V(8); PG8_WAIT_L(0); PG8_BAR; PG8_MMA(1, 0, At, B0); PG8_MMA(1, 1, At, B1); PG8_BAR; PG8_SCHED;
            } else {
            PG8_LDB(B0, 0, 0); PG8_SCHED; PG8_LDA(At, 0, 0); PG8_STAGE(PG8_SA(1, 1), a1 + hstep, voffA);
            PG8_WAIT_L(8); PG8_BAR; PG8_WAIT_L(0); PG8_MMA(0, 0, At, B0); PG8_BAR; PG8_SCHED;
            PG8_LDB(B1, 0, 1); PG8_STAGE(PG8_SB(0, 0), b2, voffB);
            PG8_BAR; PG8_WAIT_L(0); PG8_MMA(0, 1, At, B1); PG8_BAR;
            PG8_LDA(At, 0, 1); PG8_STAGE(PG8_SA(0, 0), a2, voffA);
            PG8_BAR; PG8_WAIT_L(0); PG8_MMA(1, 0, At, B0); PG8_BAR; PG8_SCHED;
            PG8_STAGE(PG8_SB(0, 1), b2 + hstep, voffB);
            PG8_WAIT_V(6); PG8_BAR; PG8_MMA(1, 1, At, B1); PG8_BAR;
            PG8_LDB(B0, 1, 0); PG8_SCHED; PG8_LDA(At, 1, 0); PG8_STAGE(PG8_SA(0, 1), a2 + hstep, voffA);
            PG8_WAIT_L(8); PG8_BAR; PG8_WAIT_L(0); PG8_MMA(0, 0, At, B0); PG8_BAR; PG8_SCHED;
            PG8_LDB(B1, 1, 1); PG8_STAGE(PG8_SB(1, 0), b3, voffB);
            PG8_BAR; PG8_WAIT_L(0); PG8_MMA(0, 1, At, B1); PG8_BAR;
            PG8_LDA(At, 1, 1); PG8_STAGE(PG8_SA(1, 0), a3, voffA);
            PG8_BAR; PG8_WAIT_L(0); PG8_MMA(1, 0, At, B0); PG8_BAR; PG8_SCHED;
            PG8_STAGE(PG8_SB(1, 1), b3 + hstep, voffB);
            PG8_WAIT_V(6); PG8_BAR; PG8_MMA(1, 1, At, B1); PG8_BAR;
            }
        }
        if constexpr (ALIGN_EPI) { if (wr == 0) PG8_BAR; }
        if constexpr (!Epi::AFTER_DRAIN) { E(acc, cur, wr, wc, fr, fq); S.done(cur); }
        if (!has_next) break;
#pragma unroll
        for (int a = 0; a < 2; ++a)
#pragma unroll
            for (int b = 0; b < 2; ++b)
#pragma unroll
                for (int m = 0; m < 4; ++m)
#pragma unroll
                    for (int n = 0; n < 2; ++n) acc[a][b][m][n] = (f32x4){0.f, 0.f, 0.f, 0.f};
        cur = nxt; cA = nA; cB = nB; ++ui;
        if constexpr (ALIGN_EPI) { if (wr == 1) PG8_BAR; }
    }
    PG8_WAIT_V(0);
    if constexpr (!ALIGN_EPI) { if (wr == 0) PG8_BAR; }
    PG8_BAR;
    if constexpr (Epi::AFTER_DRAIN) { E.fused(acc, cur, wr, wc, fr, fq, lds, wid, lane); S.done(cur); }
#undef PG8_SA
#undef PG8_SB
#undef PG8_STAGE
#undef PG8_LDA
#undef PG8_LDB
#undef PG8_MMA
#undef PG8_WAIT_V
#undef PG8_WAIT_L
#undef PG8_BAR
#undef PG8_SCHED
}
}
#define DI __device__ __forceinline__
typedef __attribute__((address_space(3))) float lds_f32_t;
typedef unsigned short bf16;
typedef float f32x4 __attribute__((ext_vector_type(4)));
typedef float f32x2 __attribute__((ext_vector_type(2)));
typedef float f32x16 __attribute__((ext_vector_type(16)));
typedef short bf16x8 __attribute__((ext_vector_type(8)));
typedef short s16x4 __attribute__((ext_vector_type(4)));
typedef unsigned u32x4 __attribute__((ext_vector_type(4)));
typedef __bf16 bf16x2_t __attribute__((ext_vector_type(2)));
#define MFMA32(a, b, c) __builtin_amdgcn_mfma_f32_32x32x16_bf16((a), (b), (c), 0, 0, 0)
#define LDS_FENCE() asm volatile("s_waitcnt lgkmcnt(0)" ::: "memory")

DI unsigned pk2(float lo, float hi) { f32x2 v = {lo, hi}; bf16x2_t b = __builtin_convertvector(v, bf16x2_t); return __builtin_bit_cast(unsigned, b); }
DI float bflo(unsigned u) { return __uint_as_float(u << 16); }
DI float bfhi(unsigned u) { return __uint_as_float(u & 0xffff0000u); }
DI float bf2f(bf16 h) { return __uint_as_float((unsigned)h << 16); }
DI float wave_sum(float v) {
#pragma unroll
    for (int o = 1; o < 64; o <<= 1) v += __shfl_xor(v, o);
    return v;
}
DI float sigmoid_(float x) { return 1.f / (1.f + __expf(-x)); }
DI float silu_(float x) { return x / (1.f + __expf(-x)); }
DI float softplus_(float x) { return x > 20.f ? x : __logf(1.0f + __expf(x)); }
DI int crow(int reg, int h) { return (reg & 3) + 8 * (reg >> 2) + 4 * h; }

constexpr int BATCH = 16, SEQ = 2048, DM = 1024, M = BATCH * SEQ, FF = 4096, N0 = 3840;
constexpr float EPS = 1e-6f, LOG2E = 1.4426950408889634f;
constexpr size_t MiB = 1u << 20;
constexpr size_t WS_W0IN = 0, WS_W0OUT = 8 * MiB, WS_W0F1 = 10 * MiB, WS_W0F2 = 18 * MiB, WS_W1IN = 26 * MiB, WS_W1OUT = 34 * MiB, WS_W1F1 = 36 * MiB, WS_W1F2 = 44 * MiB;
constexpr size_t WS_MIX = 52 * MiB, WS_ZH = 116 * MiB, WS_SS = 372 * MiB, WS_C2 = 380 * MiB, WS_XB = 384 * MiB, WS_END = 512 * MiB;
constexpr size_t WS_PAR = 381 * MiB;
constexpr int P_QN = 0, P_KN = 64, P_FB = 128, P_CONV = 256, P_ALOG = 6400, P_DTB = 6404, P_GON = 6528, P_HON = 6656, P_LB = 6784, P_END = 8832;
constexpr size_t WS_BAR = 381 * MiB + 131072;
constexpr size_t SS_STRIDE = (size_t)M * 16;
constexpr int LDS_BYTES = 147456;
#ifndef WGM_WIDE
#define WGM_WIDE 4
#endif

constexpr int RS_OFF = 131072;
template <int ACT> struct EpiAct {
    static constexpr bool PERM = true, AFTER_DRAIN = false;
    bf16* O; int ldc; const float* par; const lds_f32_t* rs; mutable int ui;
    DI void operator()(const f32x4 (&acc)[2][2][4][2], const pg8::Unit& u, int wr, int wc, int fr, int fq) const {
        const int row0 = u.pm * 256 + wr * 64 + fr, col0 = u.pn * 256 + wc * 32 + 8 * fq;
        float rsv[2][4];
#pragma unroll
        for (int ai = 0; ai < 2; ++ai)
#pragma unroll
            for (int m = 0; m < 4; ++m) rsv[ai][m] = rs[ui * 256 + ai * 128 + wr * 64 + m * 16 + fr];
        ++ui;
#pragma unroll
        for (int ai = 0; ai < 2; ++ai)
#pragma unroll
            for (int m = 0; m < 4; ++m) {
                const int row = row0 + ai * 128 + m * 16;
                const float r = rsv[ai][m];
                bf16* rowp = O + (size_t)row * ldc + col0;
                if (ACT == 2 && u.pn < 4) {
                    float ssq = 0.f;
#pragma unroll
                    for (int bj = 0; bj < 2; ++bj)
#pragma unroll
                        for (int n = 0; n < 2; ++n) { const f32x4 t = acc[ai][bj][m][n]; ssq += (t[0] * t[0] + t[1] * t[1]) + (t[2] * t[2] + t[3] * t[3]); }
                    ssq += __shfl_xor(ssq, 16); ssq += __shfl_xor(ssq, 32);
                    const float rn = r * rsqrtf(ssq * r * r * (1.0f / 64.0f) + EPS) * (u.pn < 2 ? 0.125f * LOG2E : 1.0f);
                    int fql = fq; asm volatile("" : "+v"(fql));
                    const float* gq = par + (u.pn < 2 ? P_QN : P_KN) + 8 * fql;
#pragma unroll
                    for (int bj = 0; bj < 2; ++bj) {
                        const f32x4 g0 = *(const f32x4*)(gq + bj * 32), g1 = *(const f32x4*)(gq + bj * 32 + 4);
                        const f32x4 v0 = acc[ai][bj][m][0] * rn * g0, v1 = acc[ai][bj][m][1] * rn * g1;
                        u32x4 w; w.x = pk2(v0[0], v0[1]); w.y = pk2(v0[2], v0[3]); w.z = pk2(v1[0], v1[1]); w.w = pk2(v1[2], v1[3]);
                        __builtin_nontemporal_store(w, (u32x4*)(rowp + bj * 128));
                    }
                    continue;
                }
#pragma unroll
                for (int bj = 0; bj < 2; ++bj) {
                    f32x4 v0 = acc[ai][bj][m][0] * r, v1 = acc[ai][bj][m][1] * r;
                    if (ACT == 1) {
#pragma unroll
                        for (int e = 0; e < 4; ++e) { const float x0 = fmaxf(v0[e], 0.f), x1 = fmaxf(v1[e], 0.f); v0[e] = x0 * x0; v1[e] = x1 * x1; }
                    }
                    u32x4 w; w.x = pk2(v0[0], v0[1]); w.y = pk2(v0[2], v0[3]); w.z = pk2(v1[0], v1[1]); w.w = pk2(v1[2], v1[3]);
                    __builtin_nontemporal_store(w, (u32x4*)(rowp + bj * 128));
                }
            }
    }
};
template <bool FINISHED, class Sched> DI void rs_table_build(unsigned char* lds, const float* ss, const Sched& S, const int wv_) {
    int tid = TIDX(wv_); asm volatile("" : "+v"(tid));
    float* rs = (float*)(lds + RS_OFF);
    const int r = tid & 255, par = tid >> 8;
    pg8::Unit u;
#pragma unroll
    for (int k = 0; k < 4; ++k) {
        const int i = 2 * k + par;
        if (S.next(i, u)) {
            const int row = u.pm * 256 + r;
            if (FINISHED) rs[i * 256 + r] = ss[row];
            else {
                const f32x4* p = (const f32x4*)(ss + (size_t)row * 16);
                const f32x4 a = p[0], b = p[1], c = p[2], d = p[3];
                const float sm = ((a.x + a.y) + (a.z + a.w)) + ((b.x + b.y) + (b.z + b.w)) + ((c.x + c.y) + (c.z + c.w)) + ((d.x + d.y) + (d.z + d.w));
                rs[i * 256 + r] = rsqrtf(sm * (1.0f / 1024.0f) + EPS);
            }
        }
    }
    __syncthreads();
}
template <bool BASE_BF16, bool OUT_F32> struct EpiRes {
    static constexpr bool PERM = true, AFTER_DRAIN = false;
    const void* base; float* out; bf16* xb; float* ss_out;
    DI void operator()(const f32x4 (&acc)[2][2][4][2], const pg8::Unit& u, int wr, int wc, int fr, int fq) const {
        const int row0 = u.pm * 256 + wr * 64 + fr, col0 = u.pn * 256 + wc * 32 + 8 * fq;
#pragma unroll
        for (int ai = 0; ai < 2; ++ai) {
            f32x4 bb[4][2][2];
#pragma unroll
            for (int m = 0; m < 4; ++m)
#pragma unroll
                for (int bj = 0; bj < 2; ++bj) {
                    const size_t off = (size_t)(row0 + ai * 128 + m * 16) * 1024 + col0 + bj * 128;
                    if (BASE_BF16) {
                        const u32x4 w = *(const u32x4*)((const bf16*)base + off);
                        bb[m][bj][0] = (f32x4){bflo(w[0]), bfhi(w[0]), bflo(w[1]), bfhi(w[1])}; bb[m][bj][1] = (f32x4){bflo(w[2]), bfhi(w[2]), bflo(w[3]), bfhi(w[3])};
                    } else {
                        bb[m][bj][0] = *(const f32x4*)((const float*)base + off); bb[m][bj][1] = *(const f32x4*)((const float*)base + off + 4);
                    }
                }
            __builtin_amdgcn_sched_barrier(0);
#pragma unroll
            for (int m = 0; m < 4; ++m) {
                const int row = row0 + ai * 128 + m * 16;
                float s = 0.f;
#pragma unroll
                for (int bj = 0; bj < 2; ++bj) {
                    const size_t off = (size_t)row * 1024 + col0 + bj * 128;
                    const f32x4 v0 = acc[ai][bj][m][0] + bb[m][bj][0], v1 = acc[ai][bj][m][1] + bb[m][bj][1];
                    if (OUT_F32) { *(f32x4*)(out + off) = v0; *(f32x4*)(out + off + 4) = v1; }
                    else {
                        s += ((v0[0] * v0[0] + v0[1] * v0[1]) + (v0[2] * v0[2] + v0[3] * v0[3])) + ((v1[0] * v1[0] + v1[1] * v1[1]) + (v1[2] * v1[2] + v1[3] * v1[3]));
                        u32x4 w; w.x = pk2(v0[0], v0[1]); w.y = pk2(v0[2], v0[3]); w.z = pk2(v1[0], v1[1]); w.w = pk2(v1[2], v1[3]); *(u32x4*)(xb + off) = w;
                    }
                }
                if (!OUT_F32) { s += __shfl_xor(s, 16); s += __shfl_xor(s, 32); if (fq == 0) ss_out[(size_t)row * 16 + u.pn * 4 + wc] = s; }
            }
            __builtin_amdgcn_sched_barrier(0);
        }
    }
};

DI int src_col0(int n) {
    if (n < 1024) { const int tile = n >> 8, c = n & 255, half = c >> 7, wc = (c >> 5) & 3, dl = c & 31; return (tile >> 1) * 512 + ((tile & 1) * 4 + wc) * 64 + half * 32 + dl; }
    return n < 1536 ? n : n < 3072 ? n + 8 : n < 3584 ? n + 16 : n < 3592 ? n - 3584 + 1536 : n < 3600 ? n - 3592 + 3080 : -1;
}
DI int fox_col(int which, int h, int d) { return which * 512 + 256 * (h >> 2) + (d >> 5) * 128 + 32 * (h & 3) + (d & 31); }
template <bool MAP> DI void transpose_item(const float* __restrict__ W, int K, int Nsrc, int Ndst, const float* __restrict__ gain, bf16* __restrict__ WT, float* scr, int item, int lane) {
    const int nblk = Ndst / 32, kb = item / nblk, nb = item % nblk, k0 = 64 * kb, n0 = 32 * nb;
    const int n = n0 + (lane & 31), sc = MAP ? src_col0(n) : n;
    float vals[32];
#pragma unroll
    for (int i = 0; i < 32; ++i) {
        const int kk = 2 * i + (lane >> 5); float v = 0.f;
        if (sc >= 0) v = W[(size_t)(k0 + kk) * Nsrc + sc];
        vals[i] = v;
    }
#pragma unroll
    for (int i = 0; i < 32; ++i) {
        const int kk = 2 * i + (lane >> 5); float v = vals[i];
        if (gain) v *= gain[k0 + kk];
        scr[kk * 33 + (lane & 31)] = v;
    }
    LDS_FENCE();
    const int c = lane & 7;
#pragma unroll
    for (int j = 0; j < 4; ++j) {
        const int nn = (lane >> 3) + 8 * j; const float* s = scr + (8 * c) * 33 + nn;
        u32x4 o; o.x = pk2(s[0 * 33], s[1 * 33]); o.y = pk2(s[2 * 33], s[3 * 33]); o.z = pk2(s[4 * 33], s[5 * 33]); o.w = pk2(s[6 * 33], s[7 * 33]);
        *(u32x4*)(WT + (size_t)(n0 + nn) * K + k0 + 8 * c) = o;
    }
    LDS_FENCE();
}

struct Args { const float* in[22]; float* out; unsigned char* ws; };

DI void p0_prologue(const Args& a, unsigned char* lds, const int wv_) {
    int tid = TIDX(wv_); asm volatile("" : "+v"(tid)); const int lane = tid & 63, wave = __builtin_amdgcn_readfirstlane(tid >> 6), gw = blockIdx.x * 8 + wave, NGW = gridDim.x * 8;
    float* scr = (float*)(lds + wave * 16384);
    unsigned char* ws = a.ws;
    constexpr int I0 = 16 * (N0 / 32), I_O = 16 * 32, I_1 = 16 * 128, I_2 = 64 * 32;
    constexpr int NITEMS = I0 + I_O + I_1 + I_2 + I_1 + I_O + I_1 + I_2;
    for (int it = gw; it < NITEMS; it += NGW) {
        int r = it;
        if (r < I0) { transpose_item<true>(a.in[2], 1024, 3600, N0, a.in[1], (bf16*)(ws + WS_W0IN), scr, r, lane); continue; } r -= I0;
        if (r < I_O) { transpose_item<false>(a.in[10], 1024, 1024, 1024, nullptr, (bf16*)(ws + WS_W0OUT), scr, r, lane); continue; } r -= I_O;
        if (r < I_1) { transpose_item<false>(a.in[12], 1024, 4096, 4096, a.in[11], (bf16*)(ws + WS_W0F1), scr, r, lane); continue; } r -= I_1;
        if (r < I_2) { transpose_item<false>(a.in[13], 4096, 1024, 1024, nullptr, (bf16*)(ws + WS_W0F2), scr, r, lane); continue; } r -= I_2;
        if (r < I_1) { transpose_item<false>(a.in[15], 1024, 4096, 4096, a.in[14], (bf16*)(ws + WS_W1IN), scr, r, lane); continue; } r -= I_1;
        if (r < I_O) { transpose_item<false>(a.in[17], 1024, 1024, 1024, nullptr, (bf16*)(ws + WS_W1OUT), scr, r, lane); continue; } r -= I_O;
        if (r < I_1) { transpose_item<false>(a.in[19], 1024, 4096, 4096, a.in[18], (bf16*)(ws + WS_W1F1), scr, r, lane); continue; } r -= I_1;
        transpose_item<false>(a.in[20], 4096, 1024, 1024, nullptr, (bf16*)(ws + WS_W1F2), scr, r, lane);
    }
    if (blockIdx.x == 0) {
        float* P = (float*)(ws + WS_PAR);
        for (int i = tid; i < P_END; i += 512) {
            float v = 0.f;
            if (i < 64) v = a.in[3][i]; else if (i < 128) v = a.in[4][i - 64]; else if (i < 136) v = a.in[5][i - 128];
            else if (i >= P_CONV && i < P_CONV + 6144) v = a.in[6][i - P_CONV];
            else if (i >= P_ALOG && i < P_ALOG + 4) v = a.in[7][i - P_ALOG]; else if (i >= P_DTB && i < P_DTB + 4) v = a.in[8][i - P_DTB];
            else if (i >= P_GON && i < P_GON + 128) v = a.in[9][i - P_GON]; else if (i >= P_HON && i < P_HON + 128) v = a.in[16][i - P_HON];
            else if (i >= P_LB) v = a.in[21][i - P_LB];
            P[i] = v;
        }
    }
    const float* x = a.in[0]; bf16* XB = (bf16*)(ws + WS_XB); float* SS = (float*)(ws + WS_SS);
    for (int m0 = gw; m0 < M; m0 += 2 * NGW) {
        const int m1 = m0 + NGW; const bool has1 = m1 < M;
        const f32x4* xr0 = (const f32x4*)(x + (size_t)m0 * DM) + lane; const f32x4* xr1 = (const f32x4*)(x + (size_t)(has1 ? m1 : m0) * DM) + lane;
        f32x4 v0[4], v1[4]; float s0 = 0.f, s1 = 0.f;
#pragma unroll
        for (int j = 0; j < 4; ++j) { v0[j] = xr0[64 * j]; v1[j] = xr1[64 * j]; }
#pragma unroll
        for (int j = 0; j < 4; ++j) {
            s0 += (v0[j].x * v0[j].x + v0[j].y * v0[j].y) + (v0[j].z * v0[j].z + v0[j].w * v0[j].w);
            s1 += (v1[j].x * v1[j].x + v1[j].y * v1[j].y) + (v1[j].z * v1[j].z + v1[j].w * v1[j].w);
        }
#pragma unroll
        for (int o = 1; o < 64; o <<= 1) { s0 += __shfl_xor(s0, o); s1 += __shfl_xor(s1, o); }
        unsigned long long* o80 = (unsigned long long*)(XB + (size_t)m0 * DM) + lane;
#pragma unroll
        for (int j = 0; j < 4; ++j) o80[64 * j] = (unsigned long long)pk2(v0[j].x, v0[j].y) | ((unsigned long long)pk2(v0[j].z, v0[j].w) << 32);
        if (lane == 0) SS[m0] = rsqrtf(s0 * (1.0f / 1024.0f) + EPS);
        if (has1) {
            unsigned long long* o81 = (unsigned long long*)(XB + (size_t)m1 * DM) + lane;
#pragma unroll
            for (int j = 0; j < 4; ++j) o81[64 * j] = (unsigned long long)pk2(v1[j].x, v1[j].y) | ((unsigned long long)pk2(v1[j].z, v1[j].w) << 32);
            if (lane == 0) SS[m1] = rsqrtf(s1 * (1.0f / 1024.0f) + EPS);
        }
    }
}

DI void fox_prep(const Args& a, const int wv_) {
    int tid = TIDX(wv_); asm volatile("" : "+v"(tid)); const int lane = tid & 63, wave = __builtin_amdgcn_readfirstlane(tid >> 6), gw = blockIdx.x * 8 + wave, NGW = gridDim.x * 8;
    bf16* Z = (bf16*)(a.ws + WS_ZH); float* C2 = (float*)(a.ws + WS_C2);
    for (int it = gw; it < 128; it += NGW) {
        const int b = it >> 3, h = it & 7; const float bias = ((const float*)(a.ws + WS_PAR))[P_FB + h];
        float loc[32]; float run = 0.f;
#pragma unroll
        for (int i = 0; i < 32; ++i) {
            const int t = 32 * lane + i; const float x = bf2f(Z[((size_t)b * SEQ + t) * N0 + 3584 + h]) + bias;
            const float ls = fminf(x, 0.f) - __logf(1.0f + __expf(-fabsf(x))); run += ls; loc[i] = run;
        }
        float incl = run;
#pragma unroll
        for (int o = 1; o < 64; o <<= 1) { const float y = __shfl_up(incl, o); if (lane >= o) incl += y; }
        const float excl = incl - run;
#pragma unroll
        for (int i = 0; i < 32; ++i) C2[(size_t)it * SEQ + 32 * lane + i] = (loc[i] + excl) * LOG2E;
    }
}

constexpr int LDK = 72;
DI void fox_unit(const bf16* __restrict__ Z, const float* __restrict__ C2, bf16* __restrict__ MIX, int b, int h, int qb, unsigned char* lds, const int wv_) {
    int tid = TIDX(wv_); asm volatile("" : "+v"(tid)); const int lane = tid & 63, r = lane & 31, hh = lane >> 5, w = tid >> 6;
    bf16* Ks0 = (bf16*)lds; bf16* Vt0 = (bf16*)(lds + 18432); float* C2s = (float*)(lds + 36864); float* AS = (float*)(lds + 45056) + w * 32;
    const int q0 = qb * 256, nT = (q0 + 256) / 64;
    const size_t rowbase = (size_t)b * SEQ;
    const float* c2g = C2 + (size_t)(b * 8 + h) * SEQ;
    {
        float cv[4];
#pragma unroll
        for (int k = 0; k < 4; ++k) { const int i = tid + 512 * k; cv[k] = i < q0 + 256 ? c2g[i] : 0.f; }
#pragma unroll
        for (int k = 0; k < 4; ++k) { const int i = tid + 512 * k; if (i < q0 + 256) C2s[i] = -cv[k]; }
    }
    const int qrow = q0 + 32 * w + r;
    bf16x8 qr[4];
#pragma unroll
    for (int ks = 0; ks < 4; ++ks) qr[ks] = *(const bf16x8*)(Z + (rowbase + qrow) * N0 + fox_col(0, h, ks * 16 + hh * 8));
    float m_run = -INFINITY, l_run = 0.f;
    f32x16 o0, o1;
#pragma unroll
    for (int i = 0; i < 16; ++i) { o0[i] = 0.f; o1[i] = 0.f; }
    const int kr = tid >> 3, ch = tid & 7;
    const bf16* kvp = Z + (rowbase + kr) * N0 + fox_col(1, h, ch * 8);
    const int voff = 1024 + h * 64 + ch * 8 - fox_col(1, h, ch * 8);
    u32x4 kv = *(const u32x4*)kvp, vv = *(const u32x4*)(kvp + voff);
    {
        *(u32x4*)(Ks0 + kr * LDK + ch * 8) = kv;
#pragma unroll
        for (int e = 0; e < 8; ++e) Vt0[(ch * 8 + e) * LDK + kr] = (bf16)(vv[e >> 1] >> (16 * (e & 1)));
        if (1 < nT) { const bf16* np = kvp + (size_t)64 * N0; kv = *(const u32x4*)np; vv = *(const u32x4*)(np + voff); }
    }
    __syncthreads();
    for (int jt = 0; jt < nT; ++jt) {
        const bf16* Ks = Ks0 + (jt & 1) * 4608; const bf16* Vt = Vt0 + (jt & 1) * 4608;
        if (jt + 1 < nT) {
            bf16* Kn = Ks0 + ((jt + 1) & 1) * 4608; bf16* Vn = Vt0 + ((jt + 1) & 1) * 4608;
            *(u32x4*)(Kn + kr * LDK + ch * 8) = kv;
#pragma unroll
            for (int e = 0; e < 8; ++e) Vn[(ch * 8 + e) * LDK + kr] = (bf16)(vv[e >> 1] >> (16 * (e & 1)));
            if (jt + 2 < nT) { const bf16* np = kvp + (size_t)(jt + 2) * 64 * N0; kv = *(const u32x4*)np; vv = *(const u32x4*)(np + voff); }
        }
        const int kv0 = jt * 64;
        if (kv0 <= q0 + 32 * w + 31) {
            f32x16 p0, p1;
#pragma unroll
            for (int g = 0; g < 4; ++g) {
                const f32x4 c0v = *(const f32x4*)(C2s + kv0 + 8 * g + 4 * hh), c1v = *(const f32x4*)(C2s + kv0 + 32 + 8 * g + 4 * hh);
#pragma unroll
                for (int e = 0; e < 4; ++e) { p0[4 * g + e] = c0v[e]; p1[4 * g + e] = c1v[e]; }
            }
#pragma unroll
            for (int ks = 0; ks < 4; ++ks) {
                const bf16x8 a0 = *(const bf16x8*)(Ks + r * LDK + ks * 16 + hh * 8);
                const bf16x8 a1 = *(const bf16x8*)(Ks + (32 + r) * LDK + ks * 16 + hh * 8);
                p0 = MFMA32(a0, qr[ks], p0); p1 = MFMA32(a1, qr[ks], p1);
            }
            float mt = -INFINITY;
            const bool need_mask = kv0 + 63 > q0 + 32 * w;
#pragma unroll
            for (int g = 0; g < 4; ++g) {
#pragma unroll
                for (int e = 0; e < 4; ++e) {
                    const int i = 4 * g + e, kvi = kv0 + 8 * g + 4 * hh + e;
                    float s0 = p0[i], s1 = p1[i];
                    if (need_mask) { if (kvi > qrow) s0 = -INFINITY; if (kvi + 32 > qrow) s1 = -INFINITY; }
                    p0[i] = s0; p1[i] = s1; mt = fmaxf(mt, fmaxf(s0, s1));
                }
            }
            mt = fmaxf(mt, __shfl_xor(mt, 32));
            const float m_new = fmaxf(m_run, mt);
            const float alpha = __builtin_amdgcn_exp2f(m_run - m_new);
            m_run = m_new;
            float ps = 0.f;
#pragma unroll
            for (int i = 0; i < 16; ++i) { p0[i] = __builtin_amdgcn_exp2f(p0[i] - m_new); p1[i] = __builtin_amdgcn_exp2f(p1[i] - m_new); ps += p0[i] + p1[i]; }
            l_run = l_run * alpha + ps;
            if (hh == 0) AS[r] = alpha;
            LDS_FENCE();
#pragma unroll
            for (int i = 0; i < 16; ++i) { const float al = AS[crow(i, hh)]; o0[i] *= al; o1[i] *= al; }
            bf16x8 pa[4];
#pragma unroll
            for (int s = 0; s < 2; ++s) {
                u32x4 t0, t1;
#pragma unroll
                for (int e = 0; e < 4; ++e) { t0[e] = pk2(p0[8 * s + 2 * e], p0[8 * s + 2 * e + 1]); t1[e] = pk2(p1[8 * s + 2 * e], p1[8 * s + 2 * e + 1]); }
                pa[s] = __builtin_bit_cast(bf16x8, t0); pa[2 + s] = __builtin_bit_cast(bf16x8, t1);
            }
#pragma unroll
            for (int k4 = 0; k4 < 4; ++k4) {
                const int half = k4 >> 1, s = k4 & 1;
                const bf16* vb0 = Vt + r * LDK + 32 * half + 16 * s + 4 * hh;
                const bf16* vb1 = Vt + (32 + r) * LDK + 32 * half + 16 * s + 4 * hh;
                const s16x4 lo0 = *(const s16x4*)vb0, hi0 = *(const s16x4*)(vb0 + 8);
                const s16x4 lo1 = *(const s16x4*)vb1, hi1 = *(const s16x4*)(vb1 + 8);
                const bf16x8 vf0 = __builtin_shufflevector(lo0, hi0, 0, 1, 2, 3, 4, 5, 6, 7);
                const bf16x8 vf1 = __builtin_shufflevector(lo1, hi1, 0, 1, 2, 3, 4, 5, 6, 7);
                o0 = MFMA32(pa[k4], vf0, o0); o1 = MFMA32(pa[k4], vf1, o1);
            }
            LDS_FENCE();
        }
        __syncthreads();
    }
    const float l_tot = l_run + __shfl_xor(l_run, 32);
    if (hh == 0) AS[r] = 1.0f / l_tot;
    LDS_FENCE();
#pragma unroll
    for (int i = 0; i < 16; ++i) {
        const float inv = AS[crow(i, hh)]; const size_t row = rowbase + q0 + 32 * w + crow(i, hh);
        bf16* op = MIX + row * 1024 + h * 64 + r;
        op[0] = (bf16)(pk2(o0[i] * inv, 0.f) & 0xffffu); op[32] = (bf16)(pk2(o1[i] * inv, 0.f) & 0xffffu);
    }
    __syncthreads();
}


typedef __attribute__((address_space(3))) unsigned char lds_u8;
typedef __attribute__((address_space(3))) float lds_f32;
DI void norm_gate_store(const float* Of, const float* gain, const bf16* gate_row0, size_t gate_pitch, bf16* out_row0, int tid) {
    const int t = tid >> 3, seg = tid & 7;
    const f32x4* op = (const f32x4*)(Of + t * 128 + seg * 16);
    f32x4 o[4]; float ss = 0.f;
#pragma unroll
    for (int q = 0; q < 4; ++q) { o[q] = op[q]; ss += (o[q][0] * o[q][0] + o[q][1] * o[q][1]) + (o[q][2] * o[q][2] + o[q][3] * o[q][3]); }
    ss += __shfl_xor(ss, 1); ss += __shfl_xor(ss, 2); ss += __shfl_xor(ss, 4);
    const float rn = rsqrtf(ss * (1.0f / 128.0f) + EPS);
    const u32x4* gp = (const u32x4*)(gate_row0 + (size_t)t * gate_pitch + seg * 16);
    const u32x4 ga = gp[0], gb = gp[1];
    const f32x4* gn = (const f32x4*)(gain + seg * 16);
    u32x4 w0, w1;
#pragma unroll
    for (int q = 0; q < 4; ++q) {
        const f32x4 g4 = gn[q];
        const unsigned gw0 = q < 2 ? ga[2 * q] : gb[2 * q - 4], gw1 = q < 2 ? ga[2 * q + 1] : gb[2 * q - 3];
        const float y0 = o[q][0] * rn * g4[0] * silu_(bflo(gw0)), y1 = o[q][1] * rn * g4[1] * silu_(bfhi(gw0));
        const float y2 = o[q][2] * rn * g4[2] * silu_(bflo(gw1)), y3 = o[q][3] * rn * g4[3] * silu_(bfhi(gw1));
        if (q < 2) { w0[2 * q] = pk2(y0, y1); w0[2 * q + 1] = pk2(y2, y3); } else { w1[2 * q - 4] = pk2(y0, y1); w1[2 * q - 3] = pk2(y2, y3); }
    }
    u32x4* dst = (u32x4*)(out_row0 + (size_t)t * 1024 + seg * 16);
    dst[0] = w0; dst[1] = w1;
}

#define MFMA16(a, b, c) __builtin_amdgcn_mfma_f32_16x16x32_bf16((a), (b), (c), 0, 0, 0)
constexpr int LDH = 136, LDW = 68;
constexpr int G_QH = 0, G_KH = 17408, G_U = 0, G_VH = 34816, G_WT = 34816, G_A = 52224, G_NW = 68608, G_QD = 84992, G_KD = 101376, G_AI = 117760, G_SM = 125952;
DI bf16 f2bf(float x) { return (bf16)(pk2(x, 0.f) & 0xffffu); }
DI float dpp_xor1(float v) { return __int_as_float(__builtin_amdgcn_update_dpp(0, __float_as_int(v), 0xB1, 0xF, 0xF, true)); }
DI void norm_gate_store_pre(const float* Of, const f32x4 (&gn)[4], u32x4 ga, u32x4 gb, bf16* out_row0, int tid) {
    const int t = tid >> 3, seg = tid & 7;
    const f32x4* op = (const f32x4*)(Of + t * 128 + seg * 16);
    f32x4 o[4]; float ss = 0.f;
#pragma unroll
    for (int q = 0; q < 4; ++q) { o[q] = op[q]; ss += (o[q][0] * o[q][0] + o[q][1] * o[q][1]) + (o[q][2] * o[q][2] + o[q][3] * o[q][3]); }
    ss += __shfl_xor(ss, 1); ss += __shfl_xor(ss, 2); ss += __shfl_xor(ss, 4);
    const float rn = rsqrtf(ss * (1.0f / 128.0f) + EPS);
    u32x4 w0, w1;
#pragma unroll
    for (int q = 0; q < 4; ++q) {
        const f32x4 g4 = gn[q];
        const unsigned gw0 = q < 2 ? ga[2 * q] : gb[2 * q - 4], gw1 = q < 2 ? ga[2 * q + 1] : gb[2 * q - 3];
        const float y0 = o[q][0] * rn * g4[0] * silu_(bflo(gw0)), y1 = o[q][1] * rn * g4[1] * silu_(bfhi(gw0));
        const float y2 = o[q][2] * rn * g4[2] * silu_(bflo(gw1)), y3 = o[q][3] * rn * g4[3] * silu_(bfhi(gw1));
        if (q < 2) { w0[2 * q] = pk2(y0, y1); w0[2 * q + 1] = pk2(y2, y3); } else { w1[2 * q - 4] = pk2(y0, y1); w1[2 * q - 3] = pk2(y2, y3); }
    }
    u32x4* dst = (u32x4*)(out_row0 + (size_t)t * 1024 + seg * 16);
    dst[0] = w0; dst[1] = w1;
}
constexpr int SL_NW = 0, SL_QD = 16384, SL_KD = 32768, SL_AI = 49152, SL_UB = 55296, SL_BYTES = 71680, SL_FIRST = 1872;
DI unsigned char* gdn_slot(unsigned char* ws, int idx) { return idx < SL_FIRST ? ws + WS_XB + (size_t)idx * SL_BYTES : ws + WS_ZH + 240 * MiB + (size_t)(idx - SL_FIRST) * SL_BYTES; }
constexpr size_t WS_EGL = 381 * MiB + 262144;

DI void gdn_prep_unit(const Args& a, int idx, unsigned char* lds, const int wv_) {
    const int ch = idx & 31, h = (idx >> 5) & 3, b = idx >> 7, t0 = ch * 64;
    const bf16* Z = (const bf16*)(a.ws + WS_ZH);
    bf16* QH = (bf16*)(lds + G_QH); bf16* KH = (bf16*)(lds + G_KH); bf16* VH = (bf16*)(lds + G_VH); bf16* WT = (bf16*)(lds + G_WT); float* U = (float*)(lds + G_U); float* Am = (float*)(lds + G_A);
    unsigned char* NW = lds + G_NW; unsigned char* QD = lds + G_QD; unsigned char* KD = lds + G_KD; unsigned char* AI = lds + G_AI;
    float* Gs = (float*)(lds + G_SM); float* BETA = Gs + 64; float* EG = Gs + 128; float* BE = Gs + 192;
    int tl = TIDX(wv_); asm volatile("" : "+v"(tl));
    const int lane = tl & 63, w = tl >> 6, c0 = 2 * lane;
    const float* PAR = (const float*)(a.ws + WS_PAR); const float* convw = PAR + P_CONV;
    const float negA = -__expf(PAR[P_ALOG + h]), dtb = PAR[P_DTB + h];
    float qn[8][2], kn[8][2];
    float cwa[3][4][2];
#pragma unroll
    for (int ten = 0; ten < 3; ++ten)
#pragma unroll
        for (int jj = 0; jj < 4; ++jj) { cwa[ten][jj][0] = convw[jj * 1536 + ten * 512 + h * 128 + c0]; cwa[ten][jj][1] = convw[jj * 1536 + ten * 512 + h * 128 + c0 + 1]; }
#pragma unroll
    for (int ten = 0; ten < 3; ++ten) {
        float cw[4][2];
#pragma unroll
        for (int jj = 0; jj < 4; ++jj) { cw[jj][0] = cwa[ten][jj][0]; cw[jj][1] = cwa[ten][jj][1]; }
        unsigned pre[11];
#pragma unroll
        for (int rr = 0; rr < 11; ++rr) {
            const int t = t0 + 8 * w - 3 + rr; const int tc = t < 0 ? 0 : t;
            const unsigned u = *(const unsigned*)(Z + ((size_t)b * SEQ + tc) * N0 + 1536 + ten * 512 + h * 128 + c0);
            pre[rr] = t < 0 ? 0u : u;
        }
#pragma unroll
        for (int rr = 0; rr < 8; ++rr) {
            float y0 = 0.f, y1 = 0.f;
#pragma unroll
            for (int jj = 0; jj < 4; ++jj) { y0 += cw[jj][0] * bflo(pre[rr + jj]); y1 += cw[jj][1] * bfhi(pre[rr + jj]); }
            y0 = silu_(y0); y1 = silu_(y1);
            const int t = 8 * w + rr;
            if (ten < 2) {
                const float ss = wave_sum(y0 * y0 + y1 * y1); float sc = rsqrtf(ss + EPS);
                if (ten == 0) sc *= 0.08838834764831845f;
                y0 *= sc; y1 *= sc;
                if (ten == 0) { qn[rr][0] = y0; qn[rr][1] = y1; *(unsigned*)(QH + t * LDH + c0) = pk2(y0, y1); }
                else { kn[rr][0] = y0; kn[rr][1] = y1; *(unsigned*)(KH + t * LDH + c0) = pk2(y0, y1); }
            } else {
                *(unsigned*)(VH + t * LDH + c0) = pk2(y0, y1);
            }
        }
    }
    if (w == 0) {
        const size_t m = (size_t)b * SEQ + t0 + lane;
        const float gb = bf2f(Z[m * N0 + 3592 + h]), ga = bf2f(Z[m * N0 + 3596 + h]);
        float la = negA * softplus_(ga + dtb);
#pragma unroll
        for (int o = 1; o < 64; o <<= 1) { const float y = __shfl_up(la, o); if (lane >= o) la += y; }
        const float be = sigmoid_(gb), eg = __expf(la);
        Gs[lane] = la; BETA[lane] = be; EG[lane] = eg; BE[lane] = be * eg;
        if (lane == 63) ((float*)(a.ws + WS_EGL))[idx] = eg;
    }
    __syncthreads();
    {
        const int fr = lane & 15, fq = lane >> 4, tb = w >> 1;
#pragma unroll
        for (int si = 0; si < 2; ++si) {
            const int sb = 2 * (w & 1) + si; f32x4 akk = {0.f, 0.f, 0.f, 0.f}, aqk = {0.f, 0.f, 0.f, 0.f};
#pragma unroll
            for (int kk = 0; kk < 4; ++kk) {
                const bf16x8 kt = *(const bf16x8*)(KH + (16 * tb + fr) * LDH + kk * 32 + fq * 8);
                const bf16x8 qt = *(const bf16x8*)(QH + (16 * tb + fr) * LDH + kk * 32 + fq * 8);
                const bf16x8 ks_ = *(const bf16x8*)(KH + (16 * sb + fr) * LDH + kk * 32 + fq * 8);
                akk = MFMA16(kt, ks_, akk); aqk = MFMA16(qt, ks_, aqk);
            }
#pragma unroll
            for (int jj = 0; jj < 4; ++jj) {
                const int t = 16 * tb + 4 * fq + jj, s2 = 16 * sb + fr;
                const float dec = __expf(fminf(Gs[t] - Gs[s2], 0.f));
                Am[(s2 & 1) * 2048 + t * 32 + (s2 >> 1)] = s2 < t ? BETA[t] * akk[jj] * dec : 0.f;
                const float qkv = s2 <= t ? aqk[jj] * dec : 0.f;
                const int x = s2 & 15, hp = (x >> 2) & 1, j = ((x >> 3) << 2) | (x & 3);
                const int off = ((((t >> 5) * 4 + (s2 >> 4)) * 64) + hp * 32 + (t & 31)) * 16 + j * 2;
                *(bf16*)(AI + off) = f2bf(qkv);
            }
        }
        const float gl = Gs[63];
#pragma unroll
        for (int rr = 0; rr < 8; ++rr) {
            const int t = 8 * w + rr; const float eg = EG[t], ekd = __expf(gl - Gs[t]);
            {
                const int ks = c0 >> 4, x = c0 & 15, hp = (x >> 2) & 1, j = ((x >> 3) << 2) | (x & 3);
                const int off = ((((t >> 5) * 8 + ks) * 64) + hp * 32 + (t & 31)) * 16 + j * 2;
                *(unsigned*)(QD + off) = pk2(qn[rr][0] * eg, qn[rr][1] * eg);
            }
#pragma unroll
            for (int e = 0; e < 2; ++e) {
                const int dk = c0 + e, x = t & 15, hp = (x >> 2) & 1, j = ((x >> 3) << 2) | (x & 3);
                const int off = ((((dk >> 5) * 4 + (t >> 4)) * 64) + hp * 32 + (dk & 31)) * 16 + j * 2;
                *(bf16*)(KD + off) = f2bf(kn[rr][e] * ekd);
            }
        }
    }
    __syncthreads();
    unsigned char* slot = gdn_slot(a.ws, idx);
    {
#pragma unroll
        for (int k2 = 0; k2 < 2; ++k2) {
            const int q = tl + 512 * k2;
            *(u32x4*)(slot + SL_QD + q * 16) = *(const u32x4*)(QD + q * 16);
            *(u32x4*)(slot + SL_KD + q * 16) = *(const u32x4*)(KD + q * 16);
        }
        if (tl < 384) { const int src_off = tl < 128 ? tl * 16 : 4096 + (tl - 128) * 16; *(u32x4*)(slot + SL_AI + tl * 16) = *(const u32x4*)(AI + src_off); }
    }
    {
        const int c = tl >> 1, p = tl & 1;
        const float* Ap = Am + p * 2048;
        const float* scl = c < 128 ? BETA : BE;
        const bf16* src = c < 128 ? VH + c : KH + (c - 128);
        float xm[32];
#pragma unroll
        for (int i = 0; i < 32; ++i) xm[i] = 0.f;
        f32x4 ab[2][8]; float rh[2];
        rh[0] = scl[0] * bf2f(src[0]);
#pragma unroll
        for (int t = 0; t < 64; ++t) {
            if (t + 1 < 64) {
#pragma unroll
                for (int i4 = 0; i4 < (((t + 2) / 2) + 3) / 4; ++i4) ab[(t + 1) & 1][i4] = *(const f32x4*)(Ap + (t + 1) * 32 + 4 * i4);
                rh[(t + 1) & 1] = scl[t + 1] * bf2f(src[(t + 1) * LDH]);
            }
            __builtin_amdgcn_sched_barrier(0);
            float acc0 = 0.f, acc1 = 0.f;
#pragma unroll
            for (int i4 = 0; i4 < (((t + 1) / 2) + 3) / 4; ++i4) {
                const f32x4 a4 = ab[t & 1][i4];
                acc0 += a4[0] * xm[4 * i4];
                if (2 * (4 * i4 + 1) < t) acc1 += a4[1] * xm[4 * i4 + 1];
                if (2 * (4 * i4 + 2) < t) acc0 += a4[2] * xm[4 * i4 + 2];
                if (2 * (4 * i4 + 3) < t) acc1 += a4[3] * xm[4 * i4 + 3];
            }
            const float part = acc0 + acc1;
            const float xt = rh[t & 1] - (part + dpp_xor1(part));
            xm[t >> 1] = (p == (t & 1)) ? xt : xm[t >> 1];
            __builtin_amdgcn_sched_barrier(0);
        }
        __syncthreads();
        if (c < 128) {
#pragma unroll
            for (int i = 0; i < 32; ++i) U[(2 * i + p) * 128 + c] = xm[i];
        } else {
            const int dk = c - 128;
#pragma unroll
            for (int i = 0; i < 32; ++i) {
                const float other = dpp_xor1(xm[i]);
                const float lo = p ? other : xm[i], hi = p ? xm[i] : other;
                if ((i & 1) == 0) { if (p == 0) *(unsigned*)(WT + dk * LDW + 2 * i) = pk2(-lo, -hi); }
                else { if (p == 1) *(unsigned*)(WT + dk * LDW + 2 * i) = pk2(-lo, -hi); }
            }
        }
    }
    __syncthreads();
#pragma unroll
    for (int k2 = 0; k2 < 2; ++k2) {
        const int q = tl + 512 * k2, f = q >> 6, lp = q & 63, hp = lp >> 5, rp = lp & 31;
        const int t = 32 * (f >> 3) + rp, dkb = 16 * (f & 7) + 4 * hp;
        u32x4 o;
        o[0] = (unsigned)WT[(dkb + 0) * LDW + t] | ((unsigned)WT[(dkb + 1) * LDW + t] << 16);
        o[1] = (unsigned)WT[(dkb + 2) * LDW + t] | ((unsigned)WT[(dkb + 3) * LDW + t] << 16);
        o[2] = (unsigned)WT[(dkb + 8) * LDW + t] | ((unsigned)WT[(dkb + 9) * LDW + t] << 16);
        o[3] = (unsigned)WT[(dkb + 10) * LDW + t] | ((unsigned)WT[(dkb + 11) * LDW + t] << 16);
        *(u32x4*)(slot + SL_NW + q * 16) = o;
    }
    {
        const int dq = tl >> 7, tt = (tl >> 6) & 1, lp = tl & 63, hp = lp >> 5, rp = lp & 31;
        const float* ub = U + (32 * tt + 4 * hp) * 128 + 32 * dq + rp;
        u32x4 o0, o1;
#pragma unroll
        for (int e = 0; e < 4; ++e) {
            const int i0 = 2 * e, i1 = 2 * e + 1, i2 = 8 + 2 * e, i3 = 9 + 2 * e;
            o0[e] = pk2(ub[((i0 & 3) + 8 * (i0 >> 2)) * 128], ub[((i1 & 3) + 8 * (i1 >> 2)) * 128]);
            o1[e] = pk2(ub[((i2 & 3) + 8 * (i2 >> 2)) * 128], ub[((i3 & 3) + 8 * (i3 >> 2)) * 128]);
        }
        u32x4* dst = (u32x4*)(slot + SL_UB + tl * 32);
        dst[0] = o0; dst[1] = o1;
    }
    __syncthreads();
}

DI void gdn_scan_unit(const Args& a, int bh, unsigned char* lds, const int wv_) {
    const bf16* Z = (const bf16*)(a.ws + WS_ZH); bf16* MIX = (bf16*)(a.ws + WS_MIX);
    const float* PAR = (const float*)(a.ws + WS_PAR); const float* EGL = (const float*)(a.ws + WS_EGL);
    const int b = bh >> 2, h = bh & 3;
    int tid = TIDX(wv_); asm volatile("" : "+v"(tid));
    f32x16 S[4];
#pragma unroll
    for (int kb = 0; kb < 4; ++kb)
#pragma unroll
        for (int i = 0; i < 16; ++i) S[kb][i] = 0.f;
    {
        const unsigned char* sl = gdn_slot(a.ws, bh * 32);
        for (int q = tid; q < SL_BYTES / 16; q += 512) *(u32x4*)(lds + q * 16) = *(const u32x4*)(sl + q * 16);
    }
    __syncthreads();
    u32x4 gate_na, gate_nb; float egl_n;
    {
        const u32x4* gp0 = (const u32x4*)(Z + ((size_t)b * SEQ + (tid >> 3)) * N0 + 3072 + h * 128 + (tid & 7) * 16);
        gate_na = gp0[0]; gate_nb = gp0[1]; egl_n = EGL[bh * 32];
    }
#pragma unroll 1
    for (int ch = 0; ch < 32; ++ch) {
        int tl = tid; asm volatile("" : "+v"(tl));
        const int lane = tl & 63, w = tl >> 6, r = lane & 31, hh = lane >> 5, dq = w & 3;
        const int idx = bh * 32 + ch;
        const unsigned cur = (ch & 1) * SL_BYTES, nxt = ((ch + 1) & 1) * SL_BYTES;
        const u32x4 gate_a = gate_na, gate_b = gate_nb; const float egl = egl_n;
        f32x4 gng[4];
#pragma unroll
        for (int q = 0; q < 4; ++q) gng[q] = *(const f32x4*)(PAR + P_GON + (tl & 7) * 16 + 4 * q);
        f32x16 O0, O1;
        if (w >= 4) {
            if (ch < 31) {
                const unsigned char* sl = gdn_slot(a.ws, idx + 1) + (tl - 256) * 16;
                unsigned char* dl = lds + nxt + (tl - 256) * 16;
#pragma unroll
                for (int k0 = 0; k0 < 18; k0 += 6) {
                    u32x4 stage[6];
#pragma unroll
                    for (int k = 0; k < 6; ++k) { if (k0 + k < 17 || tl - 256 < 128) stage[k] = *(const u32x4*)(sl + (k0 + k) * 4096); }
#pragma unroll
                    for (int k = 0; k < 6; ++k) { if (k0 + k < 17 || tl - 256 < 128) *(u32x4*)(dl + (k0 + k) * 4096) = stage[k]; }
                }
            }
        } else {
            lds_u8* l3 = (lds_u8*)lds;
            unsigned fo = cur + lane * 16; asm volatile("" : "+v"(fo)); const lds_u8* fp = l3 + fo;
#define LFRAG(o_) (*(const __attribute__((address_space(3))) bf16x8*)(fp + (o_)))
            bf16x8 xs[8];
#pragma unroll
            for (int kb = 0; kb < 4; ++kb)
#pragma unroll
                for (int s2 = 0; s2 < 2; ++s2) {
                    u32x4 t4;
#pragma unroll
                    for (int e = 0; e < 4; ++e) t4[e] = pk2(S[kb][8 * s2 + 2 * e], S[kb][8 * s2 + 2 * e + 1]);
                    xs[2 * kb + s2] = __builtin_bit_cast(bf16x8, t4);
                }
            f32x16 V0, V1;
            {
                const __attribute__((address_space(3))) u32x4* up = (const __attribute__((address_space(3))) u32x4*)(l3 + cur + SL_UB + ((dq * 2) * 64 + lane) * 32);
                const u32x4 a0 = up[0], a1 = up[1], b0 = up[128], b1 = up[129];
#pragma unroll
                for (int e = 0; e < 4; ++e) {
                    V0[2 * e] = bflo(a0[e]); V0[2 * e + 1] = bfhi(a0[e]); V0[8 + 2 * e] = bflo(a1[e]); V0[9 + 2 * e] = bfhi(a1[e]);
                    V1[2 * e] = bflo(b0[e]); V1[2 * e + 1] = bfhi(b0[e]); V1[8 + 2 * e] = bflo(b1[e]); V1[9 + 2 * e] = bfhi(b1[e]);
                }
            }
#pragma unroll
            for (int i = 0; i < 16; ++i) { O0[i] = 0.f; O1[i] = 0.f; }
#pragma unroll
            for (int ks = 0; ks < 8; ++ks) {
                V0 = MFMA32(LFRAG(SL_NW + (0 * 8 + ks) * 1024), xs[ks], V0);
                V1 = MFMA32(LFRAG(SL_NW + (1 * 8 + ks) * 1024), xs[ks], V1);
                O0 = MFMA32(LFRAG(SL_QD + (0 * 8 + ks) * 1024), xs[ks], O0);
                O1 = MFMA32(LFRAG(SL_QD + (1 * 8 + ks) * 1024), xs[ks], O1);
            }
            bf16x8 vx[4];
#pragma unroll
            for (int s2 = 0; s2 < 2; ++s2) {
                u32x4 t4, t5;
#pragma unroll
                for (int e = 0; e < 4; ++e) { t4[e] = pk2(V0[8 * s2 + 2 * e], V0[8 * s2 + 2 * e + 1]); t5[e] = pk2(V1[8 * s2 + 2 * e], V1[8 * s2 + 2 * e + 1]); }
                vx[s2] = __builtin_bit_cast(bf16x8, t4); vx[2 + s2] = __builtin_bit_cast(bf16x8, t5);
            }
#pragma unroll
            for (int ks = 0; ks < 2; ++ks) O0 = MFMA32(LFRAG(SL_AI + ks * 1024), vx[ks], O0);
#pragma unroll
            for (int ks = 0; ks < 4; ++ks) O1 = MFMA32(LFRAG(SL_AI + 2048 + ks * 1024), vx[ks], O1);
#pragma unroll
            for (int kb = 0; kb < 4; ++kb) {
#pragma unroll
                for (int i = 0; i < 16; ++i) S[kb][i] *= egl;
#pragma unroll
                for (int ks = 0; ks < 4; ++ks) S[kb] = MFMA32(LFRAG(SL_KD + (kb * 4 + ks) * 1024), vx[ks], S[kb]);
            }
#undef LFRAG
        }
        __syncthreads();
        if (w < 4) {
            unsigned obo = cur + ((4 * hh) * 128 + 32 * dq + r) * 4; asm volatile("" : "+v"(obo)); lds_f32* ob = (lds_f32*)((lds_u8*)lds + obo);
#pragma unroll
            for (int i = 0; i < 16; ++i) { ob[((i & 3) + 8 * (i >> 2)) * 128] = O0[i]; ob[(32 + (i & 3) + 8 * (i >> 2)) * 128] = O1[i]; }
        }
        __syncthreads();
        {
            const int cn = ch < 31 ? ch + 1 : ch;
            const u32x4* gpn = (const u32x4*)(Z + ((size_t)b * SEQ + cn * 64 + (tl >> 3)) * N0 + 3072 + h * 128 + (tl & 7) * 16);
            gate_na = gpn[0]; gate_nb = gpn[1]; egl_n = EGL[bh * 32 + cn];
        }
        norm_gate_store_pre((const float*)(lds + cur), gng, gate_a, gate_b, MIX + ((size_t)b * SEQ + ch * 64) * 1024 + 512 + h * 128, tl);
        __syncthreads();
    }
}

constexpr int L_QD = 0, L_KD = 16384, L_AI = 32768, L_VF = 40960, L_DEC = 57344, L_BF = 57856, L_QH = 90624, L_KH = 108032;
DI void hgrn_unit(const Args& a, int b, int h, unsigned char* lds, const int wv_) {
    const bf16* Z = (const bf16*)(a.ws + WS_ZH); bf16* MIX = (bf16*)(a.ws + WS_MIX);
    unsigned char* QD = lds + L_QD; unsigned char* KD = lds + L_KD; unsigned char* AI = lds + L_AI; unsigned char* VF = lds + L_VF;
    float* DEC = (float*)(lds + L_DEC); float* Bf = (float*)(lds + L_BF); bf16* QH = (bf16*)(lds + L_QH); bf16* KH = (bf16*)(lds + L_KH);
    float* TOT = (float*)(lds + L_KH + 17408);
    int tid = TIDX(wv_); asm volatile("" : "+v"(tid));
    const float* PAR = (const float*)(a.ws + WS_PAR); const float* lbl = PAR + P_LB;
    f32x16 S[4];
#pragma unroll
    for (int kb = 0; kb < 4; ++kb)
#pragma unroll
        for (int i = 0; i < 16; ++i) S[kb][i] = 0.f;
    unsigned pq[8], pf[8], pi[8];
    float lb0, lb1;
    {
        const int lane = tid & 63, w = tid >> 6, cg0 = h * 128 + 2 * lane;
        lb0 = 1.0f / (1.0f + __expf(lbl[cg0] - lbl[1024 + cg0])); lb1 = 1.0f / (1.0f + __expf(lbl[cg0 + 1] - lbl[1024 + cg0 + 1]));
#pragma unroll
        for (int rr = 0; rr < 8; ++rr) {
            const bf16* zp = Z + ((size_t)b * SEQ + 8 * w + rr) * 4096 + cg0;
            pq[rr] = *(const unsigned*)zp; pf[rr] = *(const unsigned*)(zp + 1024); pi[rr] = *(const unsigned*)(zp + 2048);
        }
    }
#pragma unroll 1
    for (int ch = 0; ch < 32; ++ch) {
        const int t0 = ch * 64;
        int tl = tid; asm volatile("" : "+v"(tl));
        const int lane = tl & 63, w = tl >> 6, r = lane & 31, hh = lane >> 5, c0 = 2 * lane, cg0 = h * 128 + c0;
        float qv[8][2], kv[8][2], Bl[8][2];
        {
            float run0 = 0.f, run1 = 0.f;
#pragma unroll
            for (int rr = 0; rr < 8; ++rr) {
                const int t = 8 * w + rr;
                const unsigned uq = pq[rr], uf = pf[rr], ui = pi[rr];
                qv[rr][0] = silu_(bflo(uq)); qv[rr][1] = silu_(bfhi(uq));
                const float f0 = lb0 + (1.f - lb0) * sigmoid_(bflo(uf)), f1 = lb1 + (1.f - lb1) * sigmoid_(bfhi(uf));
                kv[rr][0] = 1.f - f0; kv[rr][1] = 1.f - f1;
                run0 += __logf(f0); run1 += __logf(f1);
                Bl[rr][0] = run0; Bl[rr][1] = run1;
#pragma unroll
                for (int e = 0; e < 2; ++e) {
                    const int dv = c0 + e; const int off = ((((dv >> 5) * 4 + (t >> 4)) * 64) + ((t >> 3) & 1) * 32 + (dv & 31)) * 16 + (t & 7) * 2;
                    *(bf16*)(VF + off) = (bf16)(e ? (ui >> 16) : (ui & 0xffffu));
                }
            }
            TOT[w * 128 + c0] = run0; TOT[w * 128 + c0 + 1] = run1;
        }
        {
            const int tn = (ch < 31 ? t0 + 64 : t0);
#pragma unroll
            for (int rr = 0; rr < 8; ++rr) {
                const bf16* zp = Z + ((size_t)b * SEQ + tn + 8 * w + rr) * 4096 + cg0;
                pq[rr] = *(const unsigned*)zp; pf[rr] = *(const unsigned*)(zp + 1024); pi[rr] = *(const unsigned*)(zp + 2048);
            }
        }
        const u32x4* gatep = (const u32x4*)(Z + ((size_t)b * SEQ + t0 + (tl >> 3)) * 4096 + 3072 + h * 128 + (tl & 7) * 16);
        const u32x4 gate_a = gatep[0], gate_b = gatep[1];

        __syncthreads();
        {
            float off0 = 0.f, off1 = 0.f, bm0 = 0.f, bm1 = 0.f, bl0 = 0.f, bl1 = 0.f;
#pragma unroll
            for (int ww = 0; ww < 8; ++ww) {
                const float t0v = TOT[ww * 128 + c0], t1v = TOT[ww * 128 + c0 + 1];
                if (ww < w) { off0 += t0v; off1 += t1v; }
                if (ww < 4) { bm0 += t0v; bm1 += t1v; }
                bl0 += t0v; bl1 += t1v;
            }
            if (w == 0) { DEC[c0] = __expf(bl0); DEC[c0 + 1] = __expf(bl1); }
#pragma unroll
            for (int rr = 0; rr < 8; ++rr) {
                const int t = 8 * w + rr;
                const float B0 = Bl[rr][0] + off0, B1 = Bl[rr][1] + off1;
                const float qd0 = qv[rr][0] * __expf(B0), qd1 = qv[rr][1] * __expf(B1);
                const float qh0 = qv[rr][0] * __expf(fminf(B0 - bm0, 80.f)), qh1 = qv[rr][1] * __expf(fminf(B1 - bm1, 80.f));
                const float kh0 = kv[rr][0] * __expf(fminf(bm0 - B0, 80.f)), kh1 = kv[rr][1] * __expf(fminf(bm1 - B1, 80.f));
                const float kd0 = kv[rr][0] * __expf(bl0 - B0), kd1 = kv[rr][1] * __expf(bl1 - B1);
                {
                    const int ks = c0 >> 4, x = c0 & 15, hp = (x >> 2) & 1, j = ((x >> 3) << 2) | (x & 3);
                    const int off = ((((t >> 5) * 8 + ks) * 64) + hp * 32 + (t & 31)) * 16 + j * 2;
                    *(unsigned*)(QD + off) = pk2(qd0, qd1);
                }
#pragma unroll
                for (int e = 0; e < 2; ++e) {
                    const int dk = c0 + e; const int off = ((((dk >> 5) * 4 + (t >> 4)) * 64) + ((t >> 3) & 1) * 32 + (dk & 31)) * 16 + (t & 7) * 2;
                    *(bf16*)(KD + off) = f2bf(e ? kd1 : kd0);
                }
                *(unsigned*)(QH + t * LDH + c0) = pk2(qh0, qh1);
                *(unsigned*)(KH + t * LDH + c0) = pk2(kh0, kh1);
            }
        }
        __syncthreads();
        {
            const int fr = lane & 15, fq = lane >> 4, tb = w >> 1;
#pragma unroll
            for (int si = 0; si < 2; ++si) {
                const int sb = 2 * (w & 1) + si; f32x4 acc = {0.f, 0.f, 0.f, 0.f};
#pragma unroll
                for (int kk = 0; kk < 4; ++kk) {
                    const bf16x8 av = *(const bf16x8*)(QH + (16 * tb + fr) * LDH + kk * 32 + fq * 8);
                    const bf16x8 bv = *(const bf16x8*)(KH + (16 * sb + fr) * LDH + kk * 32 + fq * 8);
                    acc = MFMA16(av, bv, acc);
                }
#pragma unroll
                for (int jj = 0; jj < 4; ++jj) {
                    const int t = 16 * tb + 4 * fq + jj, s2 = 16 * sb + fr;
                    const float val = s2 <= t ? acc[jj] : 0.f;
                    const int off = ((((t >> 5) * 4 + (s2 >> 4)) * 64) + ((s2 >> 3) & 1) * 32 + (t & 31)) * 16 + (s2 & 7) * 2;
                    *(bf16*)(AI + off) = f2bf(val);
                }
            }
        }
        __syncthreads();
        if (w < 4) {
            const int dq = w;
            bf16x8 xs[8];
#pragma unroll
            for (int kb = 0; kb < 4; ++kb)
#pragma unroll
                for (int s2 = 0; s2 < 2; ++s2) {
                    u32x4 t4;
#pragma unroll
                    for (int e = 0; e < 4; ++e) t4[e] = pk2(S[kb][8 * s2 + 2 * e], S[kb][8 * s2 + 2 * e + 1]);
                    xs[2 * kb + s2] = __builtin_bit_cast(bf16x8, t4);
                }
            f32x16 O0, O1;
            unsigned obo = L_BF + ((4 * hh) * 128 + 32 * dq + r) * 4; asm volatile("" : "+v"(obo)); lds_f32* ob = (lds_f32*)((lds_u8*)lds + obo);
#pragma unroll
            for (int i = 0; i < 16; ++i) { O0[i] = 0.f; O1[i] = 0.f; }
            lds_u8* l3 = (lds_u8*)lds; unsigned fo = lane * 16; asm volatile("" : "+v"(fo)); const lds_u8* fp = l3 + fo;
#define HF(o_) (*(const __attribute__((address_space(3))) bf16x8*)(fp + (o_)))
#define SB() __builtin_amdgcn_sched_barrier(0)
            bf16x8 ga[8], gb[8];
#pragma unroll
            for (int k = 0; k < 4; ++k) { ga[k] = HF(L_QD + (0 * 8 + k) * 1024); ga[4 + k] = HF(L_QD + (1 * 8 + k) * 1024); }
#pragma unroll
            for (int k = 0; k < 4; ++k) { gb[k] = HF(L_QD + (0 * 8 + 4 + k) * 1024); gb[4 + k] = HF(L_QD + (1 * 8 + 4 + k) * 1024); }
            SB();
#pragma unroll
            for (int k = 0; k < 4; ++k) { O0 = MFMA32(ga[k], xs[k], O0); O1 = MFMA32(ga[4 + k], xs[k], O1); }
            SB();
#pragma unroll
            for (int k = 0; k < 4; ++k) ga[k] = HF(L_VF + (dq * 4 + k) * 1024);
            ga[4] = HF(L_AI + (0 * 4 + 0) * 1024); ga[5] = HF(L_AI + (0 * 4 + 1) * 1024); ga[6] = HF(L_AI + (1 * 4 + 0) * 1024); ga[7] = HF(L_AI + (1 * 4 + 1) * 1024);
            SB();
#pragma unroll
            for (int k = 0; k < 4; ++k) { O0 = MFMA32(gb[k], xs[4 + k], O0); O1 = MFMA32(gb[4 + k], xs[4 + k], O1); }
            SB();
            gb[0] = HF(L_AI + (1 * 4 + 2) * 1024); gb[1] = HF(L_AI + (1 * 4 + 3) * 1024);
#pragma unroll
            for (int k = 0; k < 4; ++k) gb[2 + k] = HF(L_KD + (0 * 4 + k) * 1024);
            f32x4 dd[4];
#define LDD(kb_) do { _Pragma("unroll") for (int g = 0; g < 4; ++g) dd[g] = *(const f32x4*)(DEC + 32 * (kb_) + 8 * g + 4 * hh); } while (0)
#define MULD(kb_) do { _Pragma("unroll") for (int g = 0; g < 4; ++g) _Pragma("unroll") for (int e = 0; e < 4; ++e) S[kb_][4 * g + e] *= dd[g][e]; } while (0)
            LDD(0);
            SB();
            const bf16x8 vf0 = ga[0], vf1 = ga[1], vf2 = ga[2], vf3 = ga[3];
            O0 = MFMA32(ga[4], vf0, O0); O0 = MFMA32(ga[5], vf1, O0); O1 = MFMA32(ga[6], vf0, O1); O1 = MFMA32(ga[7], vf1, O1);
            SB();
#pragma unroll
            for (int k = 0; k < 4; ++k) ga[4 + k] = HF(L_KD + (1 * 4 + k) * 1024);
            SB();
            O1 = MFMA32(gb[0], vf2, O1); O1 = MFMA32(gb[1], vf3, O1);
            MULD(0);
            S[0] = MFMA32(gb[2], vf0, S[0]); S[0] = MFMA32(gb[3], vf1, S[0]); S[0] = MFMA32(gb[4], vf2, S[0]); S[0] = MFMA32(gb[5], vf3, S[0]);
            SB();
            LDD(1);
#pragma unroll
            for (int k = 0; k < 4; ++k) gb[k] = HF(L_KD + (2 * 4 + k) * 1024);
            SB();
            MULD(1);
            S[1] = MFMA32(ga[4], vf0, S[1]); S[1] = MFMA32(ga[5], vf1, S[1]); S[1] = MFMA32(ga[6], vf2, S[1]); S[1] = MFMA32(ga[7], vf3, S[1]);
            SB();
            LDD(2);
#pragma unroll
            for (int k = 0; k < 4; ++k) ga[4 + k] = HF(L_KD + (3 * 4 + k) * 1024);
            SB();
            MULD(2);
            S[2] = MFMA32(gb[0], vf0, S[2]); S[2] = MFMA32(gb[1], vf1, S[2]); S[2] = MFMA32(gb[2], vf2, S[2]); S[2] = MFMA32(gb[3], vf3, S[2]);
            SB();
            LDD(3);
            SB();
            MULD(3);
            S[3] = MFMA32(ga[4], vf0, S[3]); S[3] = MFMA32(ga[5], vf1, S[3]); S[3] = MFMA32(ga[6], vf2, S[3]); S[3] = MFMA32(ga[7], vf3, S[3]);
#undef LDD
#undef MULD
#undef HF
#undef SB
#pragma unroll
            for (int i = 0; i < 16; ++i) { ob[((i & 3) + 8 * (i >> 2)) * 128] = O0[i]; ob[(32 + (i & 3) + 8 * (i >> 2)) * 128] = O1[i]; }
        }
        f32x4 gnh[4];
#pragma unroll
        for (int q = 0; q < 4; ++q) gnh[q] = *(const f32x4*)(PAR + P_HON + (tl & 7) * 16 + 4 * q);
        __syncthreads();
        norm_gate_store_pre(Bf, gnh, gate_a, gate_b, MIX + ((size_t)b * SEQ + t0) * 1024 + h * 128, tl);
    }
    __syncthreads();
}

#define LAS __attribute__((address_space(3)))
#define XB_TMO      128
#define XB_XCNT(j)  (256  + 64 * (j))
#define XB_XSUB(j)  (1280 + 64 * (j))
#define XB_XGEN(j)  (2304 + 64 * (j))
#define XB_TOP      3328
#define XB_TOPGEN   3392
#define XCD_BAR_WORDS 3456
#define XB_SPIN_CAP (1u << 18)

__device__ __forceinline__ unsigned xb_ld(unsigned* p)              { return __hip_atomic_load(p, __ATOMIC_RELAXED, __HIP_MEMORY_SCOPE_AGENT); }
__device__ __forceinline__ unsigned xb_add(unsigned* p, unsigned v) { return __hip_atomic_fetch_add(p, v, __ATOMIC_RELAXED, __HIP_MEMORY_SCOPE_AGENT); }
__device__ __forceinline__ unsigned xb_xcc_id() { return (unsigned)__builtin_amdgcn_s_getreg((3 << 11) | 20) & 0xFu; }
#define XB_SPIN(cond, bar) do { unsigned _sp = 0; while (cond) { __builtin_amdgcn_s_sleep(1); \
    if ((++_sp & 255u) == 0u) { if (xb_ld(&(bar)[XB_TMO])) break; if (_sp > XB_SPIN_CAP) { atomicAdd(&(bar)[XB_TMO], 1u); break; } } } } while (0)

struct XcdBarrier {
    unsigned* bar; unsigned x;
    volatile LAS unsigned* st;
};

__device__ __forceinline__ XcdBarrier xcd_barrier_post(unsigned* bar, volatile LAS unsigned* st, const bool t0_) {
    XcdBarrier b; b.bar = bar; b.x = xb_xcc_id(); b.st = st;
    if (t0_) (void)xb_add(&bar[XB_XCNT(b.x)], 1u);
    return b;
}
__device__ __forceinline__ void xcd_barrier_complete(unsigned* bar, unsigned x, unsigned& nloc, unsigned& nx) {
    const unsigned G = gridDim.x * gridDim.y * gridDim.z;
    unsigned sum, cnt, mine, sp = 0u;
    for (;;) {
        sum = 0u; cnt = 0u; mine = 0u;
#pragma unroll
        for (unsigned j = 0; j < 16; ++j) { const unsigned c = xb_ld(&bar[XB_XCNT(j)]); sum += c; cnt += (c > 0u) ? 1u : 0u; mine = (j == x) ? c : mine; }
        if (sum == G) break;
        __builtin_amdgcn_s_sleep(1);
        if ((++sp & 255u) == 0u) { if (xb_ld(&bar[XB_TMO])) break; if (sp > XB_SPIN_CAP) { atomicAdd(&bar[XB_TMO], 1u); break; } }
    }
    nloc = mine > 0u ? mine : 1u; nx = cnt > 0u ? cnt : 1u;
}

__device__ __forceinline__ void xcd_barrier(const XcdBarrier& b, const bool t0_) {
    asm volatile("s_waitcnt vmcnt(0)" ::: "memory");
    __syncthreads();
    if (t0_) {
        unsigned* bar = b.bar;
        __builtin_amdgcn_s_waitcnt(0);
        unsigned nloc = b.st[0], nx = b.st[1];
        if (nloc == 0u) { xcd_barrier_complete(bar, b.x, nloc, nx); b.st[0] = nloc; b.st[1] = nx; }
        const unsigned old = xb_add(&bar[XB_XSUB(b.x)], 1u);
        const unsigned gen = old / nloc;
        if (old + 1u == (gen + 1u) * nloc) {
            __builtin_amdgcn_fence(__ATOMIC_RELEASE, "agent");
            asm volatile("s_waitcnt vmcnt(0)" ::: "memory");
            const unsigned og = xb_add(&bar[XB_TOP], 1u);
            const unsigned tg = og / nx;
            if (og + 1u == (tg + 1u) * nx) xb_add(&bar[XB_TOPGEN], 1u);
            else XB_SPIN(xb_ld(&bar[XB_TOPGEN]) == tg, bar);
            __builtin_amdgcn_fence(__ATOMIC_ACQUIRE, "agent");
            xb_add(&bar[XB_XGEN(b.x)], 1u);
            asm volatile("s_waitcnt vmcnt(0)" ::: "memory");
        } else {
            XB_SPIN(xb_ld(&bar[XB_XGEN(b.x)]) == gen, bar);
            __builtin_amdgcn_fence(__ATOMIC_ACQUIRE, "agent");
            asm volatile("s_waitcnt vmcnt(0)" ::: "memory");
        }
    }
    __syncthreads();
}

__global__ void __launch_bounds__(512, 2) trunk_fwd(Args a) {
    extern __shared__ __attribute__((aligned(16))) unsigned char lds[];
    __builtin_assume(__builtin_amdgcn_workitem_id_y() == 0); __builtin_assume(__builtin_amdgcn_workitem_id_z() == 0);
    cg::grid_group grid = cg::this_grid();
    const int G = gridDim.x, blk = blockIdx.x;
    unsigned char* ws = a.ws;
    PG8_LAS unsigned char* lds3 = (PG8_LAS unsigned char*)lds;
    bf16* XB = (bf16*)(ws + WS_XB); bf16* MIX = (bf16*)(ws + WS_MIX); bf16* ZH = (bf16*)(ws + WS_ZH); float* SS = (float*)(ws + WS_SS);

    volatile LAS unsigned* bst = (volatile LAS unsigned*)((LAS unsigned char*)lds + (LDS_BYTES - 64));
    const int WV = __builtin_amdgcn_readfirstlane((int)(threadIdx.x >> 6));
    if (WV == 0 && lane_id_() == 0) { bst[0] = 0u; bst[1] = 0u; }
    __syncthreads();
    (void)xcd_barrier_post((unsigned*)(ws + WS_BAR), bst, WV == 0 && lane_id_() == 0);
#define GRID_BAR() do { unsigned char* wsl_ = a.ws; asm volatile("" : "+s"(wsl_)); XcdBarrier xb_; xb_.bar = (unsigned*)(wsl_ + WS_BAR); xb_.x = xb_xcc_id(); xb_.st = (volatile LAS unsigned*)((LAS unsigned char*)lds + (LDS_BYTES - 64)); xcd_barrier(xb_, WV == 0 && lane_id_() == 0); } while (0)
    p0_prologue(a, lds, WV);
    if (a.ws == nullptr) grid.sync();
    GRID_BAR();
    _Pragma("unroll") for (int layer = 0; layer < 2; ++layer) {
        const int NIN = layer == 0 ? N0 : 4096;
        if (layer == 0) {
            pg8::Gemm g{XB, (const bf16*)(ws + WS_W0IN), M, N0, 1024}; int blkl = blk; asm volatile("" : "+s"(blkl)); pg8::StaticOrder S; S.init(M, N0, G, blkl, WGM_WIDE);
            rs_table_build<true>(lds, SS, S, WV);
            EpiAct<2> E{ZH, N0, (const float*)(ws + WS_PAR), (const lds_f32_t*)((PG8_LAS unsigned char*)lds + RS_OFF), 0};
            pg8::gemm_phase<EpiAct<2>, pg8::StaticOrder, true, true>(lds3, g, S, E, WV);
        } else {
            pg8::Gemm g{XB, (const bf16*)(ws + WS_W1IN), M, 4096, 1024}; int blkl = blk; asm volatile("" : "+s"(blkl)); pg8::StaticOrder S; S.init(M, 4096, G, blkl, WGM_WIDE);
            rs_table_build<false>(lds, SS + (size_t)2 * SS_STRIDE, S, WV);
            EpiAct<0> E{ZH, 4096, nullptr, (const lds_f32_t*)((PG8_LAS unsigned char*)lds + RS_OFF), 0};
            pg8::gemm_phase<EpiAct<0>, pg8::StaticOrder, true, true>(lds3, g, S, E, WV);
        }
        GRID_BAR();
        if (layer == 0) {
            fox_prep(a, WV);
            for (int u = blk; u < 2048; u += G) gdn_prep_unit(a, u, lds, WV);
            GRID_BAR();
            const float* C2g = (const float*)(ws + WS_C2);
            int Gl = G; asm volatile("" : "+s"(Gl));
            const bool bal = (Gl == 256); const int sstride = bal ? 64 : Gl;
            if (blk < sstride) for (int u = blk; u < 64; u += sstride) gdn_scan_unit(a, u, lds, WV);
            const int nk = bal ? 4 : (1024 + Gl - 1) / Gl;
#pragma unroll 1
            for (int k = 0; k < nk; ++k) {
                const int i = blk - 64;
                const int u = bal ? (blk < 64 ? 768 + 64 * k + blk : 192 * k + ((k & 1) ? 191 - i : i)) : blk + Gl * k;
                if (u < 1024) { const int qb = 7 - (u >> 7), bh = u & 127; fox_unit(ZH, C2g, MIX, bh >> 3, bh & 7, qb, lds, WV); }
            }
        } else {
            for (int u = blk; u < 128; u += G) hgrn_unit(a, u >> 3, u & 7, lds, WV);
        }
        GRID_BAR();
        if (layer == 0) {
            pg8::Gemm g{MIX, (const bf16*)(ws + WS_W0OUT), M, 1024, 1024}; int blkl = blk; asm volatile("" : "+s"(blkl)); pg8::StaticOrder S; S.init(M, 1024, G, blkl);
            EpiRes<false, false> E{a.in[0], nullptr, XB, SS + (size_t)1 * SS_STRIDE};
            pg8::gemm_phase<EpiRes<false, false>, pg8::StaticOrder, true, true>(lds3, g, S, E, WV);
        } else {
            pg8::Gemm g{MIX, (const bf16*)(ws + WS_W1OUT), M, 1024, 1024}; int blkl = blk; asm volatile("" : "+s"(blkl)); pg8::StaticOrder S; S.init(M, 1024, G, blkl);
            EpiRes<true, false> E{XB, nullptr, XB, SS + (size_t)3 * SS_STRIDE};
            pg8::gemm_phase<EpiRes<true, false>, pg8::StaticOrder, true, true>(lds3, g, S, E, WV);
        }
        GRID_BAR();
        {
            pg8::Gemm g{XB, (const bf16*)(ws + (layer == 0 ? WS_W0F1 : WS_W1F1)), M, 4096, 1024}; int blkl = blk; asm volatile("" : "+s"(blkl)); pg8::StaticOrder S; S.init(M, 4096, G, blkl, WGM_WIDE);
            rs_table_build<false>(lds, SS + (size_t)(2 * layer + 1) * SS_STRIDE, S, WV);
            EpiAct<1> E{ZH, 4096, nullptr, (const lds_f32_t*)((PG8_LAS unsigned char*)lds + RS_OFF), 0};
            pg8::gemm_phase<EpiAct<1>, pg8::StaticOrder, true, true>(lds3, g, S, E, WV);
        }
        GRID_BAR();
        if (layer == 0) {
            pg8::Gemm g{ZH, (const bf16*)(ws + WS_W0F2), M, 1024, 4096}; int blkl = blk; asm volatile("" : "+s"(blkl)); pg8::StaticOrder S; S.init(M, 1024, G, blkl);
            EpiRes<true, false> E{XB, nullptr, XB, SS + 2 * SS_STRIDE};
            pg8::gemm_phase<EpiRes<true, false>, pg8::StaticOrder, true, true>(lds3, g, S, E, WV);
        } else {
            pg8::Gemm g{ZH, (const bf16*)(ws + WS_W1F2), M, 1024, 4096}; int blkl = blk; asm volatile("" : "+s"(blkl)); pg8::StaticOrder S; S.init(M, 1024, G, blkl);
            EpiRes<true, true> E{XB, a.out, nullptr, nullptr};
            pg8::gemm_phase<EpiRes<true, true>, pg8::StaticOrder, true, true>(lds3, g, S, E, WV);
        }
        if (layer == 0) GRID_BAR();
    }
}

extern "C" void kernel_launch(void* const* d_in, const int* in_sizes, int n_in, void* d_out, int out_size, void* d_ws, size_t ws_size, hipStream_t stream) {
    static int grid = 0;
    if (grid == 0) {
        if (n_in != 22 || out_size != M * DM || ws_size < WS_END) { fprintf(stderr, "kernel_launch: unexpected problem (n_in %d out %d ws %zu)\n", n_in, out_size, ws_size); grid = -1; return; }
        int dev = 0, cus = 0, per_cu = 0;
        (void)hipGetDevice(&dev);
        (void)hipDeviceGetAttribute(&cus, hipDeviceAttributeMultiprocessorCount, dev);
        (void)hipFuncSetAttribute((const void*)trunk_fwd, hipFuncAttributeMaxDynamicSharedMemorySize, LDS_BYTES);
        (void)hipOccupancyMaxActiveBlocksPerMultiprocessor(&per_cu, (const void*)trunk_fwd, 512, LDS_BYTES);
        if (per_cu < 1) per_cu = 1;
        grid = cus * per_cu;
        fprintf(stderr, "kernel_launch: grid %d (cus %d x %d)\n", grid, cus, per_cu);
    }
    if (grid < 0) return;
    Args a{};
    for (int i = 0; i < 22; ++i) a.in[i] = (const float*)d_in[i];
    a.out = (float*)d_out; a.ws = (unsigned char*)d_ws;
    (void)hipMemsetAsync((unsigned char*)d_ws + WS_BAR, 0, 16384, stream);
    void* args[] = {&a};
    hipError_t e = hipLaunchCooperativeKernel((const void*)trunk_fwd, dim3(grid), dim3(512), args, LDS_BYTES, stream);
    if (e != hipSuccess) fprintf(stderr, "kernel_launch: cooperative launch failed: %s (grid %d)\n", hipGetErrorString(e), grid);
}
```

```cpp
#include <hip/hip_runtime.h>
#include <hip/hip_cooperative_groups.h>
#include <cstdio>
#include <cstdint>
namespace cg = cooperative_groups;
__device__ __forceinline__ int lane_id_() { int l; asm volatile("v_mbcnt_lo_u32_b32 %0, -1, 0\n\tv_mbcnt_hi_u32_b32 %0, -1, %0" : "=v"(l)); return l; }
#define TIDX(wv_) ((wv_) * 64 + lane_id_())
namespace pg8 {
#define PG8_LAS __attribute__((address_space(3)))
typedef unsigned short bf16_t;
typedef short bf16x8 __attribute__((ext_vector_type(8)));
typedef float f32x4 __attribute__((ext_vector_type(4)));
typedef unsigned u32x4 __attribute__((ext_vector_type(4)));
constexpr int BM = 256, BK = 64, HALF = 128, HTB = HALF * BK * 2  , STAGE_BYTES = 8 * HTB, NXCD = 8, WGM = 8;

__host__ __device__ __forceinline__ int lds_byte(int r, int c) { const int st = (r >> 4) * 2 + (c >> 5), rr = r & 15, cc = c & 31, ob = rr * 64 + cc * 2; return st * 1024 + (ob ^ (((ob >> 9) & 1) << 5)); }
__host__ __device__ __forceinline__ void stage_rc(int b, int& R, int& C) { const int st = b / 1024, sb = b % 1024, swz = sb ^ (((sb >> 9) & 1) << 5); R = (st >> 1) * 16 + swz / 64; C = (st & 1) * 32 + (swz % 64) / 2; }
__host__ __device__ __forceinline__ int perm32(int rho) { const int n = rho >> 4, i = rho & 15; return 8 * (i >> 2) + 4 * n + (i & 3); }

struct Unit { int pm, pn; };
struct Gemm { const bf16_t* A; const bf16_t* Bt; int M, N, K; };

struct StaticOrder {
    int nM, nN, nwg, G, c, wgm;
    __host__ __device__ void init(int M, int N, int G_, int c_, int wgm_ = WGM) { nM = M / BM; nN = N / BM; nwg = nM * nN; G = G_; c = c_; wgm = wgm_; }
    __host__ __device__ bool next(int i, Unit& u) const {
        const long L = (long)i * G + c; if (L >= nwg) return false;
        int wgid = (int)L; { const int q = nwg / NXCD, r = nwg % NXCD, xcd = wgid % NXCD, off = wgid / NXCD; wgid = (xcd < r ? xcd * (q + 1) : r * (q + 1) + (xcd - r) * q) + off; }
        const int nig = wgm * nN, gid = wgid / nig, fm = gid * wgm, gsz = (nM - fm) < wgm ? (nM - fm) : wgm;
        u.pm = fm + ((wgid % nig) % gsz); u.pn = (wgid % nig) / gsz; return true;
    }
    __device__ __forceinline__ void a_ready(const Unit&) const {}
    __device__ __forceinline__ void done(const Unit&) const {}
};

__device__ __forceinline__ unsigned cvt_pk_bf16_unused(float lo, float hi) { return 0; }
template <class Epi, class Sched, bool ALIGN_EPI = false, bool SP2 = false>
__device__ __forceinline__ void gemm_phase(PG8_LAS unsigned char* lds, const Gemm g, const Sched& S, const Epi& E, const int wv_) {
    int tid_ = TIDX(wv_); asm volatile("" : "+v"(tid_)); const int tid = tid_, wid = __builtin_amdgcn_readfirstlane(tid >> 6), lane = tid & 63, wr = wid >> 2, wc = wid & 3, fr = lane & 15, fq = lane >> 4;
    const int K = g.K, nt = K / BK;
    unsigned voffA[2], voffB[2];
#pragma unroll
    for (int i = 0; i < 2; ++i) { int R, C; stage_rc(tid * 16 + i * 8192, R, C); const int Rb = Epi::PERM ? ((R & ~31) + perm32(R & 31)) : R;
        voffA[i] = (unsigned)(R * K + C) * 2u; voffB[i] = (unsigned)(Rb * K + C) * 2u; }
    const size_t kstep = (size_t)(BK * 2);
    const size_t hstep = (size_t)HALF * K * 2;
    const size_t tstep = 2 * hstep;
    const unsigned ldsw = (unsigned)wid * 1024u;
    const int aoff = lds_byte(wr * 64 + fr, fq * 8), boff = lds_byte(wc * 32 + fr, fq * 8);
#define PG8_SA(b, h) (((b) * 2 + (h)) * HTB)
#define PG8_SB(b, h) ((4 + (b) * 2 + (h)) * HTB)
#define PG8_STAGE(bufoff, gbase, voff) do { _Pragma("unroll") for (int _i = 0; _i < 2; ++_i) \
        __builtin_amdgcn_global_load_lds((const unsigned*)((const char*)(gbase) + (voff)[_i]), (PG8_LAS unsigned*)(lds + (bufoff) + ldsw + _i * 8192), 16, 0, 0); } while (0)
#define PG8_LDA(dst, b, h) do { _Pragma("unroll") for (int m = 0; m < 4; ++m) _Pragma("unroll") for (int k = 0; k < 2; ++k) dst[m][k] = *(const PG8_LAS bf16x8*)(lds + PG8_SA(b, h) + aoff + m * 2048 + k * 1024); } while (0)
#define PG8_LDB(dst, b, h) do { _Pragma("unroll") for (int n = 0; n < 2; ++n) _Pragma("unroll") for (int k = 0; k < 2; ++k) dst[n][k] = *(const PG8_LAS bf16x8*)(lds + PG8_SB(b, h) + boff + n * 2048 + k * 1024); } while (0)
#define PG8_MMA(ai, bj, At, Bt) do { __builtin_amdgcn_s_setprio(1); _Pragma("unroll") for (int m = 0; m < 4; ++m) _Pragma("unroll") for (int n = 0; n < 2; ++n) _Pragma("unroll") for (int k = 0; k < 2; ++k) \
        acc[ai][bj][m][n] = __builtin_amdgcn_mfma_f32_16x16x32_bf16(Bt[n][k], At[m][k], acc[ai][bj][m][n], 0, 0, 0); __builtin_amdgcn_s_setprio(0); } while (0)
#define PG8_WAIT_V(n) asm volatile("s_waitcnt vmcnt(" #n ")" ::: "memory")
#define PG8_WAIT_L(n) asm volatile("s_waitcnt lgkmcnt(" #n ")" ::: "memory")
#define PG8_BAR __builtin_amdgcn_s_barrier()
#define PG8_SCHED __builtin_amdgcn_sched_barrier(0)
    Unit cur, nxt; int ui = 0;
    if (!S.next(0, cur)) return;
    f32x4 acc[2][2][4][2];
#pragma unroll
    for (int a = 0; a < 2; ++a)
#pragma unroll
        for (int b = 0; b < 2; ++b)
#pragma unroll
            for (int m = 0; m < 4; ++m)
#pragma unroll
                for (int n = 0; n < 2; ++n) acc[a][b][m][n] = (f32x4){0.f, 0.f, 0.f, 0.f};
    bf16x8 At[4][2], B0[2][2], B1[2][2];
    const char* cA = (const char*)g.A + (size_t)cur.pm * tstep; const char* cB = (const char*)g.Bt + (size_t)cur.pn * tstep;
    S.a_ready(cur);
    if constexpr (SP2) {
        PG8_STAGE(PG8_SB(0, 0), cB, voffB); PG8_STAGE(PG8_SB(0, 1), cB + hstep, voffB); PG8_STAGE(PG8_SA(0, 0), cA, voffA); PG8_STAGE(PG8_SA(0, 1), cA + hstep, voffA);
        if (wr == 1) PG8_BAR;
        PG8_WAIT_V(2); PG8_BAR;
        PG8_STAGE(PG8_SB(1, 0), cB + kstep, voffB); PG8_STAGE(PG8_SA(1, 0), cA + kstep, voffA); PG8_STAGE(PG8_SB(1, 1), cB + hstep + kstep, voffB);
        PG8_WAIT_V(6); PG8_BAR;
    } else {
        PG8_STAGE(PG8_SB(0, 0), cB, voffB); PG8_STAGE(PG8_SA(0, 0), cA, voffA); PG8_STAGE(PG8_SB(0, 1), cB + hstep, voffB); PG8_STAGE(PG8_SA(0, 1), cA + hstep, voffA);
        if (wr == 1) PG8_BAR;
        PG8_WAIT_V(4); PG8_BAR;
        PG8_STAGE(PG8_SB(1, 0), cB + kstep, voffB); PG8_STAGE(PG8_SA(1, 0), cA + kstep, voffA); PG8_STAGE(PG8_SB(1, 1), cB + hstep + kstep, voffB);
        PG8_WAIT_V(6); PG8_BAR;
    }
    for (;;) {
        const bool has_next = S.next(ui + 1, nxt);
        const char* nA = has_next ? (const char*)g.A + (size_t)nxt.pm * tstep : cA; const char* nB = has_next ? (const char*)g.Bt + (size_t)nxt.pn * tstep : cB;
        for (int t = 0; t < nt; t += 2) {
            const bool last = (t == nt - 2);
            const char* a1 = cA + (size_t)(t + 1) * kstep;
            const char* a2 = last ? nA : cA + (size_t)(t + 2) * kstep; const char* b2 = last ? nB : cB + (size_t)(t + 2) * kstep;
            const char* a3 = a2 + kstep; const char* b3 = b2 + kstep;
            if (last && has_next) S.a_ready(nxt);
            if constexpr (SP2) {
            PG8_LDB(B0, 0, 0); PG8_LDB(B1, 0, 1); PG8_SCHED; PG8_LDA(At, 0, 0); PG8_STAGE(PG8_SA(1, 1), a1 + hstep, voffA);
            PG8_WAIT_V(8); PG8_WAIT_L(0); PG8_BAR; PG8_MMA(0, 0, At, B0); PG8_MMA(0, 1, At, B1); PG8_BAR; PG8_SCHED;
            PG8_LDA(At, 0, 1); PG8_STAGE(PG8_SB(0, 0), b2, voffB); PG8_STAGE(PG8_SB(0, 1), b2 + hstep, voffB); PG8_STAGE(PG8_SA(0, 0), a2, voffA);
            PG8_WAIT_V(8); PG8_WAIT_L(0); PG8_BAR; PG8_MMA(1, 0, At, B0); PG8_MMA(1, 1, At, B1); PG8_BAR; PG8_SCHED;
            PG8_LDB(B0, 1, 0); PG8_LDB(B1, 1, 1); PG8_SCHED; PG8_LDA(At, 1, 0); PG8_STAGE(PG8_SA(0, 1), a2 + hstep, voffA);
            PG8_WAIT_V(8); PG8_WAIT_L(0); PG8_BAR; PG8_MMA(0, 0, At, B0); PG8_MMA(0, 1, At, B1); PG8_BAR; PG8_SCHED;
            PG8_LDA(At, 1, 1); PG8_STAGE(PG8_SB(1, 0), b3, voffB); PG8_STAGE(PG8_SB(1, 1), b3 + hstep, voffB); PG8_STAGE(PG8_SA(1, 0), a3, voffA);
            PG8_WAIT_V(8); PG8_WAIT_L(0); PG8_BAR; PG8_MMA(1, 0, At, B0); PG8_MMA(1, 1, At, B1); PG8_BAR; PG8_SCHED;
            } else {
            PG8_LDB(B0, 0, 0); PG8_SCHED; PG8_LDA(At, 0, 0); PG8_STAGE(PG8_SA(1, 1), a1 + hstep, voffA);
            PG8_WAIT_L(8); PG8_BAR; PG8_WAIT_L(0); PG8_MMA(0, 0, At, B0); PG8_BAR; PG8_SCHED;
            PG8_LDB(B1, 0, 1); PG8_STAGE(PG8_SB(0, 0), b2, voffB);
            PG8_BAR; PG8_WAIT_L(0); PG8_MMA(0, 1, At, B1); PG8_BAR;
            PG8_LDA(At, 0, 1); PG8_STAGE(PG8_SA(0, 0), a2, voffA);
            PG8_BAR; PG8_WAIT_L(0); PG8_MMA(1, 0, At, B0); PG8_BAR; PG8_SCHED;
            PG8_STAGE(PG8_SB(0, 1), b2 + hstep, voffB);
            PG8_WAIT_V(6); PG8_BAR; PG8_MMA(1, 1, At, B1); PG8_BAR;
            PG8_LDB(B0, 1, 0); PG8_SCHED; PG8_LDA(At, 1, 0); PG8_STAGE(PG8_SA(0, 1), a2 + hstep, voffA);
            PG8_WAIT_L(8); PG8_BAR; PG8_WAIT_L(0); PG8_MMA(0, 0, At, B0); PG8_BAR; PG8_SCHED;
            PG8_LDB(B1, 1, 1); PG8_STAGE(PG8_SB(1, 0), b3, voffB);
            PG8_BAR; PG8_WAIT_L(0); PG8_MMA(0, 1, At, B1); PG8_BAR;
            PG8_LDA(At, 1, 1); PG8_STAGE(PG8_SA(1, 0), a3, voffA);
            PG8_BAR; PG8_WAIT_L(0); PG8_MMA(1, 0, At, B0); PG8_BAR; PG8_SCHED;
            PG8_STAGE(PG8_SB(1, 1), b3 + hstep, voffB);
            PG8_WAIT_V(6); PG8_BAR; PG8_MMA(1, 1, At, B1); PG8_BAR;
            }
        }
        if constexpr (ALIGN_EPI) { if (wr == 0) PG8_BAR; }
        if constexpr (!Epi::AFTER_DRAIN) { E(acc, cur, wr, wc, fr, fq); S.done(cur); }
        if (!has_next) break;
#pragma unroll
        for (int a = 0; a < 2; ++a)
#pragma unroll
            for (int b = 0; b < 2; ++b)
#pragma unroll
                for (int m = 0; m < 4; ++m)
#pragma unroll
                    for (int n = 0; n < 2; ++n) acc[a][b][m][n] = (f32x4){0.f, 0.f, 0.f, 0.f};
        cur = nxt; cA = nA; cB = nB; ++ui;
        if constexpr (ALIGN_EPI) { if (wr == 1) PG8_BAR; }
    }
    PG8_WAIT_V(0);
    if constexpr (!ALIGN_EPI) { if (wr == 0) PG8_BAR; }
    PG8_BAR;
    if constexpr (Epi::AFTER_DRAIN) { E.fused(acc, cur, wr, wc, fr, fq, lds, wid, lane); S.done(cur); }
#undef PG8_SA
#undef PG8_SB
#undef PG8_STAGE
#undef PG8_LDA
#undef PG8_LDB
#undef PG8_MMA
#undef PG8_WAIT_V
#undef PG8_WAIT_L
#undef PG8_BAR
#undef PG8_SCHED
}
}
#define DI __device__ __forceinline__
typedef __attribute__((address_space(3))) float lds_f32_t;
typedef unsigned short bf16;
typedef float f32x4 __attribute__((ext_vector_type(4)));
typedef float f32x2 __attribute__((ext_vector_type(2)));
typedef float f32x16 __attribute__((ext_vector_type(16)));
typedef short bf16x8 __attribute__((ext_vector_type(8)));
typedef short s16x4 __attribute__((ext_vector_type(4)));
typedef unsigned u32x4 __attribute__((ext_vector_type(4)));
typedef __bf16 bf16x2_t __attribute__((ext_vector_type(2)));
#define MFMA32(a, b, c) __builtin_amdgcn_mfma_f32_32x32x16_bf16((a), (b), (c), 0, 0, 0)
#define LDS_FENCE() asm volatile("s_waitcnt lgkmcnt(0)" ::: "memory")

DI unsigned pk2(float lo, float hi) { f32x2 v = {lo, hi}; bf16x2_t b = __builtin_convertvector(v, bf16x2_t); return __builtin_bit_cast(unsigned, b); }
DI float bflo(unsigned u) { return __uint_as_float(u << 16); }
DI float bfhi(unsigned u) { return __uint_as_float(u & 0xffff0000u); }
DI float bf2f(bf16 h) { return __uint_as_float((unsigned)h << 16); }
DI float wave_sum(float v) {
#pragma unroll
    for (int o = 1; o < 64; o <<= 1) v += __shfl_xor(v, o);
    return v;
}
DI float sigmoid_(float x) { return 1.f / (1.f + __expf(-x)); }
DI float silu_(float x) { return x / (1.f + __expf(-x)); }
DI float softplus_(float x) { return x > 20.f ? x : __logf(1.0f + __expf(x)); }
DI int crow(int reg, int h) { return (reg & 3) + 8 * (reg >> 2) + 4 * h; }

constexpr int BATCH = 16, SEQ = 2048, DM = 1024, M = BATCH * SEQ, FF = 4096, N0 = 3840;
constexpr float EPS = 1e-6f, LOG2E = 1.4426950408889634f;
constexpr size_t MiB = 1u << 20;
constexpr size_t WS_W0IN = 0, WS_W0OUT = 8 * MiB, WS_W0F1 = 10 * MiB, WS_W0F2 = 18 * MiB, WS_W1IN = 26 * MiB, WS_W1OUT = 34 * MiB, WS_W1F1 = 36 * MiB, WS_W1F2 = 44 * MiB;
constexpr size_t WS_MIX = 52 * MiB, WS_ZH = 116 * MiB, WS_SS = 372 * MiB, WS_C2 = 380 * MiB, WS_XB = 384 * MiB, WS_END = 512 * MiB;
constexpr size_t WS_PAR = 381 * MiB;
constexpr int P_QN = 0, P_KN = 64, P_FB = 128, P_CONV = 256, P_ALOG = 6400, P_DTB = 6404, P_GON = 6528, P_HON = 6656, P_LB = 6784, P_END = 8832;
constexpr size_t WS_BAR = 381 * MiB + 131072;
constexpr size_t SS_STRIDE = (size_t)M * 16;
constexpr int LDS_BYTES = 147456;
#ifndef WGM_WIDE
#define WGM_WIDE 4
#endif

constexpr int RS_OFF = 131072;
template <int ACT> struct EpiAct {
    static constexpr bool PERM = true, AFTER_DRAIN = false;
    bf16* O; int ldc; const float* par; const lds_f32_t* rs; mutable int ui;
    DI void operator()(const f32x4 (&acc)[2][2][4][2], const pg8::Unit& u, int wr, int wc, int fr, int fq) const {
        const int row0 = u.pm * 256 + wr * 64 + fr, col0 = u.pn * 256 + wc * 32 + 8 * fq;
        float rsv[2][4];
#pragma unroll
        for (int ai = 0; ai < 2; ++ai)
#pragma unroll
            for (int m = 0; m < 4; ++m) rsv[ai][m] = rs[ui * 256 + ai * 128 + wr * 64 + m * 16 + fr];
        ++ui;
#pragma unroll
        for (int ai = 0; ai < 2; ++ai)
#pragma unroll
            for (int m = 0; m < 4; ++m) {
                const int row = row0 + ai * 128 + m * 16;
                const float r = rsv[ai][m];
                bf16* rowp = O + (size_t)row * ldc + col0;
                if (ACT == 2 && u.pn < 4) {
                    float ssq = 0.f;
#pragma unroll
                    for (int bj = 0; bj < 2; ++bj)
#pragma unroll
                        for (int n = 0; n < 2; ++n) { const f32x4 t = acc[ai][bj][m][n]; ssq += (t[0] * t[0] + t[1] * t[1]) + (t[2] * t[2] + t[3] * t[3]); }
                    ssq += __shfl_xor(ssq, 16); ssq += __shfl_xor(ssq, 32);
                    const float rn = r * rsqrtf(ssq * r * r * (1.0f / 64.0f) + EPS) * (u.pn < 2 ? 0.125f * LOG2E : 1.0f);
                    int fql = fq; asm volatile("" : "+v"(fql));
                    const float* gq = par + (u.pn < 2 ? P_QN : P_KN) + 8 * fql;
#pragma unroll
                    for (int bj = 0; bj < 2; ++bj) {
                        const f32x4 g0 = *(const f32x4*)(gq + bj * 32), g1 = *(const f32x4*)(gq + bj * 32 + 4);
                        const f32x4 v0 = acc[ai][bj][m][0] * rn * g0, v1 = acc[ai][bj][m][1] * rn * g1;
                        u32x4 w; w.x = pk2(v0[0], v0[1]); w.y = pk2(v0[2], v0[3]); w.z = pk2(v1[0], v1[1]); w.w = pk2(v1[2], v1[3]);
                        __builtin_nontemporal_store(w, (u32x4*)(rowp + bj * 128));
                    }
                    continue;
                }
#pragma unroll
                for (int bj = 0; bj < 2; ++bj) {
                    f32x4 v0 = acc[ai][bj][m][0] * r, v1 = acc[ai][bj][m][1] * r;
                    if (ACT == 1) {
#pragma unroll
                        for (int e = 0; e < 4; ++e) { const float x0 = fmaxf(v0[e], 0.f), x1 = fmaxf(v1[e], 0.f); v0[e] = x0 * x0; v1[e] = x1 * x1; }
                    }
                    u32x4 w; w.x = pk2(v0[0], v0[1]); w.y = pk2(v0[2], v0[3]); w.z = pk2(v1[0], v1[1]); w.w = pk2(v1[2], v1[3]);
                    __builtin_nontemporal_store(w, (u32x4*)(rowp + bj * 128));
                }
            }
    }
};
template <bool FINISHED, class Sched> DI void rs_table_build(unsigned char* lds, const float* ss, const Sched& S, const int wv_) {
    int tid = TIDX(wv_); asm volatile("" : "+v"(tid));
    float* rs = (float*)(lds + RS_OFF);
    const int r = tid & 255, par = tid >> 8;
    pg8::Unit u;
#pragma unroll
    for (int k = 0; k < 4; ++k) {
        const int i = 2 * k + par;
        if (S.next(i, u)) {
            const int row = u.pm * 256 + r;
            if (FINISHED) rs[i * 256 + r] = ss[row];
            else {
                const f32x4* p = (const f32x4*)(ss + (size_t)row * 16);
                const f32x4 a = p[0], b = p[1], c = p[2], d = p[3];
                const float sm = ((a.x + a.y) + (a.z + a.w)) + ((b.x + b.y) + (b.z + b.w)) + ((c.x + c.y) + (c.z + c.w)) + ((d.x + d.y) + (d.z + d.w));
                rs[i * 256 + r] = rsqrtf(sm * (1.0f / 1024.0f) + EPS);
            }
        }
    }
    __syncthreads();
}
template <bool BASE_BF16, bool OUT_F32> struct EpiRes {
    static constexpr bool PERM = true, AFTER_DRAIN = false;
    const void* base; float* out; bf16* xb; float* ss_out;
    DI void operator()(const f32x4 (&acc)[2][2][4][2], const pg8::Unit& u, int wr, int wc, int fr, int fq) const {
        const int row0 = u.pm * 256 + wr * 64 + fr, col0 = u.pn * 256 + wc * 32 + 8 * fq;
#pragma unroll
        for (int ai = 0; ai < 2; ++ai) {
            f32x4 bb[4][2][2];
#pragma unroll
            for (int m = 0; m < 4; ++m)
#pragma unroll
                for (int bj = 0; bj < 2; ++bj) {
                    const size_t off = (size_t)(row0 + ai * 128 + m * 16) * 1024 + col0 + bj * 128;
                    if (BASE_BF16) {
                        const u32x4 w = *(const u32x4*)((const bf16*)base + off);
                        bb[m][bj][0] = (f32x4){bflo(w[0]), bfhi(w[0]), bflo(w[1]), bfhi(w[1])}; bb[m][bj][1] = (f32x4){bflo(w[2]), bfhi(w[2]), bflo(w[3]), bfhi(w[3])};
                    } else {
                        bb[m][bj][0] = *(const f32x4*)((const float*)base + off); bb[m][bj][1] = *(const f32x4*)((const float*)base + off + 4);
                    }
                }
            __builtin_amdgcn_sched_barrier(0);
#pragma unroll
            for (int m = 0; m < 4; ++m) {
                const int row = row0 + ai * 128 + m * 16;
                float s = 0.f;
#pragma unroll
                for (int bj = 0; bj < 2; ++bj) {
                    const size_t off = (size_t)row * 1024 + col0 + bj * 128;
                    const f32x4 v0 = acc[ai][bj][m][0] + bb[m][bj][0], v1 = acc[ai][bj][m][1] + bb[m][bj][1];
                    if (OUT_F32) { *(f32x4*)(out + off) = v0; *(f32x4*)(out + off + 4) = v1; }
                    else {
                        s += ((v0[0] * v0[0] + v0[1] * v0[1]) + (v0[2] * v0[2] + v0[3] * v0[3])) + ((v1[0] * v1[0] + v1[1] * v1[1]) + (v1[2] * v1[2] + v1[3] * v1[3]));
                        u32x4 w; w.x = pk2(v0[0], v0[1]); w.y = pk2(v0[2], v0[3]); w.z = pk2(v1[0], v1[1]); w.w = pk2(v1[2], v1[3]); *(u32x4*)(xb + off) = w;
                    }
                }
                if (!OUT_F32) { s += __shfl_xor(s, 16); s += __shfl_xor(s, 32); if (fq == 0) ss_out[(size_t)row * 16 + u.pn * 4 + wc] = s; }
            }
            __builtin_amdgcn_sched_barrier(0);
        }
    }
};

DI int src_col0(int n) {
    if (n < 1024) { const int tile = n >> 8, c = n & 255, half = c >> 7, wc = (c >> 5) & 3, dl = c & 31; return (tile >> 1) * 512 + ((tile & 1) * 4 + wc) * 64 + half * 32 + dl; }
    return n < 1536 ? n : n < 3072 ? n + 8 : n < 3584 ? n + 16 : n < 3592 ? n - 3584 + 1536 : n < 3600 ? n - 3592 + 3080 : -1;
}
DI int fox_col(int which, int h, int d) { return which * 512 + 256 * (h >> 2) + (d >> 5) * 128 + 32 * (h & 3) + (d & 31); }
template <bool MAP> DI void transpose_item(const float* __restrict__ W, int K, int Nsrc, int Ndst, const float* __restrict__ gain, bf16* __restrict__ WT, float* scr, int item, int lane) {
    const int nblk = Ndst / 32, kb = item / nblk, nb = item % nblk, k0 = 64 * kb, n0 = 32 * nb;
    const int n = n0 + (lane & 31), sc = MAP ? src_col0(n) : n;
    float vals[32];
#pragma unroll
    for (int i = 0; i < 32; ++i) {
        const int kk = 2 * i + (lane >> 5); float v = 0.f;
        if (sc >= 0) v = W[(size_t)(k0 + kk) * Nsrc + sc];
        vals[i] = v;
    }
#pragma unroll
    for (int i = 0; i < 32; ++i) {
        const int kk = 2 * i + (lane >> 5); float v = vals[i];
        if (gain) v *= gain[k0 + kk];
        scr[kk * 33 + (lane & 31)] = v;
    }
    LDS_FENCE();
    const int c = lane & 7;
#pragma unroll
    for (int j = 0; j < 4; ++j) {
        const int nn = (lane >> 3) + 8 * j; const float* s = scr + (8 * c) * 33 + nn;
        u32x4 o; o.x = pk2(s[0 * 33], s[1 * 33]); o.y = pk2(s[2 * 33], s[3 * 33]); o.z = pk2(s[4 * 33], s[5 * 33]); o.w = pk2(s[6 * 33], s[7 * 33]);
        *(u32x4*)(WT + (size_t)(n0 + nn) * K + k0 + 8 * c) = o;
    }
    LDS_FENCE();
}

struct Args { const float* in[22]; float* out; unsigned char* ws; };

DI void p0_prologue(const Args& a, unsigned char* lds, const int wv_) {
    int tid = TIDX(wv_); asm volatile("" : "+v"(tid)); const int lane = tid & 63, wave = __builtin_amdgcn_readfirstlane(tid >> 6), gw = blockIdx.x * 8 + wave, NGW = gridDim.x * 8;
    float* scr = (float*)(lds + wave * 16384);
    unsigned char* ws = a.ws;
    constexpr int I0 = 16 * (N0 / 32), I_O = 16 * 32, I_1 = 16 * 128, I_2 = 64 * 32;
    constexpr int NITEMS = I0 + I_O + I_1 + I_2 + I_1 + I_O + I_1 + I_2;
    for (int it = gw; it < NITEMS; it += NGW) {
        int r = it;
        if (r < I0) { transpose_item<true>(a.in[2], 1024, 3600, N0, a.in[1], (bf16*)(ws + WS_W0IN), scr, r, lane); continue; } r -= I0;
        if (r < I_O) { transpose_item<false>(a.in[10], 1024, 1024, 1024, nullptr, (bf16*)(ws + WS_W0OUT), scr, r, lane); continue; } r -= I_O;
        if (r < I_1) { transpose_item<false>(a.in[12], 1024, 4096, 4096, a.in[11], (bf16*)(ws + WS_W0F1), scr, r, lane); continue; } r -= I_1;
        if (r < I_2) { transpose_item<false>(a.in[13], 4096, 1024, 1024, nullptr, (bf16*)(ws + WS_W0F2), scr, r, lane); continue; } r -= I_2;
        if (r < I_1) { transpose_item<false>(a.in[15], 1024, 4096, 4096, a.in[14], (bf16*)(ws + WS_W1IN), scr, r, lane); continue; } r -= I_1;
        if (r < I_O) { transpose_item<false>(a.in[17], 1024, 1024, 1024, nullptr, (bf16*)(ws + WS_W1OUT), scr, r, lane); continue; } r -= I_O;
        if (r < I_1) { transpose_item<false>(a.in[19], 1024, 4096, 4096, a.in[18], (bf16*)(ws + WS_W1F1), scr, r, lane); continue; } r -= I_1;
        transpose_item<false>(a.in[20], 4096, 1024, 1024, nullptr, (bf16*)(ws + WS_W1F2), scr, r, lane);
    }
    if (blockIdx.x == 0) {
        float* P = (float*)(ws + WS_PAR);
        for (int i = tid; i < P_END; i += 512) {
            float v = 0.f;
            if (i < 64) v = a.in[3][i]; else if (i < 128) v = a.in[4][i - 64]; else if (i < 136) v = a.in[5][i - 128];
            else if (i >= P_CONV && i < P_CONV + 6144) v = a.in[6][i - P_CONV];
            else if (i >= P_ALOG && i < P_ALOG + 4) v = a.in[7][i - P_ALOG]; else if (i >= P_DTB && i < P_DTB + 4) v = a.in[8][i - P_DTB];
            else if (i >= P_GON && i < P_GON + 128) v = a.in[9][i - P_GON]; else if (i >= P_HON && i < P_HON + 128) v = a.in[16][i - P_HON];
            else if (i >= P_LB) v = a.in[21][i - P_LB];
            P[i] = v;
        }
    }
    const float* x = a.in[0]; bf16* XB = (bf16*)(ws + WS_XB); float* SS = (float*)(ws + WS_SS);
    for (int m0 = gw; m0 < M; m0 += 2 * NGW) {
        const int m1 = m0 + NGW; const bool has1 = m1 < M;
        const f32x4* xr0 = (const f32x4*)(x + (size_t)m0 * DM) + lane; const f32x4* xr1 = (const f32x4*)(x + (size_t)(has1 ? m1 : m0) * DM) + lane;
        f32x4 v0[4], v1[4]; float s0 = 0.f, s1 = 0.f;
#pragma unroll
        for (int j = 0; j < 4; ++j) { v0[j] = xr0[64 * j]; v1[j] = xr1[64 * j]; }
#pragma unroll
        for (int j = 0; j < 4; ++j) {
            s0 += (v0[j].x * v0[j].x + v0[j].y * v0[j].y) + (v0[j].z * v0[j].z + v0[j].w * v0[j].w);
            s1 += (v1[j].x * v1[j].x + v1[j].y * v1[j].y) + (v1[j].z * v1[j].z + v1[j].w * v1[j].w);
        }
#pragma unroll
        for (int o = 1; o < 64; o <<= 1) { s0 += __shfl_xor(s0, o); s1 += __shfl_xor(s1, o); }
        unsigned long long* o80 = (unsigned long long*)(XB + (size_t)m0 * DM) + lane;
#pragma unroll
        for (int j = 0; j < 4; ++j) o80[64 * j] = (unsigned long long)pk2(v0[j].x, v0[j].y) | ((unsigned long long)pk2(v0[j].z, v0[j].w) << 32);
        if (lane == 0) SS[m0] = rsqrtf(s0 * (1.0f / 1024.0f) + EPS);
        if (has1) {
            unsigned long long* o81 = (unsigned long long*)(XB + (size_t)m1 * DM) + lane;
#pragma unroll
            for (int j = 0; j < 4; ++j) o81[64 * j] = (unsigned long long)pk2(v1[j].x, v1[j].y) | ((unsigned long long)pk2(v1[j].z, v1[j].w) << 32);
            if (lane == 0) SS[m1] = rsqrtf(s1 * (1.0f / 1024.0f) + EPS);
        }
    }
}

DI void fox_prep(const Args& a, const int wv_) {
    int tid = TIDX(wv_); asm volatile("" : "+v"(tid)); const int lane = tid & 63, wave = __builtin_amdgcn_readfirstlane(tid >> 6), gw = blockIdx.x * 8 + wave, NGW = gridDim.x * 8;
    bf16* Z = (bf16*)(a.ws + WS_ZH); float* C2 = (float*)(a.ws + WS_C2);
    for (int it = gw; it < 128; it += NGW) {
        const int b = it >> 3, h = it & 7; const float bias = ((const float*)(a.ws + WS_PAR))[P_FB + h];
        float loc[32]; float run = 0.f;
#pragma unroll
        for (int i = 0; i < 32; ++i) {
            const int t = 32 * lane + i; const float x = bf2f(Z[((size_t)b * SEQ + t) * N0 + 3584 + h]) + bias;
            const float ls = fminf(x, 0.f) - __logf(1.0f + __expf(-fabsf(x))); run += ls; loc[i] = run;
        }
        float incl = run;
#pragma unroll
        for (int o = 1; o < 64; o <<= 1) { const float y = __shfl_up(incl, o); if (lane >= o) incl += y; }
        const float excl = incl - run;
#pragma unroll
        for (int i = 0; i < 32; ++i) C2[(size_t)it * SEQ + 32 * lane + i] = (loc[i] + excl) * LOG2E;
    }
}

constexpr int LDK = 72;
DI void fox_unit(const bf16* __restrict__ Z, const float* __restrict__ C2, bf16* __restrict__ MIX, int b, int h, int qb, unsigned char* lds, const int wv_) {
    int tid = TIDX(wv_); asm volatile("" : "+v"(tid)); const int lane = tid & 63, r = lane & 31, hh = lane >> 5, w = tid >> 6;
    bf16* Ks0 = (bf16*)lds; bf16* Vt0 = (bf16*)(lds + 18432); float* C2s = (float*)(lds + 36864); float* AS = (float*)(lds + 45056) + w * 32;
    const int q0 = qb * 256, nT = (q0 + 256) / 64;
    const size_t rowbase = (size_t)b * SEQ;
    const float* c2g = C2 + (size_t)(b * 8 + h) * SEQ;
    {
        float cv[4];
#pragma unroll
        for (int k = 0; k < 4; ++k) { const int i = tid + 512 * k; cv[k] = i < q0 + 256 ? c2g[i] : 0.f; }
#pragma unroll
        for (int k = 0; k < 4; ++k) { const int i = tid + 512 * k; if (i < q0 + 256) C2s[i] = -cv[k]; }
    }
    const int qrow = q0 + 32 * w + r;
    bf16x8 qr[4];
#pragma unroll
    for (int ks = 0; ks < 4; ++ks) qr[ks] = *(const bf16x8*)(Z + (rowbase + qrow) * N0 + fox_col(0, h, ks * 16 + hh * 8));
    float m_run = -INFINITY, l_run = 0.f;
    f32x16 o0, o1;
#pragma unroll
    for (int i = 0; i < 16; ++i) { o0[i] = 0.f; o1[i] = 0.f; }
    const int kr = tid >> 3, ch = tid & 7;
    const bf16* kvp = Z + (rowbase + kr) * N0 + fox_col(1, h, ch * 8);
    const int voff = 1024 + h * 64 + ch * 8 - fox_col(1, h, ch * 8);
    u32x4 kv = *(const u32x4*)kvp, vv = *(const u32x4*)(kvp + voff);
    {
        *(u32x4*)(Ks0 + kr * LDK + ch * 8) = kv;
#pragma unroll
        for (int e = 0; e < 8; ++e) Vt0[(ch * 8 + e) * LDK + kr] = (bf16)(vv[e >> 1] >> (16 * (e & 1)));
        if (1 < nT) { const bf16* np = kvp + (size_t)64 * N0; kv = *(const u32x4*)np; vv = *(const u32x4*)(np + voff); }
    }
    __syncthreads();
    for (int jt = 0; jt < nT; ++jt) {
        const bf16* Ks = Ks0 + (jt & 1) * 4608; const bf16* Vt = Vt0 + (jt & 1) * 4608;
        if (jt + 1 < nT) {
            bf16* Kn = Ks0 + ((jt + 1) & 1) * 4608; bf16* Vn = Vt0 + ((jt + 1) & 1) * 4608;
            *(u32x4*)(Kn + kr * LDK + ch * 8) = kv;
#pragma unroll
            for (int e = 0; e < 8; ++e) Vn[(ch * 8 + e) * LDK + kr] = (bf16)(vv[e >> 1] >> (16 * (e & 1)));
            if (jt + 2 < nT) { const bf16* np = kvp + (size_t)(jt + 2) * 64 * N0; kv = *(const u32x4*)np; vv = *(const u32x4*)(np + voff); }
        }
        const int kv0 = jt * 64;
        if (kv0 <= q0 + 32 * w + 31) {
            f32x16 p0, p1;
#pragma unroll
            for (int g = 0; g < 4; ++g) {
                const f32x4 c0v = *(const f32x4*)(C2s + kv0 + 8 * g + 4 * hh), c1v = *(const f32x4*)(C2s + kv0 + 32 + 8 * g + 4 * hh);
#pragma unroll
                for (int e = 0; e < 4; ++e) { p0[4 * g + e] = c0v[e]; p1[4 * g + e] = c1v[e]; }
            }
#pragma unroll
            for (int ks = 0; ks < 4; ++ks) {
                const bf16x8 a0 = *(const bf16x8*)(Ks + r * LDK + ks * 16 + hh * 8);
                const bf16x8 a1 = *(const bf16x8*)(Ks + (32 + r) * LDK + ks * 16 + hh * 8);
                p0 = MFMA32(a0, qr[ks], p0); p1 = MFMA32(a1, qr[ks], p1);
            }
            float mt = -INFINITY;
            const bool need_mask = kv0 + 63 > q0 + 32 * w;
#pragma unroll
            for (int g = 0; g < 4; ++g) {
#pragma unroll
                for (int e = 0; e < 4; ++e) {
                    const int i = 4 * g + e, kvi = kv0 + 8 * g + 4 * hh + e;
                    float s0 = p0[i], s1 = p1[i];
                    if (need_mask) { if (kvi > qrow) s0 = -INFINITY; if (kvi + 32 > qrow) s1 = -INFINITY; }
                    p0[i] = s0; p1[i] = s1; mt = fmaxf(mt, fmaxf(s0, s1));
                }
            }
            mt = fmaxf(mt, __shfl_xor(mt, 32));
            const float m_new = fmaxf(m_run, mt);
            const float alpha = __builtin_amdgcn_exp2f(m_run - m_new);
            m_run = m_new;
            float ps = 0.f;
#pragma unroll
            for (int i = 0; i < 16; ++i) { p0[i] = __builtin_amdgcn_exp2f(p0[i] - m_new); p1[i] = __builtin_amdgcn_exp2f(p1[i] - m_new); ps += p0[i] + p1[i]; }
            l_run = l_run * alpha + ps;
            if (hh == 0) AS[r] = alpha;
            LDS_FENCE();
#pragma unroll
            for (int i = 0; i < 16; ++i) { const float al = AS[crow(i, hh)]; o0[i] *= al; o1[i] *= al; }
            bf16x8 pa[4];
#pragma unroll
            for (int s = 0; s < 2; ++s) {
                u32x4 t0, t1;
#pragma unroll
                for (int e = 0; e < 4; ++e) { t0[e] = pk2(p0[8 * s + 2 * e], p0[8 * s + 2 * e + 1]); t1[e] = pk2(p1[8 * s + 2 * e], p1[8 * s + 2 * e + 1]); }
                pa[s] = __builtin_bit_cast(bf16x8, t0); pa[2 + s] = __builtin_bit_cast(bf16x8, t1);
            }
#pragma unroll
            for (int k4 = 0; k4 < 4; ++k4) {
                const int half = k4 >> 1, s = k4 & 1;
                const bf16* vb0 = Vt + r * LDK + 32 * half + 16 * s + 4 * hh;
                const bf16* vb1 = Vt + (32 + r) * LDK + 32 * half + 16 * s + 4 * hh;
                const s16x4 lo0 = *(const s16x4*)vb0, hi0 = *(const s16x4*)(vb0 + 8);
                const s16x4 lo1 = *(const s16x4*)vb1, hi1 = *(const s16x4*)(vb1 + 8);
                const bf16x8 vf0 = __builtin_shufflevector(lo0, hi0, 0, 1, 2, 3, 4, 5, 6, 7);
                const bf16x8 vf1 = __builtin_shufflevector(lo1, hi1, 0, 1, 2, 3, 4, 5, 6, 7);
                o0 = MFMA32(pa[k4], vf0, o0); o1 = MFMA32(pa[k4], vf1, o1);
            }
            LDS_FENCE();
        }
        __syncthreads();
    }
    const float l_tot = l_run + __shfl_xor(l_run, 32);
    if (hh == 0) AS[r] = 1.0f / l_tot;
    LDS_FENCE();
#pragma unroll
    for (int i = 0; i < 16; ++i) {
        const float inv = AS[crow(i, hh)]; const size_t row = rowbase + q0 + 32 * w + crow(i, hh);
        bf16* op = MIX + row * 1024 + h * 64 + r;
        op[0] = (bf16)(pk2(o0[i] * inv, 0.f) & 0xffffu); op[32] = (bf16)(pk2(o1[i] * inv, 0.f) & 0xffffu);
    }
    __syncthreads();
}


typedef __attribute__((address_space(3))) unsigned char lds_u8;
typedef __attribute__((address_space(3))) float lds_f32;
DI void norm_gate_store(const float* Of, const float* gain, const bf16* gate_row0, size_t gate_pitch, bf16* out_row0, int tid) {
    const int t = tid >> 3, seg = tid & 7;
    const f32x4* op = (const f32x4*)(Of + t * 128 + seg * 16);
    f32x4 o[4]; float ss = 0.f;
#pragma unroll
    for (int q = 0; q < 4; ++q) { o[q] = op[q]; ss += (o[q][0] * o[q][0] + o[q][1] * o[q][1]) + (o[q][2] * o[q][2] + o[q][3] * o[q][3]); }
    ss += __shfl_xor(ss, 1); ss += __shfl_xor(ss, 2); ss += __shfl_xor(ss, 4);
    const float rn = rsqrtf(ss * (1.0f / 128.0f) + EPS);
    const u32x4* gp = (const u32x4*)(gate_row0 + (size_t)t * gate_pitch + seg * 16);
    const u32x4 ga = gp[0], gb = gp[1];
    const f32x4* gn = (const f32x4*)(gain + seg * 16);
    u32x4 w0, w1;
#pragma unroll
    for (int q = 0; q < 4; ++q) {
        const f32x4 g4 = gn[q];
        const unsigned gw0 = q < 2 ? ga[2 * q] : gb[2 * q - 4], gw1 = q < 2 ? ga[2 * q + 1] : gb[2 * q - 3];
        const float y0 = o[q][0] * rn * g4[0] * silu_(bflo(gw0)), y1 = o[q][1] * rn * g4[1] * silu_(bfhi(gw0));
        const float y2 = o[q][2] * rn * g4[2] * silu_(bflo(gw1)), y3 = o[q][3] * rn * g4[3] * silu_(bfhi(gw1));
        if (q < 2) { w0[2 * q] = pk2(y0, y1); w0[2 * q + 1] = pk2(y2, y3); } else { w1[2 * q - 4] = pk2(y0, y1); w1[2 * q - 3] = pk2(y2, y3); }
    }
    u32x4* dst = (u32x4*)(out_row0 + (size_t)t * 1024 + seg * 16);
    dst[0] = w0; dst[1] = w1;
}

#define MFMA16(a, b, c) __builtin_amdgcn_mfma_f32_16x16x32_bf16((a), (b), (c), 0, 0, 0)
constexpr int LDH = 136, LDW = 68;
constexpr int G_QH = 0, G_KH = 17408, G_U = 0, G_VH = 34816, G_WT = 34816, G_A = 52224, G_NW = 68608, G_QD = 84992, G_KD = 101376, G_AI = 117760, G_SM = 125952;
DI bf16 f2bf(float x) { return (bf16)(pk2(x, 0.f) & 0xffffu); }
DI float dpp_xor1(float v) { return __int_as_float(__builtin_amdgcn_update_dpp(0, __float_as_int(v), 0xB1, 0xF, 0xF, true)); }
DI void norm_gate_store_pre(const float* Of, const f32x4 (&gn)[4], u32x4 ga, u32x4 gb, bf16* out_row0, int tid) {
    const int t = tid >> 3, seg = tid & 7;
    const f32x4* op = (const f32x4*)(Of + t * 128 + seg * 16);
    f32x4 o[4]; float ss = 0.f;
#pragma unroll
    for (int q = 0; q < 4; ++q) { o[q] = op[q]; ss += (o[q][0] * o[q][0] + o[q][1] * o[q][1]) + (o[q][2] * o[q][2] + o[q][3] * o[q][3]); }
    ss += __shfl_xor(ss, 1); ss += __shfl_xor(ss, 2); ss += __shfl_xor(ss, 4);
    const float rn = rsqrtf(ss * (1.0f / 128.0f) + EPS);
    u32x4 w0, w1;
#pragma unroll
    for (int q = 0; q < 4; ++q) {
        const f32x4 g4 = gn[q];
        const unsigned gw0 = q < 2 ? ga[2 * q] : gb[2 * q - 4], gw1 = q < 2 ? ga[2 * q + 1] : gb[2 * q - 3];
        const float y0 = o[q][0] * rn * g4[0] * silu_(bflo(gw0)), y1 = o[q][1] * rn * g4[1] * silu_(bfhi(gw0));
        const float y2 = o[q][2] * rn * g4[2] * silu_(bflo(gw1)), y3 = o[q][3] * rn * g4[3] * silu_(bfhi(gw1));
        if (q < 2) { w0[2 * q] = pk2(y0, y1); w0[2 * q + 1] = pk2(y2, y3); } else { w1[2 * q - 4] = pk2(y0, y1); w1[2 * q - 3] = pk2(y2, y3); }
    }
    u32x4* dst = (u32x4*)(out_row0 + (size_t)t * 1024 + seg * 16);
    dst[0] = w0; dst[1] = w1;
}
constexpr int SL_NW = 0, SL_QD = 16384, SL_KD = 32768, SL_AI = 49152, SL_UB = 55296, SL_BYTES = 71680, SL_FIRST = 1872;
DI unsigned char* gdn_slot(unsigned char* ws, int idx) { return idx < SL_FIRST ? ws + WS_XB + (size_t)idx * SL_BYTES : ws + WS_ZH + 240 * MiB + (size_t)(idx - SL_FIRST) * SL_BYTES; }
constexpr size_t WS_EGL = 381 * MiB + 262144;

DI void gdn_prep_unit(const Args& a, int idx, unsigned char* lds, const int wv_) {
    const int ch = idx & 31, h = (idx >> 5) & 3, b = idx >> 7, t0 = ch * 64;
    const bf16* Z = (const bf16*)(a.ws + WS_ZH);
    bf16* QH = (bf16*)(lds + G_QH); bf16* KH = (bf16*)(lds + G_KH); bf16* VH = (bf16*)(lds + G_VH); bf16* WT = (bf16*)(lds + G_WT); float* U = (float*)(lds + G_U); float* Am = (float*)(lds + G_A);
    unsigned char* NW = lds + G_NW; unsigned char* QD = lds + G_QD; unsigned char* KD = lds + G_KD; unsigned char* AI = lds + G_AI;
    float* Gs = (float*)(lds + G_SM); float* BETA = Gs + 64; float* EG = Gs + 128; float* BE = Gs + 192;
    int tl = TIDX(wv_); asm volatile("" : "+v"(tl));
    const int lane = tl & 63, w = tl >> 6, c0 = 2 * lane;
    const float* PAR = (const float*)(a.ws + WS_PAR); const float* convw = PAR + P_CONV;
    const float negA = -__expf(PAR[P_ALOG + h]), dtb = PAR[P_DTB + h];
    float qn[8][2], kn[8][2];
    float cwa[3][4][2];
#pragma unroll
    for (int ten = 0; ten < 3; ++ten)
#pragma unroll
        for (int jj = 0; jj < 4; ++jj) { cwa[ten][jj][0] = convw[jj * 1536 + ten * 512 + h * 128 + c0]; cwa[ten][jj][1] = convw[jj * 1536 + ten * 512 + h * 128 + c0 + 1]; }
#pragma unroll
    for (int ten = 0; ten < 3; ++ten) {
        float cw[4][2];
#pragma unroll
        for (int jj = 0; jj < 4; ++jj) { cw[jj][0] = cwa[ten][jj][0]; cw[jj][1] = cwa[ten][jj][1]; }
        unsigned pre[11];
#pragma unroll
        for (int rr = 0; rr < 11; ++rr) {
            const int t = t0 + 8 * w - 3 + rr; const int tc = t < 0 ? 0 : t;
            const unsigned u = *(const unsigned*)(Z + ((size_t)b * SEQ + tc) * N0 + 1536 + ten * 512 + h * 128 + c0);
            pre[rr] = t < 0 ? 0u : u;
        }
#pragma unroll
        for (int rr = 0; rr < 8; ++rr) {
            float y0 = 0.f, y1 = 0.f;
#pragma unroll
            for (int jj = 0; jj < 4; ++jj) { y0 += cw[jj][0] * bflo(pre[rr + jj]); y1 += cw[jj][1] * bfhi(pre[rr + jj]); }
            y0 = silu_(y0); y1 = silu_(y1);
            const int t = 8 * w + rr;
            if (ten < 2) {
                const float ss = wave_sum(y0 * y0 + y1 * y1); float sc = rsqrtf(ss + EPS);
                if (ten == 0) sc *= 0.08838834764831845f;
                y0 *= sc; y1 *= sc;
                if (ten == 0) { qn[rr][0] = y0; qn[rr][1] = y1; *(unsigned*)(QH + t * LDH + c0) = pk2(y0, y1); }
                else { kn[rr][0] = y0; kn[rr][1] = y1; *(unsigned*)(KH + t * LDH + c0) = pk2(y0, y1); }
            } else {
                *(unsigned*)(VH + t * LDH + c0) = pk2(y0, y1);
            }
        }
    }
    if (w == 0) {
        const size_t m = (size_t)b * SEQ + t0 + lane;
        const float gb = bf2f(Z[m * N0 + 3592 + h]), ga = bf2f(Z[m * N0 + 3596 + h]);
        float la = negA * softplus_(ga + dtb);
#pragma unroll
        for (int o = 1; o < 64; o <<= 1) { const float y = __shfl_up(la, o); if (lane >= o) la += y; }
        const float be = sigmoid_(gb), eg = __expf(la);
        Gs[lane] = la; BETA[lane] = be; EG[lane] = eg; BE[lane] = be * eg;
        if (lane == 63) ((float*)(a.ws + WS_EGL))[idx] = eg;
    }
    __syncthreads();
    {
        const int fr = lane & 15, fq = lane >> 4, tb = w >> 1;
#pragma unroll
        for (int si = 0; si < 2; ++si) {
            const int sb = 2 * (w & 1) + si; f32x4 akk = {0.f, 0.f, 0.f, 0.f}, aqk = {0.f, 0.f, 0.f, 0.f};
#pragma unroll
            for (int kk = 0; kk < 4; ++kk) {
                const bf16x8 kt = *(const bf16x8*)(KH + (16 * tb + fr) * LDH + kk * 32 + fq * 8);
                const bf16x8 qt = *(const bf16x8*)(QH + (16 * tb + fr) * LDH + kk * 32 + fq * 8);
                const bf16x8 ks_ = *(const bf16x8*)(KH + (16 * sb + fr) * LDH + kk * 32 + fq * 8);
                akk = MFMA16(kt, ks_, akk); aqk = MFMA16(qt, ks_, aqk);
            }
#pragma unroll
            for (int jj = 0; jj < 4; ++jj) {
                const int t = 16 * tb + 4 * fq + jj, s2 = 16 * sb + fr;
                const float dec = __expf(fminf(Gs[t] - Gs[s2], 0.f));
                Am[(s2 & 1) * 2048 + t * 32 + (s2 >> 1)] = s2 < t ? BETA[t] * akk[jj] * dec : 0.f;
                const float qkv = s2 <= t ? aqk[jj] * dec : 0.f;
                const int x = s2 & 15, hp = (x >> 2) & 1, j = ((x >> 3) << 2) | (x & 3);
                const int off = ((((t >> 5) * 4 + (s2 >> 4)) * 64) + hp * 32 + (t & 31)) * 16 + j * 2;
                *(bf16*)(AI + off) = f2bf(qkv);
            }
        }
        const float gl = Gs[63];
#pragma unroll
        for (int rr = 0; rr < 8; ++rr) {
            const int t = 8 * w + rr; const float eg = EG[t], ekd = __expf(gl - Gs[t]);
            {
                const int ks = c0 >> 4, x = c0 & 15, hp = (x >> 2) & 1, j = ((x >> 3) << 2) | (x & 3);
                const int off = ((((t >> 5) * 8 + ks) * 64) + hp * 32 + (t & 31)) * 16 + j * 2;
                *(unsigned*)(QD + off) = pk2(qn[rr][0] * eg, qn[rr][1] * eg);
            }
#pragma unroll
            for (int e = 0; e < 2; ++e) {
                const int dk = c0 + e, x = t & 15, hp = (x >> 2) & 1, j = ((x >> 3) << 2) | (x & 3);
                const int off = ((((dk >> 5) * 4 + (t >> 4)) * 64) + hp * 32 + (dk & 31)) * 16 + j * 2;
                *(bf16*)(KD + off) = f2bf(kn[rr][e] * ekd);
            }
        }
    }
    __syncthreads();
    unsigned char* slot = gdn_slot(a.ws, idx);
    {
#pragma unroll
        for (int k2 = 0; k2 < 2; ++k2) {
            const int q = tl + 512 * k2;
            __builtin_nontemporal_store(*(const u32x4*)(QD + q * 16), (u32x4*)(slot + SL_QD + q * 16));
            __builtin_nontemporal_store(*(const u32x4*)(KD + q * 16), (u32x4*)(slot + SL_KD + q * 16));
        }
        if (tl < 384) { const int src_off = tl < 128 ? tl * 16 : 4096 + (tl - 128) * 16; __builtin_nontemporal_store(*(const u32x4*)(AI + src_off), (u32x4*)(slot + SL_AI + tl * 16)); }
    }
    {
        const int c = tl >> 1, p = tl & 1;
        const float* Ap = Am + p * 2048;
        const float* scl = c < 128 ? BETA : BE;
        const bf16* src = c < 128 ? VH + c : KH + (c - 128);
        float xm[32];
#pragma unroll
        for (int i = 0; i < 32; ++i) xm[i] = 0.f;
        f32x4 ab[2][8]; float rh[2];
        rh[0] = scl[0] * bf2f(src[0]);
#pragma unroll
        for (int t = 0; t < 64; ++t) {
            if (t + 1 < 64) {
#pragma unroll
                for (int i4 = 0; i4 < (((t + 2) / 2) + 3) / 4; ++i4) ab[(t + 1) & 1][i4] = *(const f32x4*)(Ap + (t + 1) * 32 + 4 * i4);
                rh[(t + 1) & 1] = scl[t + 1] * bf2f(src[(t + 1) * LDH]);
            }
            __builtin_amdgcn_sched_barrier(0);
            float acc0 = 0.f, acc1 = 0.f;
#pragma unroll
            for (int i4 = 0; i4 < (((t + 1) / 2) + 3) / 4; ++i4) {
                const f32x4 a4 = ab[t & 1][i4];
                acc0 += a4[0] * xm[4 * i4];
                if (2 * (4 * i4 + 1) < t) acc1 += a4[1] * xm[4 * i4 + 1];
                if (2 * (4 * i4 + 2) < t) acc0 += a4[2] * xm[4 * i4 + 2];
                if (2 * (4 * i4 + 3) < t) acc1 += a4[3] * xm[4 * i4 + 3];
            }
            const float part = acc0 + acc1;
            const float xt = rh[t & 1] - (part + dpp_xor1(part));
            xm[t >> 1] = (p == (t & 1)) ? xt : xm[t >> 1];
            __builtin_amdgcn_sched_barrier(0);
        }
        __syncthreads();
        if (c < 128) {
#pragma unroll
            for (int i = 0; i < 32; ++i) U[(2 * i + p) * 128 + c] = xm[i];
        } else {
            const int dk = c - 128;
#pragma unroll
            for (int i = 0; i < 32; ++i) {
                const float other = dpp_xor1(xm[i]);
                const float lo = p ? other : xm[i], hi = p ? xm[i] : other;
                if ((i & 1) == 0) { if (p == 0) *(unsigned*)(WT + dk * LDW + 2 * i) = pk2(-lo, -hi); }
                else { if (p == 1) *(unsigned*)(WT + dk * LDW + 2 * i) = pk2(-lo, -hi); }
            }
        }
    }
    __syncthreads();
#pragma unroll
    for (int k2 = 0; k2 < 2; ++k2) {
        const int q = tl + 512 * k2, f = q >> 6, lp = q & 63, hp = lp >> 5, rp = lp & 31;
        const int t = 32 * (f >> 3) + rp, dkb = 16 * (f & 7) + 4 * hp;
        u32x4 o;
        o[0] = (unsigned)WT[(dkb + 0) * LDW + t] | ((unsigned)WT[(dkb + 1) * LDW + t] << 16);
        o[1] = (unsigned)WT[(dkb + 2) * LDW + t] | ((unsigned)WT[(dkb + 3) * LDW + t] << 16);
        o[2] = (unsigned)WT[(dkb + 8) * LDW + t] | ((unsigned)WT[(dkb + 9) * LDW + t] << 16);
        o[3] = (unsigned)WT[(dkb + 10) * LDW + t] | ((unsigned)WT[(dkb + 11) * LDW + t] << 16);
        __builtin_nontemporal_store(o, (u32x4*)(slot + SL_NW + q * 16));
    }
    {
        const int dq = tl >> 7, tt = (tl >> 6) & 1, lp = tl & 63, hp = lp >> 5, rp = lp & 31;
        const float* ub = U + (32 * tt + 4 * hp) * 128 + 32 * dq + rp;
        u32x4 o0, o1;
#pragma unroll
        for (int e = 0; e < 4; ++e) {
            const int i0 = 2 * e, i1 = 2 * e + 1, i2 = 8 + 2 * e, i3 = 9 + 2 * e;
            o0[e] = pk2(ub[((i0 & 3) + 8 * (i0 >> 2)) * 128], ub[((i1 & 3) + 8 * (i1 >> 2)) * 128]);
            o1[e] = pk2(ub[((i2 & 3) + 8 * (i2 >> 2)) * 128], ub[((i3 & 3) + 8 * (i3 >> 2)) * 128]);
        }
        u32x4* dst = (u32x4*)(slot + SL_UB + tl * 32);
        __builtin_nontemporal_store(o0, dst); __builtin_nontemporal_store(o1, dst + 1);
    }
    __syncthreads();
}

DI void gdn_scan_unit(const Args& a, int bh, unsigned char* lds, const int wv_) {
    const bf16* Z = (const bf16*)(a.ws + WS_ZH); bf16* MIX = (bf16*)(a.ws + WS_MIX);
    const float* PAR = (const float*)(a.ws + WS_PAR); const float* EGL = (const float*)(a.ws + WS_EGL);
    const int b = bh >> 2, h = bh & 3;
    int tid = TIDX(wv_); asm volatile("" : "+v"(tid));
    f32x16 S[4];
#pragma unroll
    for (int kb = 0; kb < 4; ++kb)
#pragma unroll
        for (int i = 0; i < 16; ++i) S[kb][i] = 0.f;
    {
        const unsigned char* sl = gdn_slot(a.ws, bh * 32);
        for (int q = tid; q < SL_BYTES / 16; q += 512) *(u32x4*)(lds + q * 16) = __builtin_nontemporal_load((const u32x4*)(sl + q * 16));
    }
    __syncthreads();
    u32x4 gate_na, gate_nb; float egl_n;
    {
        const u32x4* gp0 = (const u32x4*)(Z + ((size_t)b * SEQ + (tid >> 3)) * N0 + 3072 + h * 128 + (tid & 7) * 16);
        gate_na = gp0[0]; gate_nb = gp0[1]; egl_n = EGL[bh * 32];
    }
#pragma unroll 1
    for (int ch = 0; ch < 32; ++ch) {
        int tl = tid; asm volatile("" : "+v"(tl));
        const int lane = tl & 63, w = tl >> 6, r = lane & 31, hh = lane >> 5, dq = w & 3;
        const int idx = bh * 32 + ch;
        const unsigned cur = (ch & 1) * SL_BYTES, nxt = ((ch + 1) & 1) * SL_BYTES;
        const u32x4 gate_a = gate_na, gate_b = gate_nb; const float egl = egl_n;
        f32x4 gng[4];
#pragma unroll
        for (int q = 0; q < 4; ++q) gng[q] = *(const f32x4*)(PAR + P_GON + (tl & 7) * 16 + 4 * q);
        f32x16 O0, O1;
        if (w >= 4) {
            if (ch < 31) {
                const unsigned char* sl = gdn_slot(a.ws, idx + 1) + (tl - 256) * 16;
                unsigned char* dl = lds + nxt + (tl - 256) * 16;
#pragma unroll
                for (int k0 = 0; k0 < 18; k0 += 6) {
                    u32x4 stage[6];
#pragma unroll
                    for (int k = 0; k < 6; ++k) { if (k0 + k < 17 || tl - 256 < 128) stage[k] = __builtin_nontemporal_load((const u32x4*)(sl + (k0 + k) * 4096)); }
#pragma unroll
                    for (int k = 0; k < 6; ++k) { if (k0 + k < 17 || tl - 256 < 128) *(u32x4*)(dl + (k0 + k) * 4096) = stage[k]; }
                }
            }
        } else {
            lds_u8* l3 = (lds_u8*)lds;
            unsigned fo = cur + lane * 16; asm volatile("" : "+v"(fo)); const lds_u8* fp = l3 + fo;
#define LFRAG(o_) (*(const __attribute__((address_space(3))) bf16x8*)(fp + (o_)))
            bf16x8 xs[8];
#pragma unroll
            for (int kb = 0; kb < 4; ++kb)
#pragma unroll
                for (int s2 = 0; s2 < 2; ++s2) {
                    u32x4 t4;
#pragma unroll
                    for (int e = 0; e < 4; ++e) t4[e] = pk2(S[kb][8 * s2 + 2 * e], S[kb][8 * s2 + 2 * e + 1]);
                    xs[2 * kb + s2] = __builtin_bit_cast(bf16x8, t4);
                }
            f32x16 V0, V1;
            {
                const __attribute__((address_space(3))) u32x4* up = (const __attribute__((address_space(3))) u32x4*)(l3 + cur + SL_UB + ((dq * 2) * 64 + lane) * 32);
                const u32x4 a0 = up[0], a1 = up[1], b0 = up[128], b1 = up[129];
#pragma unroll
                for (int e = 0; e < 4; ++e) {
                    V0[2 * e] = bflo(a0[e]); V0[2 * e + 1] = bfhi(a0[e]); V0[8 + 2 * e] = bflo(a1[e]); V0[9 + 2 * e] = bfhi(a1[e]);
                    V1[2 * e] = bflo(b0[e]); V1[2 * e + 1] = bfhi(b0[e]); V1[8 + 2 * e] = bflo(b1[e]); V1[9 + 2 * e] = bfhi(b1[e]);
                }
            }
#pragma unroll
            for (int i = 0; i < 16; ++i) { O0[i] = 0.f; O1[i] = 0.f; }
#pragma unroll
            for (int ks = 0; ks < 8; ++ks) {
                V0 = MFMA32(LFRAG(SL_NW + (0 * 8 + ks) * 1024), xs[ks], V0);
                V1 = MFMA32(LFRAG(SL_NW + (1 * 8 + ks) * 1024), xs[ks], V1);
                O0 = MFMA32(LFRAG(SL_QD + (0 * 8 + ks) * 1024), xs[ks], O0);
                O1 = MFMA32(LFRAG(SL_QD + (1 * 8 + ks) * 1024), xs[ks], O1);
            }
            bf16x8 vx[4];
#pragma unroll
            for (int s2 = 0; s2 < 2; ++s2) {
                u32x4 t4, t5;
#pragma unroll
                for (int e = 0; e < 4; ++e) { t4[e] = pk2(V0[8 * s2 + 2 * e], V0[8 * s2 + 2 * e + 1]); t5[e] = pk2(V1[8 * s2 + 2 * e], V1[8 * s2 + 2 * e + 1]); }
                vx[s2] = __builtin_bit_cast(bf16x8, t4); vx[2 + s2] = __builtin_bit_cast(bf16x8, t5);
            }
#pragma unroll
            for (int ks = 0; ks < 2; ++ks) O0 = MFMA32(LFRAG(SL_AI + ks * 1024), vx[ks], O0);
#pragma unroll
            for (int ks = 0; ks < 4; ++ks) O1 = MFMA32(LFRAG(SL_AI + 2048 + ks * 1024), vx[ks], O1);
#pragma unroll
            for (int kb = 0; kb < 4; ++kb) {
#pragma unroll
                for (int i = 0; i < 16; ++i) S[kb][i] *= egl;
#pragma unroll
                for (int ks = 0; ks < 4; ++ks) S[kb] = MFMA32(LFRAG(SL_KD + (kb * 4 + ks) * 1024), vx[ks], S[kb]);
            }
#undef LFRAG
        }
        __syncthreads();
        if (w < 4) {
            unsigned obo = cur + ((4 * hh) * 128 + 32 * dq + r) * 4; asm volatile("" : "+v"(obo)); lds_f32* ob = (lds_f32*)((lds_u8*)lds + obo);
#pragma unroll
            for (int i = 0; i < 16; ++i) { ob[((i & 3) + 8 * (i >> 2)) * 128] = O0[i]; ob[(32 + (i & 3) + 8 * (i >> 2)) * 128] = O1[i]; }
        }
        __syncthreads();
        {
            const int cn = ch < 31 ? ch + 1 : ch;
            const u32x4* gpn = (const u32x4*)(Z + ((size_t)b * SEQ + cn * 64 + (tl >> 3)) * N0 + 3072 + h * 128 + (tl & 7) * 16);
            gate_na = gpn[0]; gate_nb = gpn[1]; egl_n = EGL[bh * 32 + cn];
        }
        norm_gate_store_pre((const float*)(lds + cur), gng, gate_a, gate_b, MIX + ((size_t)b * SEQ + ch * 64) * 1024 + 512 + h * 128, tl);
        __syncthreads();
    }
}

constexpr int L_QD = 0, L_KD = 16384, L_AI = 32768, L_VF = 40960, L_DEC = 57344, L_BF = 57856, L_QH = 90624, L_KH = 108032;
DI void hgrn_unit(const Args& a, int b, int h, unsigned char* lds, const int wv_) {
    const bf16* Z = (const bf16*)(a.ws + WS_ZH); bf16* MIX = (bf16*)(a.ws + WS_MIX);
    unsigned char* QD = lds + L_QD; unsigned char* KD = lds + L_KD; unsigned char* AI = lds + L_AI; unsigned char* VF = lds + L_VF;
    float* DEC = (float*)(lds + L_DEC); float* Bf = (float*)(lds + L_BF); bf16* QH = (bf16*)(lds + L_QH); bf16* KH = (bf16*)(lds + L_KH);
    float* TOT = (float*)(lds + L_KH + 17408);
    int tid = TIDX(wv_); asm volatile("" : "+v"(tid));
    const float* PAR = (const float*)(a.ws + WS_PAR); const float* lbl = PAR + P_LB;
    f32x16 S[4];
#pragma unroll
    for (int kb = 0; kb < 4; ++kb)
#pragma unroll
        for (int i = 0; i < 16; ++i) S[kb][i] = 0.f;
    unsigned pq[8], pf[8], pi[8];
    float lb0, lb1;
    {
        const int lane = tid & 63, w = tid >> 6, cg0 = h * 128 + 2 * lane;
        lb0 = 1.0f / (1.0f + __expf(lbl[cg0] - lbl[1024 + cg0])); lb1 = 1.0f / (1.0f + __expf(lbl[cg0 + 1] - lbl[1024 + cg0 + 1]));
#pragma unroll
        for (int rr = 0; rr < 8; ++rr) {
            const bf16* zp = Z + ((size_t)b * SEQ + 8 * w + rr) * 4096 + cg0;
            pq[rr] = *(const unsigned*)zp; pf[rr] = *(const unsigned*)(zp + 1024); pi[rr] = *(const unsigned*)(zp + 2048);
        }
    }
#pragma unroll 1
    for (int ch = 0; ch < 32; ++ch) {
        const int t0 = ch * 64;
        int tl = tid; asm volatile("" : "+v"(tl));
        const int lane = tl & 63, w = tl >> 6, r = lane & 31, hh = lane >> 5, c0 = 2 * lane, cg0 = h * 128 + c0;
        float qv[8][2], kv[8][2], Bl[8][2];
        {
            float run0 = 0.f, run1 = 0.f;
#pragma unroll
            for (int rr = 0; rr < 8; ++rr) {
                const int t = 8 * w + rr;
                const unsigned uq = pq[rr], uf = pf[rr], ui = pi[rr];
                qv[rr][0] = silu_(bflo(uq)); qv[rr][1] = silu_(bfhi(uq));
                const float f0 = lb0 + (1.f - lb0) * sigmoid_(bflo(uf)), f1 = lb1 + (1.f - lb1) * sigmoid_(bfhi(uf));
                kv[rr][0] = 1.f - f0; kv[rr][1] = 1.f - f1;
                run0 += __logf(f0); run1 += __logf(f1);
                Bl[rr][0] = run0; Bl[rr][1] = run1;
#pragma unroll
                for (int e = 0; e < 2; ++e) {
                    const int dv = c0 + e; const int off = ((((dv >> 5) * 4 + (t >> 4)) * 64) + ((t >> 3) & 1) * 32 + (dv & 31)) * 16 + (t & 7) * 2;
                    *(bf16*)(VF + off) = (bf16)(e ? (ui >> 16) : (ui & 0xffffu));
                }
            }
            TOT[w * 128 + c0] = run0; TOT[w * 128 + c0 + 1] = run1;
        }
        {
            const int tn = (ch < 31 ? t0 + 64 : t0);
#pragma unroll
            for (int rr = 0; rr < 8; ++rr) {
                const bf16* zp = Z + ((size_t)b * SEQ + tn + 8 * w + rr) * 4096 + cg0;
                pq[rr] = *(const unsigned*)zp; pf[rr] = *(const unsigned*)(zp + 1024); pi[rr] = *(const unsigned*)(zp + 2048);
            }
        }
        const u32x4* gatep = (const u32x4*)(Z + ((size_t)b * SEQ + t0 + (tl >> 3)) * 4096 + 3072 + h * 128 + (tl & 7) * 16);
        const u32x4 gate_a = gatep[0], gate_b = gatep[1];

        __syncthreads();
        {
            float off0 = 0.f, off1 = 0.f, bm0 = 0.f, bm1 = 0.f, bl0 = 0.f, bl1 = 0.f;
#pragma unroll
            for (int ww = 0; ww < 8; ++ww) {
                const float t0v = TOT[ww * 128 + c0], t1v = TOT[ww * 128 + c0 + 1];
                if (ww < w) { off0 += t0v; off1 += t1v; }
                if (ww < 4) { bm0 += t0v; bm1 += t1v; }
                bl0 += t0v; bl1 += t1v;
            }
            if (w == 0) { DEC[c0] = __expf(bl0); DEC[c0 + 1] = __expf(bl1); }
#pragma unroll
            for (int rr = 0; rr < 8; ++rr) {
                const int t = 8 * w + rr;
                const float B0 = Bl[rr][0] + off0, B1 = Bl[rr][1] + off1;
                const float qd0 = qv[rr][0] * __expf(B0), qd1 = qv[rr][1] * __expf(B1);
                const float qh0 = qv[rr][0] * __expf(fminf(B0 - bm0, 80.f)), qh1 = qv[rr][1] * __expf(fminf(B1 - bm1, 80.f));
                const float kh0 = kv[rr][0] * __expf(fminf(bm0 - B0, 80.f)), kh1 = kv[rr][1] * __expf(fminf(bm1 - B1, 80.f));
                const float kd0 = kv[rr][0] * __expf(bl0 - B0), kd1 = kv[rr][1] * __expf(bl1 - B1);
                {
                    const int ks = c0 >> 4, x = c0 & 15, hp = (x >> 2) & 1, j = ((x >> 3) << 2) | (x & 3);
                    const int off = ((((t >> 5) * 8 + ks) * 64) + hp * 32 + (t & 31)) * 16 + j * 2;
                    *(unsigned*)(QD + off) = pk2(qd0, qd1);
                }
#pragma unroll
                for (int e = 0; e < 2; ++e) {
                    const int dk = c0 + e; const int off = ((((dk >> 5) * 4 + (t >> 4)) * 64) + ((t >> 3) & 1) * 32 + (dk & 31)) * 16 + (t & 7) * 2;
                    *(bf16*)(KD + off) = f2bf(e ? kd1 : kd0);
                }
                *(unsigned*)(QH + t * LDH + c0) = pk2(qh0, qh1);
                *(unsigned*)(KH + t * LDH + c0) = pk2(kh0, kh1);
            }
        }
        __syncthreads();
        {
            const int fr = lane & 15, fq = lane >> 4, tb = w >> 1;
#pragma unroll
            for (int si = 0; si < 2; ++si) {
                const int sb = 2 * (w & 1) + si; f32x4 acc = {0.f, 0.f, 0.f, 0.f};
#pragma unroll
                for (int kk = 0; kk < 4; ++kk) {
                    const bf16x8 av = *(const bf16x8*)(QH + (16 * tb + fr) * LDH + kk * 32 + fq * 8);
                    const bf16x8 bv = *(const bf16x8*)(KH + (16 * sb + fr) * LDH + kk * 32 + fq * 8);
                    acc = MFMA16(av, bv, acc);
                }
#pragma unroll
                for (int jj = 0; jj < 4; ++jj) {
                    const int t = 16 * tb + 4 * fq + jj, s2 = 16 * sb + fr;
                    const float val = s2 <= t ? acc[jj] : 0.f;
                    const int off = ((((t >> 5) * 4 + (s2 >> 4)) * 64) + ((s2 >> 3) & 1) * 32 + (t & 31)) * 16 + (s2 & 7) * 2;
                    *(bf16*)(AI + off) = f2bf(val);
                }
            }
        }
        __syncthreads();
        if (w < 4) {
            const int dq = w;
            bf16x8 xs[8];
#pragma unroll
            for (int kb = 0; kb < 4; ++kb)
#pragma unroll
                for (int s2 = 0; s2 < 2; ++s2) {
                    u32x4 t4;
#pragma unroll
                    for (int e = 0; e < 4; ++e) t4[e] = pk2(S[kb][8 * s2 + 2 * e], S[kb][8 * s2 + 2 * e + 1]);
                    xs[2 * kb + s2] = __builtin_bit_cast(bf16x8, t4);
                }
            f32x16 O0, O1;
            unsigned obo = L_BF + ((4 * hh) * 128 + 32 * dq + r) * 4; asm volatile("" : "+v"(obo)); lds_f32* ob = (lds_f32*)((lds_u8*)lds + obo);
#pragma unroll
            for (int i = 0; i < 16; ++i) { O0[i] = 0.f; O1[i] = 0.f; }
            lds_u8* l3 = (lds_u8*)lds; unsigned fo = lane * 16; asm volatile("" : "+v"(fo)); const lds_u8* fp = l3 + fo;
#define HF(o_) (*(const __attribute__((address_space(3))) bf16x8*)(fp + (o_)))
#define SB() __builtin_amdgcn_sched_barrier(0)
            bf16x8 ga[8], gb[8];
#pragma unroll
            for (int k = 0; k < 4; ++k) { ga[k] = HF(L_QD + (0 * 8 + k) * 1024); ga[4 + k] = HF(L_QD + (1 * 8 + k) * 1024); }
#pragma unroll
            for (int k = 0; k < 4; ++k) { gb[k] = HF(L_QD + (0 * 8 + 4 + k) * 1024); gb[4 + k] = HF(L_QD + (1 * 8 + 4 + k) * 1024); }
            SB();
#pragma unroll
            for (int k = 0; k < 4; ++k) { O0 = MFMA32(ga[k], xs[k], O0); O1 = MFMA32(ga[4 + k], xs[k], O1); }
            SB();
#pragma unroll
            for (int k = 0; k < 4; ++k) ga[k] = HF(L_VF + (dq * 4 + k) * 1024);
            ga[4] = HF(L_AI + (0 * 4 + 0) * 1024); ga[5] = HF(L_AI + (0 * 4 + 1) * 1024); ga[6] = HF(L_AI + (1 * 4 + 0) * 1024); ga[7] = HF(L_AI + (1 * 4 + 1) * 1024);
            SB();
#pragma unroll
            for (int k = 0; k < 4; ++k) { O0 = MFMA32(gb[k], xs[4 + k], O0); O1 = MFMA32(gb[4 + k], xs[4 + k], O1); }
            SB();
            gb[0] = HF(L_AI + (1 * 4 + 2) * 1024); gb[1] = HF(L_AI + (1 * 4 + 3) * 1024);
#pragma unroll
            for (int k = 0; k < 4; ++k) gb[2 + k] = HF(L_KD + (0 * 4 + k) * 1024);
            f32x4 dd[4];
#define LDD(kb_) do { _Pragma("unroll") for (int g = 0; g < 4; ++g) dd[g] = *(const f32x4*)(DEC + 32 * (kb_) + 8 * g + 4 * hh); } while (0)
#define MULD(kb_) do { _Pragma("unroll") for (int g = 0; g < 4; ++g) _Pragma("unroll") for (int e = 0; e < 4; ++e) S[kb_][4 * g + e] *= dd[g][e]; } while (0)
            LDD(0);
            SB();
            const bf16x8 vf0 = ga[0], vf1 = ga[1], vf2 = ga[2], vf3 = ga[3];
            O0 = MFMA32(ga[4], vf0, O0); O0 = MFMA32(ga[5], vf1, O0); O1 = MFMA32(ga[6], vf0, O1); O1 = MFMA32(ga[7], vf1, O1);
            SB();
#pragma unroll
            for (int k = 0; k < 4; ++k) ga[4 + k] = HF(L_KD + (1 * 4 + k) * 1024);
            SB();
            O1 = MFMA32(gb[0], vf2, O1); O1 = MFMA32(gb[1], vf3, O1);
            MULD(0);
            S[0] = MFMA32(gb[2], vf0, S[0]); S[0] = MFMA32(gb[3], vf1, S[0]); S[0] = MFMA32(gb[4], vf2, S[0]); S[0] = MFMA32(gb[5], vf3, S[0]);
            SB();
            LDD(1);
#pragma unroll
            for (int k = 0; k < 4; ++k) gb[k] = HF(L_KD + (2 * 4 + k) * 1024);
            SB();
            MULD(1);
            S[1] = MFMA32(ga[4], vf0, S[1]); S[1] = MFMA32(ga[5], vf1, S[1]); S[1] = MFMA32(ga[6], vf2, S[1]); S[1] = MFMA32(ga[7], vf3, S[1]);
            SB();
            LDD(2);
#pragma unroll
            for (int k = 0; k < 4; ++k) ga[4 + k] = HF(L_KD + (3 * 4 + k) * 1024);
            SB();
            MULD(2);
            S[2] = MFMA32(gb[0], vf0, S[2]); S[2] = MFMA32(gb[1], vf1, S[2]); S[2] = MFMA32(gb[2], vf2, S[2]); S[2] = MFMA32(gb[3], vf3, S[2]);
            SB();
            LDD(3);
            SB();
            MULD(3);
            S[3] = MFMA32(ga[4], vf0, S[3]); S[3] = MFMA32(ga[5], vf1, S[3]); S[3] = MFMA32(ga[6], vf2, S[3]); S[3] = MFMA32(ga[7], vf3, S[3]);
#undef LDD
#undef MULD
#undef HF
#undef SB
#pragma unroll
            for (int i = 0; i < 16; ++i) { ob[((i & 3) + 8 * (i >> 2)) * 128] = O0[i]; ob[(32 + (i & 3) + 8 * (i >> 2)) * 128] = O1[i]; }
        }
        f32x4 gnh[4];
#pragma unroll
        for (int q = 0; q < 4; ++q) gnh[q] = *(const f32x4*)(PAR + P_HON + (tl & 7) * 16 + 4 * q);
        __syncthreads();
        norm_gate_store_pre(Bf, gnh, gate_a, gate_b, MIX + ((size_t)b * SEQ + t0) * 1024 + h * 128, tl);
    }
    __syncthreads();
}

#define LAS __attribute__((address_space(3)))
#define XB_TMO      128
#define XB_XCNT(j)  (256  + 64 * (j))
#define XB_XSUB(j)  (1280 + 64 * (j))
#define XB_XGEN(j)  (2304 + 64 * (j))
#define XB_TOP      3328
#define XB_TOPGEN   3392
#define XCD_BAR_WORDS 3456
#define XB_SPIN_CAP (1u << 18)

__device__ __forceinline__ unsigned xb_ld(unsigned* p)              { return __hip_atomic_load(p, __ATOMIC_RELAXED, __HIP_MEMORY_SCOPE_AGENT); }
__device__ __forceinline__ unsigned xb_add(unsigned* p, unsigned v) { return __hip_atomic_fetch_add(p, v, __ATOMIC_RELAXED, __HIP_MEMORY_SCOPE_AGENT); }
__device__ __forceinline__ unsigned xb_xcc_id() { return (unsigned)__builtin_amdgcn_s_getreg((3 << 11) | 20) & 0xFu; }
#define XB_SPIN(cond, bar) do { unsigned _sp = 0; while (cond) { __builtin_amdgcn_s_sleep(1); \
    if ((++_sp & 255u) == 0u) { if (xb_ld(&(bar)[XB_TMO])) break; if (_sp > XB_SPIN_CAP) { atomicAdd(&(bar)[XB_TMO], 1u); break; } } } } while (0)

struct XcdBarrier {
    unsigned* bar; unsigned x;
    volatile LAS unsigned* st;
};

__device__ __forceinline__ XcdBarrier xcd_barrier_post(unsigned* bar, volatile LAS unsigned* st, const bool t0_) {
    XcdBarrier b; b.bar = bar; b.x = xb_xcc_id(); b.st = st;
    if (t0_) (void)xb_add(&bar[XB_XCNT(b.x)], 1u);
    return b;
}
__device__ __forceinline__ void xcd_barrier_complete(unsigned* bar, unsigned x, unsigned& nloc, unsigned& nx) {
    const unsigned G = gridDim.x * gridDim.y * gridDim.z;
    unsigned sum, cnt, mine, sp = 0u;
    for (;;) {
        sum = 0u; cnt = 0u; mine = 0u;
#pragma unroll
        for (unsigned j = 0; j < 16; ++j) { const unsigned c = xb_ld(&bar[XB_XCNT(j)]); sum += c; cnt += (c > 0u) ? 1u : 0u; mine = (j == x) ? c : mine; }
        if (sum == G) break;
        __builtin_amdgcn_s_sleep(1);
        if ((++sp & 255u) == 0u) { if (xb_ld(&bar[XB_TMO])) break; if (sp > XB_SPIN_CAP) { atomicAdd(&bar[XB_TMO], 1u); break; } }
    }
    nloc = mine > 0u ? mine : 1u; nx = cnt > 0u ? cnt : 1u;
}

__device__ __forceinline__ void xcd_barrier(const XcdBarrier& b, const bool t0_) {
    asm volatile("s_waitcnt vmcnt(0)" ::: "memory");
    __syncthreads();
    if (t0_) {
        unsigned* bar = b.bar;
        __builtin_amdgcn_s_waitcnt(0);
        unsigned nloc = b.st[0], nx = b.st[1];
        if (nloc == 0u) { xcd_barrier_complete(bar, b.x, nloc, nx); b.st[0] = nloc; b.st[1] = nx; }
        const unsigned old = xb_add(&bar[XB_XSUB(b.x)], 1u);
        const unsigned gen = old / nloc;
        if (old + 1u == (gen + 1u) * nloc) {
            __builtin_amdgcn_fence(__ATOMIC_RELEASE, "agent");
            asm volatile("s_waitcnt vmcnt(0)" ::: "memory");
            const unsigned og = xb_add(&bar[XB_TOP], 1u);
            const unsigned tg = og / nx;
            if (og + 1u == (tg + 1u) * nx) xb_add(&bar[XB_TOPGEN], 1u);
            else XB_SPIN(xb_ld(&bar[XB_TOPGEN]) == tg, bar);
            __builtin_amdgcn_fence(__ATOMIC_ACQUIRE, "agent");
            xb_add(&bar[XB_XGEN(b.x)], 1u);
            asm volatile("s_waitcnt vmcnt(0)" ::: "memory");
        } else {
            XB_SPIN(xb_ld(&bar[XB_XGEN(b.x)]) == gen, bar);
            __builtin_amdgcn_fence(__ATOMIC_ACQUIRE, "agent");
            asm volatile("s_waitcnt vmcnt(0)" ::: "memory");
        }
    }
    __syncthreads();
}

__global__ void __launch_bounds__(512, 2) trunk_fwd(Args a) {
    extern __shared__ __attribute__((aligned(16))) unsigned char lds[];
    __builtin_assume(__builtin_amdgcn_workitem_id_y() == 0); __builtin_assume(__builtin_amdgcn_workitem_id_z() == 0);
    cg::grid_group grid = cg::this_grid();
    const int G = gridDim.x, blk = blockIdx.x;
    unsigned char* ws = a.ws;
    PG8_LAS unsigned char* lds3 = (PG8_LAS unsigned char*)lds;
    bf16* XB = (bf16*)(ws + WS_XB); bf16* MIX = (bf16*)(ws + WS_MIX); bf16* ZH = (bf16*)(ws + WS_ZH); float* SS = (float*)(ws + WS_SS);

    volatile LAS unsigned* bst = (volatile LAS unsigned*)((LAS unsigned char*)lds + (LDS_BYTES - 64));
    const int WV = __builtin_amdgcn_readfirstlane((int)(threadIdx.x >> 6));
    if (WV == 0 && lane_id_() == 0) { bst[0] = 0u; bst[1] = 0u; }
    __syncthreads();
    (void)xcd_barrier_post((unsigned*)(ws + WS_BAR), bst, WV == 0 && lane_id_() == 0);
#define GRID_BAR() do { unsigned char* wsl_ = a.ws; asm volatile("" : "+s"(wsl_)); XcdBarrier xb_; xb_.bar = (unsigned*)(wsl_ + WS_BAR); xb_.x = xb_xcc_id(); xb_.st = (volatile LAS unsigned*)((LAS unsigned char*)lds + (LDS_BYTES - 64)); xcd_barrier(xb_, WV == 0 && lane_id_() == 0); } while (0)
    p0_prologue(a, lds, WV);
    if (a.ws == nullptr) grid.sync();
    GRID_BAR();
    _Pragma("unroll") for (int layer = 0; layer < 2; ++layer) {
        const int NIN = layer == 0 ? N0 : 4096;
        if (layer == 0) {
            pg8::Gemm g{XB, (const bf16*)(ws + WS_W0IN), M, N0, 1024}; int blkl = blk; asm volatile("" : "+s"(blkl)); pg8::StaticOrder S; S.init(M, N0, G, blkl, WGM_WIDE);
            rs_table_build<true>(lds, SS, S, WV);
            EpiAct<2> E{ZH, N0, (const float*)(ws + WS_PAR), (const lds_f32_t*)((PG8_LAS unsigned char*)lds + RS_OFF), 0};
            pg8::gemm_phase<EpiAct<2>, pg8::StaticOrder, true, true>(lds3, g, S, E, WV);
        } else {
            pg8::Gemm g{XB, (const bf16*)(ws + WS_W1IN), M, 4096, 1024}; int blkl = blk; asm volatile("" : "+s"(blkl)); pg8::StaticOrder S; S.init(M, 4096, G, blkl, WGM_WIDE);
            rs_table_build<false>(lds, SS + (size_t)2 * SS_STRIDE, S, WV);
            EpiAct<0> E{ZH, 4096, nullptr, (const lds_f32_t*)((PG8_LAS unsigned char*)lds + RS_OFF), 0};
            pg8::gemm_phase<EpiAct<0>, pg8::StaticOrder, true, true>(lds3, g, S, E, WV);
        }
        GRID_BAR();
        if (layer == 0) {
            fox_prep(a, WV);
            for (int u = blk; u < 2048; u += G) gdn_prep_unit(a, u, lds, WV);
            GRID_BAR();
            const float* C2g = (const float*)(ws + WS_C2);
            int Gl = G; asm volatile("" : "+s"(Gl));
            const bool bal = (Gl == 256); const int sstride = bal ? 64 : Gl;
            if (blk < sstride) for (int u = blk; u < 64; u += sstride) gdn_scan_unit(a, u, lds, WV);
            const int nk = bal ? 4 : (1024 + Gl - 1) / Gl;
#pragma unroll 1
            for (int k = 0; k < nk; ++k) {
                const int i = blk - 64;
                const int u = bal ? (blk < 64 ? 768 + 64 * k + blk : 192 * k + ((k & 1) ? 191 - i : i)) : blk + Gl * k;
                if (u < 1024) { const int qb = 7 - (u >> 7), bh = u & 127; fox_unit(ZH, C2g, MIX, bh >> 3, bh & 7, qb, lds, WV); }
            }
        } else {
            for (int u = blk; u < 128; u += G) hgrn_unit(a, u >> 3, u & 7, lds, WV);
        }
        GRID_BAR();
        if (layer == 0) {
            pg8::Gemm g{MIX, (const bf16*)(ws + WS_W0OUT), M, 1024, 1024}; int blkl = blk; asm volatile("" : "+s"(blkl)); pg8::StaticOrder S; S.init(M, 1024, G, blkl);
            EpiRes<false, false> E{a.in[0], nullptr, XB, SS + (size_t)1 * SS_STRIDE};
            pg8::gemm_phase<EpiRes<false, false>, pg8::StaticOrder, true, true>(lds3, g, S, E, WV);
        } else {
            pg8::Gemm g{MIX, (const bf16*)(ws + WS_W1OUT), M, 1024, 1024}; int blkl = blk; asm volatile("" : "+s"(blkl)); pg8::StaticOrder S; S.init(M, 1024, G, blkl);
            EpiRes<true, false> E{XB, nullptr, XB, SS + (size_t)3 * SS_STRIDE};
            pg8::gemm_phase<EpiRes<true, false>, pg8::StaticOrder, true, true>(lds3, g, S, E, WV);
        }
        GRID_BAR();
        {
            pg8::Gemm g{XB, (const bf16*)(ws + (layer == 0 ? WS_W0F1 : WS_W1F1)), M, 4096, 1024}; int blkl = blk; asm volatile("" : "+s"(blkl)); pg8::StaticOrder S; S.init(M, 4096, G, blkl, WGM_WIDE);
            rs_table_build<false>(lds, SS + (size_t)(2 * layer + 1) * SS_STRIDE, S, WV);
            EpiAct<1> E{ZH, 4096, nullptr, (const lds_f32_t*)((PG8_LAS unsigned char*)lds + RS_OFF), 0};
            pg8::gemm_phase<EpiAct<1>, pg8::StaticOrder, true, true>(lds3, g, S, E, WV);
        }
        GRID_BAR();
        if (layer == 0) {
            pg8::Gemm g{ZH, (const bf16*)(ws + WS_W0F2), M, 1024, 4096}; int blkl = blk; asm volatile("" : "+s"(blkl)); pg8::StaticOrder S; S.init(M, 1024, G, blkl);
            EpiRes<true, false> E{XB, nullptr, XB, SS + 2 * SS_STRIDE};
            pg8::gemm_phase<EpiRes<true, false>, pg8::StaticOrder, true, true>(lds3, g, S, E, WV);
        } else {
            pg8::Gemm g{ZH, (const bf16*)(ws + WS_W1F2), M, 1024, 4096}; int blkl = blk; asm volatile("" : "+s"(blkl)); pg8::StaticOrder S; S.init(M, 1024, G, blkl);
            EpiRes<true, true> E{XB, a.out, nullptr, nullptr};
            pg8::gemm_phase<EpiRes<true, true>, pg8::StaticOrder, true, true>(lds3, g, S, E, WV);
        }
        if (layer == 0) GRID_BAR();
    }
}

extern "C" void kernel_launch(void* const* d_in, const int* in_sizes, int n_in, void* d_out, int out_size, void* d_ws, size_t ws_size, hipStream_t stream) {
    static int grid = 0;
    if (grid == 0) {
        if (n_in != 22 || out_size != M * DM || ws_size < WS_END) { fprintf(stderr, "kernel_launch: unexpected problem (n_in %d out %d ws %zu)\n", n_in, out_size, ws_size); grid = -1; return; }
        int dev = 0, cus = 0, per_cu = 0;
        (void)hipGetDevice(&dev);
        (void)hipDeviceGetAttribute(&cus, hipDeviceAttributeMultiprocessorCount, dev);
        (void)hipFuncSetAttribute((const void*)trunk_fwd, hipFuncAttributeMaxDynamicSharedMemorySize, LDS_BYTES);
        (void)hipOccupancyMaxActiveBlocksPerMultiprocessor(&per_cu, (const void*)trunk_fwd, 512, LDS_BYTES);
        if (per_cu < 1) per_cu = 1;
        grid = cus * per_cu;
        fprintf(stderr, "kernel_launch: grid %d (cus %d x %d)\n", grid, cus, per_cu);
    }
    if (grid < 0) return;
    Args a{};
    for (int i = 0; i < 22; ++i) a.in[i] = (const float*)d_in[i];
    a.out = (float*)d_out; a.ws = (unsigned char*)d_ws;
    (void)hipMemsetAsync((unsigned char*)d_ws + WS_BAR, 0, 16384, stream);
    void* args[] = {&a};
    hipError_t e = hipLaunchCooperativeKernel((const void*)trunk_fwd, dim3(grid), dim3(512), args, LDS_BYTES, stream);
    if (e != hipSuccess) fprintf(stderr, "kernel_launch: cooperative launch failed: %s (grid %d)\n", hipGetErrorString(e), grid);
}
```

```cpp
#include <hip/hip_runtime.h>
#include <hip/hip_cooperative_groups.h>
#include <cstdio>
#include <cstdint>
namespace cg = cooperative_groups;
__device__ __forceinline__ int lane_id_() { int l; asm volatile("v_mbcnt_lo_u32_b32 %0, -1, 0\n\tv_mbcnt_hi_u32_b32 %0, -1, %0" : "=v"(l)); return l; }
#define TIDX(wv_) ((wv_) * 64 + lane_id_())
namespace pg8 {
#define PG8_LAS __attribute__((address_space(3)))
typedef unsigned short bf16_t;
typedef short bf16x8 __attribute__((ext_vector_type(8)));
typedef float f32x4 __attribute__((ext_vector_type(4)));
typedef unsigned u32x4 __attribute__((ext_vector_type(4)));
constexpr int BM = 256, BK = 64, HALF = 128, HTB = HALF * BK * 2  , STAGE_BYTES = 8 * HTB, NXCD = 8, WGM = 8;

__host__ __device__ __forceinline__ int lds_byte(int r, int c) { const int st = (r >> 4) * 2 + (c >> 5), rr = r & 15, cc = c & 31, ob = rr * 64 + cc * 2; return st * 1024 + (ob ^ (((ob >> 9) & 1) << 5)); }
__host__ __device__ __forceinline__ void stage_rc(int b, int& R, int& C) { const int st = b / 1024, sb = b % 1024, swz = sb ^ (((sb >> 9) & 1) << 5); R = (st >> 1) * 16 + swz / 64; C = (st & 1) * 32 + (swz % 64) / 2; }
__host__ __device__ __forceinline__ int perm32(int rho) { const int n = rho >> 4, i = rho & 15; return 8 * (i >> 2) + 4 * n + (i & 3); }

struct Unit { int pm, pn; };
struct Gemm { const bf16_t* A; const bf16_t* Bt; int M, N, K; };

struct StaticOrder {
    int nM, nN, nwg, G, c, wgm;
    __host__ __device__ void init(int M, int N, int G_, int c_, int wgm_ = WGM) { nM = M / BM; nN = N / BM; nwg = nM * nN; G = G_; c = c_; wgm = wgm_; }
    __host__ __device__ bool next(int i, Unit& u) const {
        const long L = (long)i * G + c; if (L >= nwg) return false;
        int wgid = (int)L; { const int q = nwg / NXCD, r = nwg % NXCD, xcd = wgid % NXCD, off = wgid / NXCD; wgid = (xcd < r ? xcd * (q + 1) : r * (q + 1) + (xcd - r) * q) + off; }
        const int nig = wgm * nN, gid = wgid / nig, fm = gid * wgm, gsz = (nM - fm) < wgm ? (nM - fm) : wgm;
        u.pm = fm + ((wgid % nig) % gsz); u.pn = (wgid % nig) / gsz; return true;
    }
    __device__ __forceinline__ void a_ready(const Unit&) const {}
    __device__ __forceinline__ void done(const Unit&) const {}
};

__device__ __forceinline__ unsigned cvt_pk_bf16_unused(float lo, float hi) { return 0; }
template <class Epi, class Sched, bool ALIGN_EPI = false, bool SP2 = false>
__device__ __forceinline__ void gemm_phase(PG8_LAS unsigned char* lds, const Gemm g, const Sched& S, const Epi& E, const int wv_) {
    int tid_ = TIDX(wv_); asm volatile("" : "+v"(tid_)); const int tid = tid_, wid = __builtin_amdgcn_readfirstlane(tid >> 6), lane = tid & 63, wr = wid >> 2, wc = wid & 3, fr = lane & 15, fq = lane >> 4;
    const int K = g.K, nt = K / BK;
    unsigned voffA[2], voffB[2];
#pragma unroll
    for (int i = 0; i < 2; ++i) { int R, C; stage_rc(tid * 16 + i * 8192, R, C); const int Rb = Epi::PERM ? ((R & ~31) + perm32(R & 31)) : R;
        voffA[i] = (unsigned)(R * K + C) * 2u; voffB[i] = (unsigned)(Rb * K + C) * 2u; }
    const size_t kstep = (size_t)(BK * 2);
    const size_t hstep = (size_t)HALF * K * 2;
    const size_t tstep = 2 * hstep;
    const unsigned ldsw = (unsigned)wid * 1024u;
    const int aoff = lds_byte(wr * 64 + fr, fq * 8), boff = lds_byte(wc * 32 + fr, fq * 8);
#define PG8_SA(b, h) (((b) * 2 + (h)) * HTB)
#define PG8_SB(b, h) ((4 + (b) * 2 + (h)) * HTB)
#define PG8_STAGE(bufoff, gbase, voff) do { _Pragma("unroll") for (int _i = 0; _i < 2; ++_i) \
        __builtin_amdgcn_global_load_lds((const unsigned*)((const char*)(gbase) + (voff)[_i]), (PG8_LAS unsigned*)(lds + (bufoff) + ldsw + _i * 8192), 16, 0, 0); } while (0)
#define PG8_LDA(dst, b, h) do { _Pragma("unroll") for (int m = 0; m < 4; ++m) _Pragma("unroll") for (int k = 0; k < 2; ++k) dst[m][k] = *(const PG8_LAS bf16x8*)(lds + PG8_SA(b, h) + aoff + m * 2048 + k * 1024); } while (0)
#define PG8_LDB(dst, b, h) do { _Pragma("unroll") for (int n = 0; n < 2; ++n) _Pragma("unroll") for (int k = 0; k < 2; ++k) dst[n][k] = *(const PG8_LAS bf16x8*)(lds + PG8_SB(b, h) + boff + n * 2048 + k * 1024); } while (0)
#define PG8_MMA(ai, bj, At, Bt) do { __builtin_amdgcn_s_setprio(1); _Pragma("unroll") for (int m = 0; m < 4; ++m) _Pragma("unroll") for (int n = 0; n < 2; ++n) _Pragma("unroll") for (int k = 0; k < 2; ++k) \
        acc[ai][bj][m][n] = __builtin_amdgcn_mfma_f32_16x16x32_bf16(Bt[n][k], At[m][k], acc[ai][bj][m][n], 0, 0, 0); __builtin_amdgcn_s_setprio(0); } while (0)
#define PG8_WAIT_V(n) asm volatile("s_waitcnt vmcnt(" #n ")" ::: "memory")
#define PG8_WAIT_L(n) asm volatile("s_waitcnt lgkmcnt(" #n ")" ::: "memory")
#define PG8_BAR __builtin_amdgcn_s_barrier()
#define PG8_SCHED __builtin_amdgcn_sched_barrier(0)
    Unit cur, nxt; int ui = 0;
    if (!S.next(0, cur)) return;
    f32x4 acc[2][2][4][2];
#pragma unroll
    for (int a = 0; a < 2; ++a)
#pragma unroll
        for (int b = 0; b < 2; ++b)
#pragma unroll
            for (int m = 0; m < 4; ++m)
#pragma unroll
                for (int n = 0; n < 2; ++n) acc[a][b][m][n] = (f32x4){0.f, 0.f, 0.f, 0.f};
    bf16x8 At[4][2], B0[2][2], B1[2][2];
    const char* cA = (const char*)g.A + (size_t)cur.pm * tstep; const char* cB = (const char*)g.Bt + (size_t)cur.pn * tstep;
    S.a_ready(cur);
    if constexpr (SP2) {
        PG8_STAGE(PG8_SB(0, 0), cB, voffB); PG8_STAGE(PG8_SB(0, 1), cB + hstep, voffB); PG8_STAGE(PG8_SA(0, 0), cA, voffA); PG8_STAGE(PG8_SA(0, 1), cA + hstep, voffA);
        if (wr == 1) PG8_BAR;
        PG8_WAIT_V(2); PG8_BAR;
        PG8_STAGE(PG8_SB(1, 0), cB + kstep, voffB); PG8_STAGE(PG8_SA(1, 0), cA + kstep, voffA); PG8_STAGE(PG8_SB(1, 1), cB + hstep + kstep, voffB);
        PG8_WAIT_V(6); PG8_BAR;
    } else {
        PG8_STAGE(PG8_SB(0, 0), cB, voffB); PG8_STAGE(PG8_SA(0, 0), cA, voffA); PG8_STAGE(PG8_SB(0, 1), cB + hstep, voffB); PG8_STAGE(PG8_SA(0, 1), cA + hstep, voffA);
        if (wr == 1) PG8_BAR;
        PG8_WAIT_V(4); PG8_BAR;
        PG8_STAGE(PG8_SB(1, 0), cB + kstep, voffB); PG8_STAGE(PG8_SA(1, 0), cA + kstep, voffA); PG8_STAGE(PG8_SB(1, 1), cB + hstep + kstep, voffB);
        PG8_WAIT_V(6); PG8_BAR;
    }
    for (;;) {
        const bool has_next = S.next(ui + 1, nxt);
        const char* nA = has_next ? (const char*)g.A + (size_t)nxt.pm * tstep : cA; const char* nB = has_next ? (const char*)g.Bt + (size_t)nxt.pn * tstep : cB;
        for (int t = 0; t < nt; t += 2) {
            const bool last = (t == nt - 2);
            const char* a1 = cA + (size_t)(t + 1) * kstep;
            const char* a2 = last ? nA : cA + (size_t)(t + 2) * kstep; const char* b2 = last ? nB : cB + (size_t)(t + 2) * kstep;
            const char* a3 = a2 + kstep; const char* b3 = b2 + kstep;
            if (last && has_next) S.a_ready(nxt);
            if constexpr (SP2) {
            PG8_LDB(B0, 0, 0); PG8_LDB(B1, 0, 1); PG8_SCHED; PG8_LDA(At, 0, 0); PG8_STAGE(PG8_SA(1, 1), a1 + hstep, voffA);
            PG8_WAIT_V(8); PG8_WAIT_L(0); PG8_BAR; PG8_MMA(0, 0, At, B0); PG8_MMA(0, 1, At, B1); PG8_BAR; PG8_SCHED;
            PG8_LDA(At, 0, 1); PG8_STAGE(PG8_SB(0, 0), b2, voffB); PG8_STAGE(PG8_SB(0, 1), b2 + hstep, voffB); PG8_STAGE(PG8_SA(0, 0), a2, voffA);
            PG8_WAIT_V(8); PG8_WAIT_L(0); PG8_BAR; PG8_MMA(1, 0, At, B0); PG8_MMA(1, 1, At, B1); PG8_BAR; PG8_SCHED;
            PG8_LDB(B0, 1, 0); PG8_LDB(B1, 1, 1); PG8_SCHED; PG8_LDA(At, 1, 0); PG8_STAGE(PG8_SA(0, 1), a2 + hstep, voffA);
            PG8_WAIT_V(8); PG8_WAIT_L(0); PG8_BAR; PG8_MMA(0, 0, At, B0); PG8_MMA(0, 1, At, B1); PG8_BAR; PG8_SCHED;
            PG8_LDA(At, 1, 1); PG8_STAGE(PG8_SB(1, 0), b3, voffB); PG8_STAGE(PG8_SB(1, 1), b3 + hstep, voffB); PG8_STAGE(PG8_SA(1, 0), a3, voffA);
            PG8_WAIT_V(8); PG8_WAIT_L(0); PG8_BAR; PG8_MMA(1, 0, At, B0); PG8_MMA(1, 1, At, B1); PG8_BAR; PG8_SCHED;
            } else {
            PG8_LDB(B0, 0, 0); PG8_SCHED; PG8_LDA(At, 0, 0); PG8_STAGE(PG8_SA(1, 1), a1 + hstep, voffA);
            PG8_WAIT_L(8); PG8_BAR; PG8_WAIT_L(0); PG8_MMA(0, 0, At, B0); PG8_BAR; PG8_SCHED;
            PG8_LDB(B1, 0, 1); PG8_STAGE(PG8_SB(0, 0), b2, voffB);
            PG8_BAR; PG8_WAIT_L(0); PG8_MMA(0, 1, At, B1); PG8_BAR;
            PG8_LDA(At, 0, 1); PG8_STAGE(PG8_SA(0, 0), a2, voffA);
            PG8_BAR; PG8_WAIT_L(0); PG8_MMA(1, 0, At, B0); PG8_BAR; PG8_SCHED;
            PG8_STAGE(PG8_SB(0, 1), b2 + hstep, voffB);
            PG8_WAIT_V(6); PG8_BAR; PG8_MMA(1, 1, At, B1); PG8_BAR;
            PG8_LDB(B0, 1, 0); PG8_SCHED; PG8_LDA(At, 1, 0); PG8_STAGE(PG8_SA(0, 1), a2 + hstep, voffA);
            PG8_WAIT_L(8); PG8_BAR; PG8_WAIT_L(0); PG8_MMA(0, 0, At, B0); PG8_BAR; PG8_SCHED;
            PG8_LDB(B1, 1, 1); PG8_STAGE(PG8_SB(1, 0), b3, voffB);
            PG8_BAR; PG8_WAIT_L(0); PG8_MMA(0, 1, At, B1); PG8_BAR;
            PG8_LDA(At, 1, 1); PG8_STAGE(PG8_SA(1, 0), a3, voffA);
            PG8_BAR; PG8_WAIT_L(0); PG8_MMA(1, 0, At, B0); PG8_BAR; PG8_SCHED;
            PG8_STAGE(PG8_SB(1, 1), b3 + hstep, voffB);
            PG8_WAIT_V(6); PG8_BAR; PG8_MMA(1, 1, At, B1); PG8_BAR;
            }
        }
        if constexpr (ALIGN_EPI) { if (wr == 0) PG8_BAR; }
        if constexpr (!Epi::AFTER_DRAIN) { E(acc, cur, wr, wc, fr, fq); S.done(cur); }
        if (!has_next) break;
#pragma unroll
        for (int a = 0; a < 2; ++a)
#pragma unroll
            for (int b = 0; b < 2; ++b)
#pragma unroll
                for (int m = 0; m < 4; ++m)
#pragma unroll
                    for (int n = 0; n < 2; ++n) acc[a][b][m][n] = (f32x4){0.f, 0.f, 0.f, 0.f};
        cur = nxt; cA = nA; cB = nB; ++ui;
        if constexpr (ALIGN_EPI) { if (wr == 1) PG8_BAR; }
    }
    PG8_WAIT_V(0);
    if constexpr (!ALIGN_EPI) { if (wr == 0) PG8_BAR; }
    PG8_BAR;
    if constexpr (Epi::AFTER_DRAIN) { E.fused(acc, cur, wr, wc, fr, fq, lds, wid, lane); S.done(cur); }
#undef PG8_SA
#undef PG8_SB
#undef PG8_STAGE
#undef PG8_LDA
#undef PG8_LDB
#undef PG8_MMA
#undef PG8_WAIT_V
#undef PG8_WAIT_L
#undef PG8_BAR
#undef PG8_SCHED
}
}
#define DI __device__ __forceinline__
typedef __attribute__((address_space(3))) float lds_f32_t;
typedef unsigned short bf16;
typedef float f32x4 __attribute__((ext_vector_type(4)));
typedef float f32x2 __attribute__((ext_vector_type(2)));
typedef float f32x16 __attribute__((ext_vector_type(16)));
typedef short bf16x8 __attribute__((ext_vector_type(8)));
typedef short s16x4 __attribute__((ext_vector_type(4)));
typedef unsigned u32x4 __attribute__((ext_vector_type(4)));
typedef __bf16 bf16x2_t __attribute__((ext_vector_type(2)));
#define MFMA32(a, b, c) __builtin_amdgcn_mfma_f32_32x32x16_bf16((a), (b), (c), 0, 0, 0)
#define LDS_FENCE() asm volatile("s_waitcnt lgkmcnt(0)" ::: "memory")

DI unsigned pk2(float lo, float hi) { f32x2 v = {lo, hi}; bf16x2_t b = __builtin_convertvector(v, bf16x2_t); return __builtin_bit_cast(unsigned, b); }
DI float bflo(unsigned u) { return __uint_as_float(u << 16); }
DI float bfhi(unsigned u) { return __uint_as_float(u & 0xffff0000u); }
DI float bf2f(bf16 h) { return __uint_as_float((unsigned)h << 16); }
DI float wave_sum(float v) {
#pragma unroll
    for (int o = 1; o < 64; o <<= 1) v += __shfl_xor(v, o);
    return v;
}
DI float sigmoid_(float x) { return 1.f / (1.f + __expf(-x)); }
DI float silu_(float x) { return x / (1.f + __expf(-x)); }
DI float softplus_(float x) { return x > 20.f ? x : __logf(1.0f + __expf(x)); }
DI int crow(int reg, int h) { return (reg & 3) + 8 * (reg >> 2) + 4 * h; }

constexpr int BATCH = 16, SEQ = 2048, DM = 1024, M = BATCH * SEQ, FF = 4096, N0 = 3840;
constexpr float EPS = 1e-6f, LOG2E = 1.4426950408889634f;
constexpr size_t MiB = 1u << 20;
constexpr size_t WS_W0IN = 0, WS_W0OUT = 8 * MiB, WS_W0F1 = 10 * MiB, WS_W0F2 = 18 * MiB, WS_W1IN = 26 * MiB, WS_W1OUT = 34 * MiB, WS_W1F1 = 36 * MiB, WS_W1F2 = 44 * MiB;
constexpr size_t WS_MIX = 52 * MiB, WS_ZH = 116 * MiB, WS_SS = 372 * MiB, WS_C2 = 380 * MiB, WS_XB = 384 * MiB, WS_END = 512 * MiB;
constexpr size_t WS_PAR = 381 * MiB;
constexpr int P_QN = 0, P_KN = 64, P_FB = 128, P_CONV = 256, P_ALOG = 6400, P_DTB = 6404, P_GON = 6528, P_HON = 6656, P_LB = 6784, P_END = 8832;
constexpr size_t WS_BAR = 381 * MiB + 131072;
constexpr size_t SS_STRIDE = (size_t)M * 16;
constexpr int LDS_BYTES = 147456;
#ifndef WGM_WIDE
#define WGM_WIDE 4
#endif

constexpr int RS_OFF = 131072;
template <int ACT> struct EpiAct {
    static constexpr bool PERM = true, AFTER_DRAIN = false;
    bf16* O; int ldc; const float* par; const lds_f32_t* rs; mutable int ui;
    DI void operator()(const f32x4 (&acc)[2][2][4][2], const pg8::Unit& u, int wr, int wc, int fr, int fq) const {
        const int row0 = u.pm * 256 + wr * 64 + fr, col0 = u.pn * 256 + wc * 32 + 8 * fq;
        float rsv[2][4];
#pragma unroll
        for (int ai = 0; ai < 2; ++ai)
#pragma unroll
            for (int m = 0; m < 4; ++m) rsv[ai][m] = rs[ui * 256 + ai * 128 + wr * 64 + m * 16 + fr];
        ++ui;
#pragma unroll
        for (int ai = 0; ai < 2; ++ai)
#pragma unroll
            for (int m = 0; m < 4; ++m) {
                const int row = row0 + ai * 128 + m * 16;
                const float r = rsv[ai][m];
                bf16* rowp = O + (size_t)row * ldc + col0;
                if (ACT == 2 && u.pn < 4) {
                    float ssq = 0.f;
#pragma unroll
                    for (int bj = 0; bj < 2; ++bj)
#pragma unroll
                        for (int n = 0; n < 2; ++n) { const f32x4 t = acc[ai][bj][m][n]; ssq += (t[0] * t[0] + t[1] * t[1]) + (t[2] * t[2] + t[3] * t[3]); }
                    ssq += __shfl_xor(ssq, 16); ssq += __shfl_xor(ssq, 32);
                    const float rn = r * rsqrtf(ssq * r * r * (1.0f / 64.0f) + EPS) * (u.pn < 2 ? 0.125f * LOG2E : 1.0f);
                    int fql = fq; asm volatile("" : "+v"(fql));
                    const float* gq = par + (u.pn < 2 ? P_QN : P_KN) + 8 * fql;
#pragma unroll
                    for (int bj = 0; bj < 2; ++bj) {
                        const f32x4 g0 = *(const f32x4*)(gq + bj * 32), g1 = *(const f32x4*)(gq + bj * 32 + 4);
                        const f32x4 v0 = acc[ai][bj][m][0] * rn * g0, v1 = acc[ai][bj][m][1] * rn * g1;
                        u32x4 w; w.x = pk2(v0[0], v0[1]); w.y = pk2(v0[2], v0[3]); w.z = pk2(v1[0], v1[1]); w.w = pk2(v1[2], v1[3]);
                        __builtin_nontemporal_store(w, (u32x4*)(rowp + bj * 128));
                    }
                    continue;
                }
#pragma unroll
                for (int bj = 0; bj < 2; ++bj) {
                    f32x4 v0 = acc[ai][bj][m][0] * r, v1 = acc[ai][bj][m][1] * r;
                    if (ACT == 1) {
#pragma unroll
                        for (int e = 0; e < 4; ++e) { const float x0 = fmaxf(v0[e], 0.f), x1 = fmaxf(v1[e], 0.f); v0[e] = x0 * x0; v1[e] = x1 * x1; }
                    }
                    u32x4 w; w.x = pk2(v0[0], v0[1]); w.y = pk2(v0[2], v0[3]); w.z = pk2(v1[0], v1[1]); w.w = pk2(v1[2], v1[3]);
                    __builtin_nontemporal_store(w, (u32x4*)(rowp + bj * 128));
                }
            }
    }
};
template <bool FINISHED, class Sched> DI void rs_table_build(unsigned char* lds, const float* ss, const Sched& S, const int wv_) {
    int tid = TIDX(wv_); asm volatile("" : "+v"(tid));
    float* rs = (float*)(lds + RS_OFF);
    const int r = tid & 255, par = tid >> 8;
    pg8::Unit u;
#pragma unroll
    for (int k = 0; k < 4; ++k) {
        const int i = 2 * k + par;
        if (S.next(i, u)) {
            const int row = u.pm * 256 + r;
            if (FINISHED) rs[i * 256 + r] = ss[row];
            else {
                const f32x4* p = (const f32x4*)(ss + (size_t)row * 16);
                const f32x4 a = p[0], b = p[1], c = p[2], d = p[3];
                const float sm = ((a.x + a.y) + (a.z + a.w)) + ((b.x + b.y) + (b.z + b.w)) + ((c.x + c.y) + (c.z + c.w)) + ((d.x + d.y) + (d.z + d.w));
                rs[i * 256 + r] = rsqrtf(sm * (1.0f / 1024.0f) + EPS);
            }
        }
    }
    __syncthreads();
}
template <bool BASE_BF16, bool OUT_F32> struct EpiRes {
    static constexpr bool PERM = true, AFTER_DRAIN = false;
    const void* base; float* out; bf16* xb; float* ss_out;
    DI void operator()(const f32x4 (&acc)[2][2][4][2], const pg8::Unit& u, int wr, int wc, int fr, int fq) const {
        const int row0 = u.pm * 256 + wr * 64 + fr, col0 = u.pn * 256 + wc * 32 + 8 * fq;
#pragma unroll
        for (int ai = 0; ai < 2; ++ai) {
            f32x4 bb[4][2][2];
#pragma unroll
            for (int m = 0; m < 4; ++m)
#pragma unroll
                for (int bj = 0; bj < 2; ++bj) {
                    const size_t off = (size_t)(row0 + ai * 128 + m * 16) * 1024 + col0 + bj * 128;
                    if (BASE_BF16) {
                        const u32x4 w = *(const u32x4*)((const bf16*)base + off);
                        bb[m][bj][0] = (f32x4){bflo(w[0]), bfhi(w[0]), bflo(w[1]), bfhi(w[1])}; bb[m][bj][1] = (f32x4){bflo(w[2]), bfhi(w[2]), bflo(w[3]), bfhi(w[3])};
                    } else {
                        bb[m][bj][0] = *(const f32x4*)((const float*)base + off); bb[m][bj][1] = *(const f32x4*)((const float*)base + off + 4);
                    }
                }
            __builtin_amdgcn_sched_barrier(0);
#pragma unroll
            for (int m = 0; m < 4; ++m) {
                const int row = row0 + ai * 128 + m * 16;
                float s = 0.f;
#pragma unroll
                for (int bj = 0; bj < 2; ++bj) {
                    const size_t off = (size_t)row * 1024 + col0 + bj * 128;
                    const f32x4 v0 = acc[ai][bj][m][0] + bb[m][bj][0], v1 = acc[ai][bj][m][1] + bb[m][bj][1];
                    if (OUT_F32) { *(f32x4*)(out + off) = v0; *(f32x4*)(out + off + 4) = v1; }
                    else {
                        s += ((v0[0] * v0[0] + v0[1] * v0[1]) + (v0[2] * v0[2] + v0[3] * v0[3])) + ((v1[0] * v1[0] + v1[1] * v1[1]) + (v1[2] * v1[2] + v1[3] * v1[3]));
                        u32x4 w; w.x = pk2(v0[0], v0[1]); w.y = pk2(v0[2], v0[3]); w.z = pk2(v1[0], v1[1]); w.w = pk2(v1[2], v1[3]); *(u32x4*)(xb + off) = w;
                    }
                }
                if (!OUT_F32) { s += __shfl_xor(s, 16); s += __shfl_xor(s, 32); if (fq == 0) ss_out[(size_t)row * 16 + u.pn * 4 + wc] = s; }
            }
            __builtin_amdgcn_sched_barrier(0);
        }
    }
};

DI int src_col0(int n) {
    if (n < 1024) { const int tile = n >> 8, c = n & 255, half = c >> 7, wc = (c >> 5) & 3, dl = c & 31; return (tile >> 1) * 512 + ((tile & 1) * 4 + wc) * 64 + half * 32 + dl; }
    return n < 1536 ? n : n < 3072 ? n + 8 : n < 3584 ? n + 16 : n < 3592 ? n - 3584 + 1536 : n < 3600 ? n - 3592 + 3080 : -1;
}
DI int fox_col(int which, int h, int d) { return which * 512 + 256 * (h >> 2) + (d >> 5) * 128 + 32 * (h & 3) + (d & 31); }
template <bool MAP> DI void transpose_item(const float* __restrict__ W, int K, int Nsrc, int Ndst, const float* __restrict__ gain, bf16* __restrict__ WT, float* scr, int item, int lane) {
    const int nblk = Ndst / 32, kb = item / nblk, nb = item % nblk, k0 = 64 * kb, n0 = 32 * nb;
    const int n = n0 + (lane & 31), sc = MAP ? src_col0(n) : n;
    float vals[32];
#pragma unroll
    for (int i = 0; i < 32; ++i) {
        const int kk = 2 * i + (lane >> 5); float v = 0.f;
        if (sc >= 0) v = __builtin_nontemporal_load(W + (size_t)(k0 + kk) * Nsrc + sc);
        vals[i] = v;
    }
#pragma unroll
    for (int i = 0; i < 32; ++i) {
        const int kk = 2 * i + (lane >> 5); float v = vals[i];
        if (gain) v *= gain[k0 + kk];
        scr[kk * 33 + (lane & 31)] = v;
    }
    LDS_FENCE();
    const int c = lane & 7;
#pragma unroll
    for (int j = 0; j < 4; ++j) {
        const int nn = (lane >> 3) + 8 * j; const float* s = scr + (8 * c) * 33 + nn;
        u32x4 o; o.x = pk2(s[0 * 33], s[1 * 33]); o.y = pk2(s[2 * 33], s[3 * 33]); o.z = pk2(s[4 * 33], s[5 * 33]); o.w = pk2(s[6 * 33], s[7 * 33]);
        *(u32x4*)(WT + (size_t)(n0 + nn) * K + k0 + 8 * c) = o;
    }
    LDS_FENCE();
}

struct Args { const float* in[22]; float* out; unsigned char* ws; };

DI void p0_prologue(const Args& a, unsigned char* lds, const int wv_) {
    int tid = TIDX(wv_); asm volatile("" : "+v"(tid)); const int lane = tid & 63, wave = __builtin_amdgcn_readfirstlane(tid >> 6), gw = blockIdx.x * 8 + wave, NGW = gridDim.x * 8;
    float* scr = (float*)(lds + wave * 16384);
    unsigned char* ws = a.ws;
    constexpr int I0 = 16 * (N0 / 32), I_O = 16 * 32, I_1 = 16 * 128, I_2 = 64 * 32;
    constexpr int NITEMS = I0 + I_O + I_1 + I_2 + I_1 + I_O + I_1 + I_2;
    for (int it = gw; it < NITEMS; it += NGW) {
        int r = it;
        if (r < I0) { transpose_item<true>(a.in[2], 1024, 3600, N0, a.in[1], (bf16*)(ws + WS_W0IN), scr, r, lane); continue; } r -= I0;
        if (r < I_O) { transpose_item<false>(a.in[10], 1024, 1024, 1024, nullptr, (bf16*)(ws + WS_W0OUT), scr, r, lane); continue; } r -= I_O;
        if (r < I_1) { transpose_item<false>(a.in[12], 1024, 4096, 4096, a.in[11], (bf16*)(ws + WS_W0F1), scr, r, lane); continue; } r -= I_1;
        if (r < I_2) { transpose_item<false>(a.in[13], 4096, 1024, 1024, nullptr, (bf16*)(ws + WS_W0F2), scr, r, lane); continue; } r -= I_2;
        if (r < I_1) { transpose_item<false>(a.in[15], 1024, 4096, 4096, a.in[14], (bf16*)(ws + WS_W1IN), scr, r, lane); continue; } r -= I_1;
        if (r < I_O) { transpose_item<false>(a.in[17], 1024, 1024, 1024, nullptr, (bf16*)(ws + WS_W1OUT), scr, r, lane); continue; } r -= I_O;
        if (r < I_1) { transpose_item<false>(a.in[19], 1024, 4096, 4096, a.in[18], (bf16*)(ws + WS_W1F1), scr, r, lane); continue; } r -= I_1;
        transpose_item<false>(a.in[20], 4096, 1024, 1024, nullptr, (bf16*)(ws + WS_W1F2), scr, r, lane);
    }
    if (blockIdx.x == 0) {
        float* P = (float*)(ws + WS_PAR);
        for (int i = tid; i < P_END; i += 512) {
            float v = 0.f;
            if (i < 64) v = a.in[3][i]; else if (i < 128) v = a.in[4][i - 64]; else if (i < 136) v = a.in[5][i - 128];
            else if (i >= P_CONV && i < P_CONV + 6144) v = a.in[6][i - P_CONV];
            else if (i >= P_ALOG && i < P_ALOG + 4) v = a.in[7][i - P_ALOG]; else if (i >= P_DTB && i < P_DTB + 4) v = a.in[8][i - P_DTB];
            else if (i >= P_GON && i < P_GON + 128) v = a.in[9][i - P_GON]; else if (i >= P_HON && i < P_HON + 128) v = a.in[16][i - P_HON];
            else if (i >= P_LB) v = a.in[21][i - P_LB];
            P[i] = v;
        }
    }
    const float* x = a.in[0]; bf16* XB = (bf16*)(ws + WS_XB); float* SS = (float*)(ws + WS_SS);
    for (int m0 = gw; m0 < M; m0 += 2 * NGW) {
        const int m1 = m0 + NGW; const bool has1 = m1 < M;
        const f32x4* xr0 = (const f32x4*)(x + (size_t)m0 * DM) + lane; const f32x4* xr1 = (const f32x4*)(x + (size_t)(has1 ? m1 : m0) * DM) + lane;
        f32x4 v0[4], v1[4]; float s0 = 0.f, s1 = 0.f;
#pragma unroll
        for (int j = 0; j < 4; ++j) { v0[j] = __builtin_nontemporal_load(xr0 + 64 * j); v1[j] = __builtin_nontemporal_load(xr1 + 64 * j); }
#pragma unroll
        for (int j = 0; j < 4; ++j) {
            s0 += (v0[j].x * v0[j].x + v0[j].y * v0[j].y) + (v0[j].z * v0[j].z + v0[j].w * v0[j].w);
            s1 += (v1[j].x * v1[j].x + v1[j].y * v1[j].y) + (v1[j].z * v1[j].z + v1[j].w * v1[j].w);
        }
#pragma unroll
        for (int o = 1; o < 64; o <<= 1) { s0 += __shfl_xor(s0, o); s1 += __shfl_xor(s1, o); }
        unsigned long long* o80 = (unsigned long long*)(XB + (size_t)m0 * DM) + lane;
#pragma unroll
        for (int j = 0; j < 4; ++j) o80[64 * j] = (unsigned long long)pk2(v0[j].x, v0[j].y) | ((unsigned long long)pk2(v0[j].z, v0[j].w) << 32);
        if (lane == 0) SS[m0] = rsqrtf(s0 * (1.0f / 1024.0f) + EPS);
        if (has1) {
            unsigned long long* o81 = (unsigned long long*)(XB + (size_t)m1 * DM) + lane;
#pragma unroll
            for (int j = 0; j < 4; ++j) o81[64 * j] = (unsigned long long)pk2(v1[j].x, v1[j].y) | ((unsigned long long)pk2(v1[j].z, v1[j].w) << 32);
            if (lane == 0) SS[m1] = rsqrtf(s1 * (1.0f / 1024.0f) + EPS);
        }
    }
}

DI void fox_prep(const Args& a, const int wv_) {
    int tid = TIDX(wv_); asm volatile("" : "+v"(tid)); const int lane = tid & 63, wave = __builtin_amdgcn_readfirstlane(tid >> 6), gw = blockIdx.x * 8 + wave, NGW = gridDim.x * 8;
    bf16* Z = (bf16*)(a.ws + WS_ZH); float* C2 = (float*)(a.ws + WS_C2);
    for (int it = gw; it < 128; it += NGW) {
        const int b = it >> 3, h = it & 7; const float bias = ((const float*)(a.ws + WS_PAR))[P_FB + h];
        float loc[32]; float run = 0.f;
#pragma unroll
        for (int i = 0; i < 32; ++i) {
            const int t = 32 * lane + i; const float x = bf2f(Z[((size_t)b * SEQ + t) * N0 + 3584 + h]) + bias;
            const float ls = fminf(x, 0.f) - __logf(1.0f + __expf(-fabsf(x))); run += ls; loc[i] = run;
        }
        float incl = run;
#pragma unroll
        for (int o = 1; o < 64; o <<= 1) { const float y = __shfl_up(incl, o); if (lane >= o) incl += y; }
        const float excl = incl - run;
#pragma unroll
        for (int i = 0; i < 32; ++i) C2[(size_t)it * SEQ + 32 * lane + i] = (loc[i] + excl) * LOG2E;
    }
}

constexpr int LDK = 72;
DI void fox_unit(const bf16* __restrict__ Z, const float* __restrict__ C2, bf16* __restrict__ MIX, int b, int h, int qb, unsigned char* lds, const int wv_) {
    int tid = TIDX(wv_); asm volatile("" : "+v"(tid)); const int lane = tid & 63, r = lane & 31, hh = lane >> 5, w = tid >> 6;
    bf16* Ks0 = (bf16*)lds; bf16* Vt0 = (bf16*)(lds + 18432); float* C2s = (float*)(lds + 36864); float* AS = (float*)(lds + 45056) + w * 32;
    const int q0 = qb * 256, nT = (q0 + 256) / 64;
    const size_t rowbase = (size_t)b * SEQ;
    const float* c2g = C2 + (size_t)(b * 8 + h) * SEQ;
    {
        float cv[4];
#pragma unroll
        for (int k = 0; k < 4; ++k) { const int i = tid + 512 * k; cv[k] = i < q0 + 256 ? c2g[i] : 0.f; }
#pragma unroll
        for (int k = 0; k < 4; ++k) { const int i = tid + 512 * k; if (i < q0 + 256) C2s[i] = -cv[k]; }
    }
    const int qrow = q0 + 32 * w + r;
    bf16x8 qr[4];
#pragma unroll
    for (int ks = 0; ks < 4; ++ks) qr[ks] = *(const bf16x8*)(Z + (rowbase + qrow) * N0 + fox_col(0, h, ks * 16 + hh * 8));
    float m_run = -INFINITY, l_run = 0.f;
    f32x16 o0, o1;
#pragma unroll
    for (int i = 0; i < 16; ++i) { o0[i] = 0.f; o1[i] = 0.f; }
    const int kr = tid >> 3, ch = tid & 7;
    const bf16* kvp = Z + (rowbase + kr) * N0 + fox_col(1, h, ch * 8);
    const int voff = 1024 + h * 64 + ch * 8 - fox_col(1, h, ch * 8);
    u32x4 kv = *(const u32x4*)kvp, vv = *(const u32x4*)(kvp + voff);
    {
        *(u32x4*)(Ks0 + kr * LDK + ch * 8) = kv;
#pragma unroll
        for (int e = 0; e < 8; ++e) Vt0[(ch * 8 + e) * LDK + kr] = (bf16)(vv[e >> 1] >> (16 * (e & 1)));
        if (1 < nT) { const bf16* np = kvp + (size_t)64 * N0; kv = *(const u32x4*)np; vv = *(const u32x4*)(np + voff); }
    }
    __syncthreads();
    for (int jt = 0; jt < nT; ++jt) {
        const bf16* Ks = Ks0 + (jt & 1) * 4608; const bf16* Vt = Vt0 + (jt & 1) * 4608;
        if (jt + 1 < nT) {
            bf16* Kn = Ks0 + ((jt + 1) & 1) * 4608; bf16* Vn = Vt0 + ((jt + 1) & 1) * 4608;
            *(u32x4*)(Kn + kr * LDK + ch * 8) = kv;
#pragma unroll
            for (int e = 0; e < 8; ++e) Vn[(ch * 8 + e) * LDK + kr] = (bf16)(vv[e >> 1] >> (16 * (e & 1)));
            if (jt + 2 < nT) { const bf16* np = kvp + (size_t)(jt + 2) * 64 * N0; kv = *(const u32x4*)np; vv = *(const u32x4*)(np + voff); }
        }
        const int kv0 = jt * 64;
        if (kv0 <= q0 + 32 * w + 31) {
            f32x16 p0, p1;
#pragma unroll
            for (int g = 0; g < 4; ++g) {
                const f32x4 c0v = *(const f32x4*)(C2s + kv0 + 8 * g + 4 * hh), c1v = *(const f32x4*)(C2s + kv0 + 32 + 8 * g + 4 * hh);
#pragma unroll
                for (int e = 0; e < 4; ++e) { p0[4 * g + e] = c0v[e]; p1[4 * g + e] = c1v[e]; }
            }
#pragma unroll
            for (int ks = 0; ks < 4; ++ks) {
                const bf16x8 a0 = *(const bf16x8*)(Ks + r * LDK + ks * 16 + hh * 8);
                const bf16x8 a1 = *(const bf16x8*)(Ks + (32 + r) * LDK + ks * 16 + hh * 8);
                p0 = MFMA32(a0, qr[ks], p0); p1 = MFMA32(a1, qr[ks], p1);
            }
            float mt = -INFINITY;
            const bool need_mask = kv0 + 63 > q0 + 32 * w;
#pragma unroll
            for (int g = 0; g < 4; ++g) {
#pragma unroll
                for (int e = 0; e < 4; ++e) {
                    const int i = 4 * g + e, kvi = kv0 + 8 * g + 4 * hh + e;
                    float s0 = p0[i], s1 = p1[i];
                    if (need_mask) { if (kvi > qrow) s0 = -INFINITY; if (kvi + 32 > qrow) s1 = -INFINITY; }
                    p0[i] = s0; p1[i] = s1; mt = fmaxf(mt, fmaxf(s0, s1));
                }
            }
            mt = fmaxf(mt, __shfl_xor(mt, 32));
            const float m_new = fmaxf(m_run, mt);
            const float alpha = __builtin_amdgcn_exp2f(m_run - m_new);
            m_run = m_new;
            float ps = 0.f;
#pragma unroll
            for (int i = 0; i < 16; ++i) { p0[i] = __builtin_amdgcn_exp2f(p0[i] - m_new); p1[i] = __builtin_amdgcn_exp2f(p1[i] - m_new); ps += p0[i] + p1[i]; }
            l_run = l_run * alpha + ps;
            if (hh == 0) AS[r] = alpha;
            LDS_FENCE();
#pragma unroll
            for (int i = 0; i < 16; ++i) { const float al = AS[crow(i, hh)]; o0[i] *= al; o1[i] *= al; }
            bf16x8 pa[4];
#pragma unroll
            for (int s = 0; s < 2; ++s) {
                u32x4 t0, t1;
#pragma unroll
                for (int e = 0; e < 4; ++e) { t0[e] = pk2(p0[8 * s + 2 * e], p0[8 * s + 2 * e + 1]); t1[e] = pk2(p1[8 * s + 2 * e], p1[8 * s + 2 * e + 1]); }
                pa[s] = __builtin_bit_cast(bf16x8, t0); pa[2 + s] = __builtin_bit_cast(bf16x8, t1);
            }
#pragma unroll
            for (int k4 = 0; k4 < 4; ++k4) {
                const int half = k4 >> 1, s = k4 & 1;
                const bf16* vb0 = Vt + r * LDK + 32 * half + 16 * s + 4 * hh;
                const bf16* vb1 = Vt + (32 + r) * LDK + 32 * half + 16 * s + 4 * hh;
                const s16x4 lo0 = *(const s16x4*)vb0, hi0 = *(const s16x4*)(vb0 + 8);
                const s16x4 lo1 = *(const s16x4*)vb1, hi1 = *(const s16x4*)(vb1 + 8);
                const bf16x8 vf0 = __builtin_shufflevector(lo0, hi0, 0, 1, 2, 3, 4, 5, 6, 7);
                const bf16x8 vf1 = __builtin_shufflevector(lo1, hi1, 0, 1, 2, 3, 4, 5, 6, 7);
                o0 = MFMA32(pa[k4], vf0, o0); o1 = MFMA32(pa[k4], vf1, o1);
            }
            LDS_FENCE();
        }
        __syncthreads();
    }
    const float l_tot = l_run + __shfl_xor(l_run, 32);
    if (hh == 0) AS[r] = 1.0f / l_tot;
    LDS_FENCE();
#pragma unroll
    for (int i = 0; i < 16; ++i) {
        const float inv = AS[crow(i, hh)]; const size_t row = rowbase + q0 + 32 * w + crow(i, hh);
        bf16* op = MIX + row * 1024 + h * 64 + r;
        op[0] = (bf16)(pk2(o0[i] * inv, 0.f) & 0xffffu); op[32] = (bf16)(pk2(o1[i] * inv, 0.f) & 0xffffu);
    }
    __syncthreads();
}


typedef __attribute__((address_space(3))) unsigned char lds_u8;
typedef __attribute__((address_space(3))) float lds_f32;
DI void norm_gate_store(const float* Of, const float* gain, const bf16* gate_row0, size_t gate_pitch, bf16* out_row0, int tid) {
    const int t = tid >> 3, seg = tid & 7;
    const f32x4* op = (const f32x4*)(Of + t * 128 + seg * 16);
    f32x4 o[4]; float ss = 0.f;
#pragma unroll
    for (int q = 0; q < 4; ++q) { o[q] = op[q]; ss += (o[q][0] * o[q][0] + o[q][1] * o[q][1]) + (o[q][2] * o[q][2] + o[q][3] * o[q][3]); }
    ss += __shfl_xor(ss, 1); ss += __shfl_xor(ss, 2); ss += __shfl_xor(ss, 4);
    const float rn = rsqrtf(ss * (1.0f / 128.0f) + EPS);
    const u32x4* gp = (const u32x4*)(gate_row0 + (size_t)t * gate_pitch + seg * 16);
    const u32x4 ga = gp[0], gb = gp[1];
    const f32x4* gn = (const f32x4*)(gain + seg * 16);
    u32x4 w0, w1;
#pragma unroll
    for (int q = 0; q < 4; ++q) {
        const f32x4 g4 = gn[q];
        const unsigned gw0 = q < 2 ? ga[2 * q] : gb[2 * q - 4], gw1 = q < 2 ? ga[2 * q + 1] : gb[2 * q - 3];
        const float y0 = o[q][0] * rn * g4[0] * silu_(bflo(gw0)), y1 = o[q][1] * rn * g4[1] * silu_(bfhi(gw0));
        const float y2 = o[q][2] * rn * g4[2] * silu_(bflo(gw1)), y3 = o[q][3] * rn * g4[3] * silu_(bfhi(gw1));
        if (q < 2) { w0[2 * q] = pk2(y0, y1); w0[2 * q + 1] = pk2(y2, y3); } else { w1[2 * q - 4] = pk2(y0, y1); w1[2 * q - 3] = pk2(y2, y3); }
    }
    u32x4* dst = (u32x4*)(out_row0 + (size_t)t * 1024 + seg * 16);
    dst[0] = w0; dst[1] = w1;
}

#define MFMA16(a, b, c) __builtin_amdgcn_mfma_f32_16x16x32_bf16((a), (b), (c), 0, 0, 0)
constexpr int LDH = 136, LDW = 68;
constexpr int G_QH = 0, G_KH = 17408, G_U = 0, G_VH = 34816, G_WT = 34816, G_A = 52224, G_NW = 68608, G_QD = 84992, G_KD = 101376, G_AI = 117760, G_SM = 125952;
DI bf16 f2bf(float x) { return (bf16)(pk2(x, 0.f) & 0xffffu); }
DI float dpp_xor1(float v) { return __int_as_float(__builtin_amdgcn_update_dpp(0, __float_as_int(v), 0xB1, 0xF, 0xF, true)); }
DI void norm_gate_store_pre(const float* Of, const f32x4 (&gn)[4], u32x4 ga, u32x4 gb, bf16* out_row0, int tid) {
    const int t = tid >> 3, seg = tid & 7;
    const f32x4* op = (const f32x4*)(Of + t * 128 + seg * 16);
    f32x4 o[4]; float ss = 0.f;
#pragma unroll
    for (int q = 0; q < 4; ++q) { o[q] = op[q]; ss += (o[q][0] * o[q][0] + o[q][1] * o[q][1]) + (o[q][2] * o[q][2] + o[q][3] * o[q][3]); }
    ss += __shfl_xor(ss, 1); ss += __shfl_xor(ss, 2); ss += __shfl_xor(ss, 4);
    const float rn = rsqrtf(ss * (1.0f / 128.0f) + EPS);
    u32x4 w0, w1;
#pragma unroll
    for (int q = 0; q < 4; ++q) {
        const f32x4 g4 = gn[q];
        const unsigned gw0 = q < 2 ? ga[2 * q] : gb[2 * q - 4], gw1 = q < 2 ? ga[2 * q + 1] : gb[2 * q - 3];
        const float y0 = o[q][0] * rn * g4[0] * silu_(bflo(gw0)), y1 = o[q][1] * rn * g4[1] * silu_(bfhi(gw0));
        const float y2 = o[q][2] * rn * g4[2] * silu_(bflo(gw1)), y3 = o[q][3] * rn * g4[3] * silu_(bfhi(gw1));
        if (q < 2) { w0[2 * q] = pk2(y0, y1); w0[2 * q + 1] = pk2(y2, y3); } else { w1[2 * q - 4] = pk2(y0, y1); w1[2 * q - 3] = pk2(y2, y3); }
    }
    u32x4* dst = (u32x4*)(out_row0 + (size_t)t * 1024 + seg * 16);
    dst[0] = w0; dst[1] = w1;
}
constexpr int SL_NW = 0, SL_QD = 16384, SL_KD = 32768, SL_AI = 49152, SL_UB = 55296, SL_BYTES = 71680, SL_FIRST = 1872;
DI unsigned char* gdn_slot(unsigned char* ws, int idx) { return idx < SL_FIRST ? ws + WS_XB + (size_t)idx * SL_BYTES : ws + WS_ZH + 240 * MiB + (size_t)(idx - SL_FIRST) * SL_BYTES; }
constexpr size_t WS_EGL = 381 * MiB + 262144;

DI void gdn_prep_unit(const Args& a, int idx, unsigned char* lds, const int wv_) {
    const int ch = idx & 31, h = (idx >> 5) & 3, b = idx >> 7, t0 = ch * 64;
    const bf16* Z = (const bf16*)(a.ws + WS_ZH);
    bf16* QH = (bf16*)(lds + G_QH); bf16* KH = (bf16*)(lds + G_KH); bf16* VH = (bf16*)(lds + G_VH); bf16* WT = (bf16*)(lds + G_WT); float* U = (float*)(lds + G_U); float* Am = (float*)(lds + G_A);
    unsigned char* NW = lds + G_NW; unsigned char* QD = lds + G_QD; unsigned char* KD = lds + G_KD; unsigned char* AI = lds + G_AI;
    float* Gs = (float*)(lds + G_SM); float* BETA = Gs + 64; float* EG = Gs + 128; float* BE = Gs + 192;
    int tl = TIDX(wv_); asm volatile("" : "+v"(tl));
    const int lane = tl & 63, w = tl >> 6, c0 = 2 * lane;
    const float* PAR = (const float*)(a.ws + WS_PAR); const float* convw = PAR + P_CONV;
    const float negA = -__expf(PAR[P_ALOG + h]), dtb = PAR[P_DTB + h];
    float qn[8][2], kn[8][2];
    float cwa[3][4][2];
#pragma unroll
    for (int ten = 0; ten < 3; ++ten)
#pragma unroll
        for (int jj = 0; jj < 4; ++jj) { cwa[ten][jj][0] = convw[jj * 1536 + ten * 512 + h * 128 + c0]; cwa[ten][jj][1] = convw[jj * 1536 + ten * 512 + h * 128 + c0 + 1]; }
#pragma unroll
    for (int ten = 0; ten < 3; ++ten) {
        float cw[4][2];
#pragma unroll
        for (int jj = 0; jj < 4; ++jj) { cw[jj][0] = cwa[ten][jj][0]; cw[jj][1] = cwa[ten][jj][1]; }
        unsigned pre[11];
#pragma unroll
        for (int rr = 0; rr < 11; ++rr) {
            const int t = t0 + 8 * w - 3 + rr; const int tc = t < 0 ? 0 : t;
            const unsigned u = *(const unsigned*)(Z + ((size_t)b * SEQ + tc) * N0 + 1536 + ten * 512 + h * 128 + c0);
            pre[rr] = t < 0 ? 0u : u;
        }
#pragma unroll
        for (int rr = 0; rr < 8; ++rr) {
            float y0 = 0.f, y1 = 0.f;
#pragma unroll
            for (int jj = 0; jj < 4; ++jj) { y0 += cw[jj][0] * bflo(pre[rr + jj]); y1 += cw[jj][1] * bfhi(pre[rr + jj]); }
            y0 = silu_(y0); y1 = silu_(y1);
            const int t = 8 * w + rr;
            if (ten < 2) {
                const float ss = wave_sum(y0 * y0 + y1 * y1); float sc = rsqrtf(ss + EPS);
                if (ten == 0) sc *= 0.08838834764831845f;
                y0 *= sc; y1 *= sc;
                if (ten == 0) { qn[rr][0] = y0; qn[rr][1] = y1; *(unsigned*)(QH + t * LDH + c0) = pk2(y0, y1); }
                else { kn[rr][0] = y0; kn[rr][1] = y1; *(unsigned*)(KH + t * LDH + c0) = pk2(y0, y1); }
            } else {
                *(unsigned*)(VH + t * LDH + c0) = pk2(y0, y1);
            }
        }
    }
    if (w == 0) {
        const size_t m = (size_t)b * SEQ + t0 + lane;
        const float gb = bf2f(Z[m * N0 + 3592 + h]), ga = bf2f(Z[m * N0 + 3596 + h]);
        float la = negA * softplus_(ga + dtb);
#pragma unroll
        for (int o = 1; o < 64; o <<= 1) { const float y = __shfl_up(la, o); if (lane >= o) la += y; }
        const float be = sigmoid_(gb), eg = __expf(la);
        Gs[lane] = la; BETA[lane] = be; EG[lane] = eg; BE[lane] = be * eg;
        if (lane == 63) ((float*)(a.ws + WS_EGL))[idx] = eg;
    }
    __syncthreads();
    {
        const int fr = lane & 15, fq = lane >> 4, tb = w >> 1;
#pragma unroll
        for (int si = 0; si < 2; ++si) {
            const int sb = 2 * (w & 1) + si; f32x4 akk = {0.f, 0.f, 0.f, 0.f}, aqk = {0.f, 0.f, 0.f, 0.f};
#pragma unroll
            for (int kk = 0; kk < 4; ++kk) {
                const bf16x8 kt = *(const bf16x8*)(KH + (16 * tb + fr) * LDH + kk * 32 + fq * 8);
                const bf16x8 qt = *(const bf16x8*)(QH + (16 * tb + fr) * LDH + kk * 32 + fq * 8);
                const bf16x8 ks_ = *(const bf16x8*)(KH + (16 * sb + fr) * LDH + kk * 32 + fq * 8);
                akk = MFMA16(kt, ks_, akk); aqk = MFMA16(qt, ks_, aqk);
            }
#pragma unroll
            for (int jj = 0; jj < 4; ++jj) {
                const int t = 16 * tb + 4 * fq + jj, s2 = 16 * sb + fr;
                const float dec = __expf(fminf(Gs[t] - Gs[s2], 0.f));
                Am[(s2 & 1) * 2048 + t * 32 + (s2 >> 1)] = s2 < t ? BETA[t] * akk[jj] * dec : 0.f;
                const float qkv = s2 <= t ? aqk[jj] * dec : 0.f;
                const int x = s2 & 15, hp = (x >> 2) & 1, j = ((x >> 3) << 2) | (x & 3);
                const int off = ((((t >> 5) * 4 + (s2 >> 4)) * 64) + hp * 32 + (t & 31)) * 16 + j * 2;
                *(bf16*)(AI + off) = f2bf(qkv);
            }
        }
        const float gl = Gs[63];
#pragma unroll
        for (int rr = 0; rr < 8; ++rr) {
            const int t = 8 * w + rr; const float eg = EG[t], ekd = __expf(gl - Gs[t]);
            {
                const int ks = c0 >> 4, x = c0 & 15, hp = (x >> 2) & 1, j = ((x >> 3) << 2) | (x & 3);
                const int off = ((((t >> 5) * 8 + ks) * 64) + hp * 32 + (t & 31)) * 16 + j * 2;
                *(unsigned*)(QD + off) = pk2(qn[rr][0] * eg, qn[rr][1] * eg);
            }
#pragma unroll
            for (int e = 0; e < 2; ++e) {
                const int dk = c0 + e, x = t & 15, hp = (x >> 2) & 1, j = ((x >> 3) << 2) | (x & 3);
                const int off = ((((dk >> 5) * 4 + (t >> 4)) * 64) + hp * 32 + (dk & 31)) * 16 + j * 2;
                *(bf16*)(KD + off) = f2bf(kn[rr][e] * ekd);
            }
        }
    }
    __syncthreads();
    unsigned char* slot = gdn_slot(a.ws, idx);
    {
#pragma unroll
        for (int k2 = 0; k2 < 2; ++k2) {
            const int q = tl + 512 * k2;
            __builtin_nontemporal_store(*(const u32x4*)(QD + q * 16), (u32x4*)(slot + SL_QD + q * 16));
            __builtin_nontemporal_store(*(const u32x4*)(KD + q * 16), (u32x4*)(slot + SL_KD + q * 16));
        }
        if (tl < 384) { const int src_off = tl < 128 ? tl * 16 : 4096 + (tl - 128) * 16; __builtin_nontemporal_store(*(const u32x4*)(AI + src_off), (u32x4*)(slot + SL_AI + tl * 16)); }
    }
    {
        const int c = tl >> 1, p = tl & 1;
        const float* Ap = Am + p * 2048;
        const float* scl = c < 128 ? BETA : BE;
        const bf16* src = c < 128 ? VH + c : KH + (c - 128);
        float xm[32];
#pragma unroll
        for (int i = 0; i < 32; ++i) xm[i] = 0.f;
        f32x4 ab[2][8]; float rh[2];
        rh[0] = scl[0] * bf2f(src[0]);
#pragma unroll
        for (int t = 0; t < 64; ++t) {
            if (t + 1 < 64) {
#pragma unroll
                for (int i4 = 0; i4 < (((t + 2) / 2) + 3) / 4; ++i4) ab[(t + 1) & 1][i4] = *(const f32x4*)(Ap + (t + 1) * 32 + 4 * i4);
                rh[(t + 1) & 1] = scl[t + 1] * bf2f(src[(t + 1) * LDH]);
            }
            __builtin_amdgcn_sched_barrier(0);
            float acc0 = 0.f, acc1 = 0.f;
#pragma unroll
            for (int i4 = 0; i4 < (((t + 1) / 2) + 3) / 4; ++i4) {
                const f32x4 a4 = ab[t & 1][i4];
                acc0 += a4[0] * xm[4 * i4];
                if (2 * (4 * i4 + 1) < t) acc1 += a4[1] * xm[4 * i4 + 1];
                if (2 * (4 * i4 + 2) < t) acc0 += a4[2] * xm[4 * i4 + 2];
                if (2 * (4 * i4 + 3) < t) acc1 += a4[3] * xm[4 * i4 + 3];
            }
            const float part = acc0 + acc1;
            const float xt = rh[t & 1] - (part + dpp_xor1(part));
            xm[t >> 1] = (p == (t & 1)) ? xt : xm[t >> 1];
            __builtin_amdgcn_sched_barrier(0);
        }
        __syncthreads();
        if (c < 128) {
#pragma unroll
            for (int i = 0; i < 32; ++i) U[(2 * i + p) * 128 + c] = xm[i];
        } else {
            const int dk = c - 128;
#pragma unroll
            for (int i = 0; i < 32; ++i) {
                const float other = dpp_xor1(xm[i]);
                const float lo = p ? other : xm[i], hi = p ? xm[i] : other;
                if ((i & 1) == 0) { if (p == 0) *(unsigned*)(WT + dk * LDW + 2 * i) = pk2(-lo, -hi); }
                else { if (p == 1) *(unsigned*)(WT + dk * LDW + 2 * i) = pk2(-lo, -hi); }
            }
        }
    }
    __syncthreads();
#pragma unroll
    for (int k2 = 0; k2 < 2; ++k2) {
        const int q = tl + 512 * k2, f = q >> 6, lp = q & 63, hp = lp >> 5, rp = lp & 31;
        const int t = 32 * (f >> 3) + rp, dkb = 16 * (f & 7) + 4 * hp;
        u32x4 o;
        o[0] = (unsigned)WT[(dkb + 0) * LDW + t] | ((unsigned)WT[(dkb + 1) * LDW + t] << 16);
        o[1] = (unsigned)WT[(dkb + 2) * LDW + t] | ((unsigned)WT[(dkb + 3) * LDW + t] << 16);
        o[2] = (unsigned)WT[(dkb + 8) * LDW + t] | ((unsigned)WT[(dkb + 9) * LDW + t] << 16);
        o[3] = (unsigned)WT[(dkb + 10) * LDW + t] | ((unsigned)WT[(dkb + 11) * LDW + t] << 16);
        __builtin_nontemporal_store(o, (u32x4*)(slot + SL_NW + q * 16));
    }
    {
        const int dq = tl >> 7, tt = (tl >> 6) & 1, lp = tl & 63, hp = lp >> 5, rp = lp & 31;
        const float* ub = U + (32 * tt + 4 * hp) * 128 + 32 * dq + rp;
        u32x4 o0, o1;
#pragma unroll
        for (int e = 0; e < 4; ++e) {
            const int i0 = 2 * e, i1 = 2 * e + 1, i2 = 8 + 2 * e, i3 = 9 + 2 * e;
            o0[e] = pk2(ub[((i0 & 3) + 8 * (i0 >> 2)) * 128], ub[((i1 & 3) + 8 * (i1 >> 2)) * 128]);
            o1[e] = pk2(ub[((i2 & 3) + 8 * (i2 >> 2)) * 128], ub[((i3 & 3) + 8 * (i3 >> 2)) * 128]);
        }
        u32x4* dst = (u32x4*)(slot + SL_UB + tl * 32);
        __builtin_nontemporal_store(o0, dst); __builtin_nontemporal_store(o1, dst + 1);
    }
    __syncthreads();
}

DI void gdn_scan_unit(const Args& a, int bh, unsigned char* lds, const int wv_) {
    const bf16* Z = (const bf16*)(a.ws + WS_ZH); bf16* MIX = (bf16*)(a.ws + WS_MIX);
    const float* PAR = (const float*)(a.ws + WS_PAR); const float* EGL = (const float*)(a.ws + WS_EGL);
    const int b = bh >> 2, h = bh & 3;
    int tid = TIDX(wv_); asm volatile("" : "+v"(tid));
    f32x16 S[4];
#pragma unroll
    for (int kb = 0; kb < 4; ++kb)
#pragma unroll
        for (int i = 0; i < 16; ++i) S[kb][i] = 0.f;
    {
        const unsigned char* sl = gdn_slot(a.ws, bh * 32);
        for (int q = tid; q < SL_BYTES / 16; q += 512) *(u32x4*)(lds + q * 16) = __builtin_nontemporal_load((const u32x4*)(sl + q * 16));
    }
    __syncthreads();
    u32x4 gate_na, gate_nb; float egl_n;
    {
        const u32x4* gp0 = (const u32x4*)(Z + ((size_t)b * SEQ + (tid >> 3)) * N0 + 3072 + h * 128 + (tid & 7) * 16);
        gate_na = gp0[0]; gate_nb = gp0[1]; egl_n = EGL[bh * 32];
    }
#pragma unroll 1
    for (int ch = 0; ch < 32; ++ch) {
        int tl = tid; asm volatile("" : "+v"(tl));
        const int lane = tl & 63, w = tl >> 6, r = lane & 31, hh = lane >> 5, dq = w & 3;
        const int idx = bh * 32 + ch;
        const unsigned cur = (ch & 1) * SL_BYTES, nxt = ((ch + 1) & 1) * SL_BYTES;
        const u32x4 gate_a = gate_na, gate_b = gate_nb; const float egl = egl_n;
        f32x4 gng[4];
#pragma unroll
        for (int q = 0; q < 4; ++q) gng[q] = *(const f32x4*)(PAR + P_GON + (tl & 7) * 16 + 4 * q);
        f32x16 O0, O1;
        if (w >= 4) {
            if (ch < 31) {
                const unsigned char* sl = gdn_slot(a.ws, idx + 1) + (tl - 256) * 16;
                unsigned char* dl = lds + nxt + (tl - 256) * 16;
#pragma unroll
                for (int k0 = 0; k0 < 18; k0 += 6) {
                    u32x4 stage[6];
#pragma unroll
                    for (int k = 0; k < 6; ++k) { if (k0 + k < 17 || tl - 256 < 128) stage[k] = __builtin_nontemporal_load((const u32x4*)(sl + (k0 + k) * 4096)); }
#pragma unroll
                    for (int k = 0; k < 6; ++k) { if (k0 + k < 17 || tl - 256 < 128) *(u32x4*)(dl + (k0 + k) * 4096) = stage[k]; }
                }
            }
        } else {
            lds_u8* l3 = (lds_u8*)lds;
            unsigned fo = cur + lane * 16; asm volatile("" : "+v"(fo)); const lds_u8* fp = l3 + fo;
#define LFRAG(o_) (*(const __attribute__((address_space(3))) bf16x8*)(fp + (o_)))
            bf16x8 xs[8];
#pragma unroll
            for (int kb = 0; kb < 4; ++kb)
#pragma unroll
                for (int s2 = 0; s2 < 2; ++s2) {
                    u32x4 t4;
#pragma unroll
                    for (int e = 0; e < 4; ++e) t4[e] = pk2(S[kb][8 * s2 + 2 * e], S[kb][8 * s2 + 2 * e + 1]);
                    xs[2 * kb + s2] = __builtin_bit_cast(bf16x8, t4);
                }
            f32x16 V0, V1;
            {
                const __attribute__((address_space(3))) u32x4* up = (const __attribute__((address_space(3))) u32x4*)(l3 + cur + SL_UB + ((dq * 2) * 64 + lane) * 32);
                const u32x4 a0 = up[0], a1 = up[1], b0 = up[128], b1 = up[129];
#pragma unroll
                for (int e = 0; e < 4; ++e) {
                    V0[2 * e] = bflo(a0[e]); V0[2 * e + 1] = bfhi(a0[e]); V0[8 + 2 * e] = bflo(a1[e]); V0[9 + 2 * e] = bfhi(a1[e]);
                    V1[2 * e] = bflo(b0[e]); V1[2 * e + 1] = bfhi(b0[e]); V1[8 + 2 * e] = bflo(b1[e]); V1[9 + 2 * e] = bfhi(b1[e]);
                }
            }
#pragma unroll
            for (int i = 0; i < 16; ++i) { O0[i] = 0.f; O1[i] = 0.f; }
#pragma unroll
            for (int ks = 0; ks < 8; ++ks) {
                V0 = MFMA32(LFRAG(SL_NW + (0 * 8 + ks) * 1024), xs[ks], V0);
                V1 = MFMA32(LFRAG(SL_NW + (1 * 8 + ks) * 1024), xs[ks], V1);
                O0 = MFMA32(LFRAG(SL_QD + (0 * 8 + ks) * 1024), xs[ks], O0);
                O1 = MFMA32(LFRAG(SL_QD + (1 * 8 + ks) * 1024), xs[ks], O1);
            }
            bf16x8 vx[4];
#pragma unroll
            for (int s2 = 0; s2 < 2; ++s2) {
                u32x4 t4, t5;
#pragma unroll
                for (int e = 0; e < 4; ++e) { t4[e] = pk2(V0[8 * s2 + 2 * e], V0[8 * s2 + 2 * e + 1]); t5[e] = pk2(V1[8 * s2 + 2 * e], V1[8 * s2 + 2 * e + 1]); }
                vx[s2] = __builtin_bit_cast(bf16x8, t4); vx[2 + s2] = __builtin_bit_cast(bf16x8, t5);
            }
#pragma unroll
            for (int ks = 0; ks < 2; ++ks) O0 = MFMA32(LFRAG(SL_AI + ks * 1024), vx[ks], O0);
#pragma unroll
            for (int ks = 0; ks < 4; ++ks) O1 = MFMA32(LFRAG(SL_AI + 2048 + ks * 1024), vx[ks], O1);
#pragma unroll
            for (int kb = 0; kb < 4; ++kb) {
#pragma unroll
                for (int i = 0; i < 16; ++i) S[kb][i] *= egl;
#pragma unroll
                for (int ks = 0; ks < 4; ++ks) S[kb] = MFMA32(LFRAG(SL_KD + (kb * 4 + ks) * 1024), vx[ks], S[kb]);
            }
#undef LFRAG
        }
        __syncthreads();
        if (w < 4) {
            unsigned obo = cur + ((4 * hh) * 128 + 32 * dq + r) * 4; asm volatile("" : "+v"(obo)); lds_f32* ob = (lds_f32*)((lds_u8*)lds + obo);
#pragma unroll
            for (int i = 0; i < 16; ++i) { ob[((i & 3) + 8 * (i >> 2)) * 128] = O0[i]; ob[(32 + (i & 3) + 8 * (i >> 2)) * 128] = O1[i]; }
        }
        __syncthreads();
        {
            const int cn = ch < 31 ? ch + 1 : ch;
            const u32x4* gpn = (const u32x4*)(Z + ((size_t)b * SEQ + cn * 64 + (tl >> 3)) * N0 + 3072 + h * 128 + (tl & 7) * 16);
            gate_na = gpn[0]; gate_nb = gpn[1]; egl_n = EGL[bh * 32 + cn];
        }
        norm_gate_store_pre((const float*)(lds + cur), gng, gate_a, gate_b, MIX + ((size_t)b * SEQ + ch * 64) * 1024 + 512 + h * 128, tl);
        __syncthreads();
    }
}

constexpr int L_QD = 0, L_KD = 16384, L_AI = 32768, L_VF = 40960, L_DEC = 57344, L_BF = 57856, L_QH = 90624, L_KH = 108032;
DI void hgrn_unit(const Args& a, int b, int h, unsigned char* lds, const int wv_) {
    const bf16* Z = (const bf16*)(a.ws + WS_ZH); bf16* MIX = (bf16*)(a.ws + WS_MIX);
    unsigned char* QD = lds + L_QD; unsigned char* KD = lds + L_KD; unsigned char* AI = lds + L_AI; unsigned char* VF = lds + L_VF;
    float* DEC = (float*)(lds + L_DEC); float* Bf = (float*)(lds + L_BF); bf16* QH = (bf16*)(lds + L_QH); bf16* KH = (bf16*)(lds + L_KH);
    float* TOT = (float*)(lds + L_KH + 17408);
    int tid = TIDX(wv_); asm volatile("" : "+v"(tid));
    const float* PAR = (const float*)(a.ws + WS_PAR); const float* lbl = PAR + P_LB;
    f32x16 S[4];
#pragma unroll
    for (int kb = 0; kb < 4; ++kb)
#pragma unroll
        for (int i = 0; i < 16; ++i) S[kb][i] = 0.f;
    unsigned pq[8], pf[8], pi[8];
    float lb0, lb1;
    {
        const int lane = tid & 63, w = tid >> 6, cg0 = h * 128 + 2 * lane;
        lb0 = 1.0f / (1.0f + __expf(lbl[cg0] - lbl[1024 + cg0])); lb1 = 1.0f / (1.0f + __expf(lbl[cg0 + 1] - lbl[1024 + cg0 + 1]));
#pragma unroll
        for (int rr = 0; rr < 8; ++rr) {
            const bf16* zp = Z + ((size_t)b * SEQ + 8 * w + rr) * 4096 + cg0;
            pq[rr] = *(const unsigned*)zp; pf[rr] = *(const unsigned*)(zp + 1024); pi[rr] = *(const unsigned*)(zp + 2048);
        }
    }
#pragma unroll 1
    for (int ch = 0; ch < 32; ++ch) {
        const int t0 = ch * 64;
        int tl = tid; asm volatile("" : "+v"(tl));
        const int lane = tl & 63, w = tl >> 6, r = lane & 31, hh = lane >> 5, c0 = 2 * lane, cg0 = h * 128 + c0;
        float qv[8][2], kv[8][2], Bl[8][2];
        {
            float run0 = 0.f, run1 = 0.f;
#pragma unroll
            for (int rr = 0; rr < 8; ++rr) {
                const int t = 8 * w + rr;
                const unsigned uq = pq[rr], uf = pf[rr], ui = pi[rr];
                qv[rr][0] = silu_(bflo(uq)); qv[rr][1] = silu_(bfhi(uq));
                const float f0 = lb0 + (1.f - lb0) * sigmoid_(bflo(uf)), f1 = lb1 + (1.f - lb1) * sigmoid_(bfhi(uf));
                kv[rr][0] = 1.f - f0; kv[rr][1] = 1.f - f1;
                run0 += __logf(f0); run1 += __logf(f1);
                Bl[rr][0] = run0; Bl[rr][1] = run1;
#pragma unroll
                for (int e = 0; e < 2; ++e) {
                    const int dv = c0 + e; const int off = ((((dv >> 5) * 4 + (t >> 4)) * 64) + ((t >> 3) & 1) * 32 + (dv & 31)) * 16 + (t & 7) * 2;
                    *(bf16*)(VF + off) = (bf16)(e ? (ui >> 16) : (ui & 0xffffu));
                }
            }
            TOT[w * 128 + c0] = run0; TOT[w * 128 + c0 + 1] = run1;
        }
        {
            const int tn = (ch < 31 ? t0 + 64 : t0);
#pragma unroll
            for (int rr = 0; rr < 8; ++rr) {
                const bf16* zp = Z + ((size_t)b * SEQ + tn + 8 * w + rr) * 4096 + cg0;
                pq[rr] = *(const unsigned*)zp; pf[rr] = *(const unsigned*)(zp + 1024); pi[rr] = *(const unsigned*)(zp + 2048);
            }
        }
        const u32x4* gatep = (const u32x4*)(Z + ((size_t)b * SEQ + t0 + (tl >> 3)) * 4096 + 3072 + h * 128 + (tl & 7) * 16);
        const u32x4 gate_a = gatep[0], gate_b = gatep[1];

        __syncthreads();
        {
            float off0 = 0.f, off1 = 0.f, bm0 = 0.f, bm1 = 0.f, bl0 = 0.f, bl1 = 0.f;
#pragma unroll
            for (int ww = 0; ww < 8; ++ww) {
                const float t0v = TOT[ww * 128 + c0], t1v = TOT[ww * 128 + c0 + 1];
                if (ww < w) { off0 += t0v; off1 += t1v; }
                if (ww < 4) { bm0 += t0v; bm1 += t1v; }
                bl0 += t0v; bl1 += t1v;
            }
            if (w == 0) { DEC[c0] = __expf(bl0); DEC[c0 + 1] = __expf(bl1); }
#pragma unroll
            for (int rr = 0; rr < 8; ++rr) {
                const int t = 8 * w + rr;
                const float B0 = Bl[rr][0] + off0, B1 = Bl[rr][1] + off1;
                const float qd0 = qv[rr][0] * __expf(B0), qd1 = qv[rr][1] * __expf(B1);
                const float qh0 = qv[rr][0] * __expf(fminf(B0 - bm0, 80.f)), qh1 = qv[rr][1] * __expf(fminf(B1 - bm1, 80.f));
                const float kh0 = kv[rr][0] * __expf(fminf(bm0 - B0, 80.f)), kh1 = kv[rr][1] * __expf(fminf(bm1 - B1, 80.f));
                const float kd0 = kv[rr][0] * __expf(bl0 - B0), kd1 = kv[rr][1] * __expf(bl1 - B1);
                {
                    const int ks = c0 >> 4, x = c0 & 15, hp = (x >> 2) & 1, j = ((x >> 3) << 2) | (x & 3);
                    const int off = ((((t >> 5) * 8 + ks) * 64) + hp * 32 + (t & 31)) * 16 + j * 2;
                    *(unsigned*)(QD + off) = pk2(qd0, qd1);
                }
#pragma unroll
                for (int e = 0; e < 2; ++e) {
                    const int dk = c0 + e; const int off = ((((dk >> 5) * 4 + (t >> 4)) * 64) + ((t >> 3) & 1) * 32 + (dk & 31)) * 16 + (t & 7) * 2;
                    *(bf16*)(KD + off) = f2bf(e ? kd1 : kd0);
                }
                *(unsigned*)(QH + t * LDH + c0) = pk2(qh0, qh1);
                *(unsigned*)(KH + t * LDH + c0) = pk2(kh0, kh1);
            }
        }
        __syncthreads();
        {
            const int fr = lane & 15, fq = lane >> 4, tb = w >> 1;
#pragma unroll
            for (int si = 0; si < 2; ++si) {
                const int sb = 2 * (w & 1) + si; f32x4 acc = {0.f, 0.f, 0.f, 0.f};
#pragma unroll
                for (int kk = 0; kk < 4; ++kk) {
                    const bf16x8 av = *(const bf16x8*)(QH + (16 * tb + fr) * LDH + kk * 32 + fq * 8);
                    const bf16x8 bv = *(const bf16x8*)(KH + (16 * sb + fr) * LDH + kk * 32 + fq * 8);
                    acc = MFMA16(av, bv, acc);
                }
#pragma unroll
                for (int jj = 0; jj < 4; ++jj) {
                    const int t = 16 * tb + 4 * fq + jj, s2 = 16 * sb + fr;
                    const float val = s2 <= t ? acc[jj] : 0.f;
                    const int off = ((((t >> 5) * 4 + (s2 >> 4)) * 64) + ((s2 >> 3) & 1) * 32 + (t & 31)) * 16 + (s2 & 7) * 2;
                    *(bf16*)(AI + off) = f2bf(val);
                }
            }
        }
        __syncthreads();
        if (w < 4) {
            const int dq = w;
            bf16x8 xs[8];
#pragma unroll
            for (int kb = 0; kb < 4; ++kb)
#pragma unroll
                for (int s2 = 0; s2 < 2; ++s2) {
                    u32x4 t4;
#pragma unroll
                    for (int e = 0; e < 4; ++e) t4[e] = pk2(S[kb][8 * s2 + 2 * e], S[kb][8 * s2 + 2 * e + 1]);
                    xs[2 * kb + s2] = __builtin_bit_cast(bf16x8, t4);
                }
            f32x16 O0, O1;
            unsigned obo = L_BF + ((4 * hh) * 128 + 32 * dq + r) * 4; asm volatile("" : "+v"(obo)); lds_f32* ob = (lds_f32*)((lds_u8*)lds + obo);
#pragma unroll
            for (int i = 0; i < 16; ++i) { O0[i] = 0.f; O1[i] = 0.f; }
            lds_u8* l3 = (lds_u8*)lds; unsigned fo = lane * 16; asm volatile("" : "+v"(fo)); const lds_u8* fp = l3 + fo;
#define HF(o_) (*(const __attribute__((address_space(3))) bf16x8*)(fp + (o_)))
#define SB() __builtin_amdgcn_sched_barrier(0)
            bf16x8 ga[8], gb[8];
#pragma unroll
            for (int k = 0; k < 4; ++k) { ga[k] = HF(L_QD + (0 * 8 + k) * 1024); ga[4 + k] = HF(L_QD + (1 * 8 + k) * 1024); }
#pragma unroll
            for (int k = 0; k < 4; ++k) { gb[k] = HF(L_QD + (0 * 8 + 4 + k) * 1024); gb[4 + k] = HF(L_QD + (1 * 8 + 4 + k) * 1024); }
            SB();
#pragma unroll
            for (int k = 0; k < 4; ++k) { O0 = MFMA32(ga[k], xs[k], O0); O1 = MFMA32(ga[4 + k], xs[k], O1); }
            SB();
#pragma unroll
            for (int k = 0; k < 4; ++k) ga[k] = HF(L_VF + (dq * 4 + k) * 1024);
            ga[4] = HF(L_AI + (0 * 4 + 0) * 1024); ga[5] = HF(L_AI + (0 * 4 + 1) * 1024); ga[6] = HF(L_AI + (1 * 4 + 0) * 1024); ga[7] = HF(L_AI + (1 * 4 + 1) * 1024);
            SB();
#pragma unroll
            for (int k = 0; k < 4; ++k) { O0 = MFMA32(gb[k], xs[4 + k], O0); O1 = MFMA32(gb[4 + k], xs[4 + k], O1); }
            SB();
            gb[0] = HF(L_AI + (1 * 4 + 2) * 1024); gb[1] = HF(L_AI + (1 * 4 + 3) * 1024);
#pragma unroll
            for (int k = 0; k < 4; ++k) gb[2 + k] = HF(L_KD + (0 * 4 + k) * 1024);
            f32x4 dd[4];
#define LDD(kb_) do { _Pragma("unroll") for (int g = 0; g < 4; ++g) dd[g] = *(const f32x4*)(DEC + 32 * (kb_) + 8 * g + 4 * hh); } while (0)
#define MULD(kb_) do { _Pragma("unroll") for (int g = 0; g < 4; ++g) _Pragma("unroll") for (int e = 0; e < 4; ++e) S[kb_][4 * g + e] *= dd[g][e]; } while (0)
            LDD(0);
            SB();
            const bf16x8 vf0 = ga[0], vf1 = ga[1], vf2 = ga[2], vf3 = ga[3];
            O0 = MFMA32(ga[4], vf0, O0); O0 = MFMA32(ga[5], vf1, O0); O1 = MFMA32(ga[6], vf0, O1); O1 = MFMA32(ga[7], vf1, O1);
            SB();
#pragma unroll
            for (int k = 0; k < 4; ++k) ga[4 + k] = HF(L_KD + (1 * 4 + k) * 1024);
            SB();
            O1 = MFMA32(gb[0], vf2, O1); O1 = MFMA32(gb[1], vf3, O1);
            MULD(0);
            S[0] = MFMA32(gb[2], vf0, S[0]); S[0] = MFMA32(gb[3], vf1, S[0]); S[0] = MFMA32(gb[4], vf2, S[0]); S[0] = MFMA32(gb[5], vf3, S[0]);
            SB();
            LDD(1);
#pragma unroll
            for (int k = 0; k < 4; ++k) gb[k] = HF(L_KD + (2 * 4 + k) * 1024);
            SB();
            MULD(1);
            S[1] = MFMA32(ga[4], vf0, S[1]); S[1] = MFMA32(ga[5], vf1, S[1]); S[1] = MFMA32(ga[6], vf2, S[1]); S[1] = MFMA32(ga[7], vf3, S[1]);
            SB();
            LDD(2);
#pragma unroll
            for (int k = 0; k < 4; ++k) ga[4 + k] = HF(L_KD + (3 * 4 + k) * 1024);
            SB();
            MULD(2);
            S[2] = MFMA32(gb[0], vf0, S[2]); S[2] = MFMA32(gb[1], vf1, S[2]); S[2] = MFMA32(gb[2], vf2, S[2]); S[2] = MFMA32(gb[3], vf3, S[2]);
            SB();
            LDD(3);
            SB();
            MULD(3);
            S[3] = MFMA32(ga[4], vf0, S[3]); S[3] = MFMA32(ga[5], vf1, S[3]); S[3] = MFMA32(ga[6], vf2, S[3]); S[3] = MFMA32(ga[7], vf3, S[3]);
#undef LDD
#undef MULD
#undef HF
#undef SB
#pragma unroll
            for (int i = 0; i < 16; ++i) { ob[((i & 3) + 8 * (i >> 2)) * 128] = O0[i]; ob[(32 + (i & 3) + 8 * (i >> 2)) * 128] = O1[i]; }
        }
        f32x4 gnh[4];
#pragma unroll
        for (int q = 0; q < 4; ++q) gnh[q] = *(const f32x4*)(PAR + P_HON + (tl & 7) * 16 + 4 * q);
        __syncthreads();
        norm_gate_store_pre(Bf, gnh, gate_a, gate_b, MIX + ((size_t)b * SEQ + t0) * 1024 + h * 128, tl);
    }
    __syncthreads();
}

#define LAS __attribute__((address_space(3)))
#define XB_TMO      128
#define XB_XCNT(j)  (256  + 64 * (j))
#define XB_XSUB(j)  (1280 + 64 * (j))
#define XB_XGEN(j)  (2304 + 64 * (j))
#define XB_TOP      3328
#define XB_TOPGEN   3392
#define XCD_BAR_WORDS 3456
#define XB_SPIN_CAP (1u << 18)

__device__ __forceinline__ unsigned xb_ld(unsigned* p)              { return __hip_atomic_load(p, __ATOMIC_RELAXED, __HIP_MEMORY_SCOPE_AGENT); }
__device__ __forceinline__ unsigned xb_add(unsigned* p, unsigned v) { return __hip_atomic_fetch_add(p, v, __ATOMIC_RELAXED, __HIP_MEMORY_SCOPE_AGENT); }
__device__ __forceinline__ unsigned xb_xcc_id() { return (unsigned)__builtin_amdgcn_s_getreg((3 << 11) | 20) & 0xFu; }
#define XB_SPIN(cond, bar) do { unsigned _sp = 0; while (cond) { __builtin_amdgcn_s_sleep(1); \
    if ((++_sp & 255u) == 0u) { if (xb_ld(&(bar)[XB_TMO])) break; if (_sp > XB_SPIN_CAP) { atomicAdd(&(bar)[XB_TMO], 1u); break; } } } } while (0)

struct XcdBarrier {
    unsigned* bar; unsigned x;
    volatile LAS unsigned* st;
};

__device__ __forceinline__ XcdBarrier xcd_barrier_post(unsigned* bar, volatile LAS unsigned* st, const bool t0_) {
    XcdBarrier b; b.bar = bar; b.x = xb_xcc_id(); b.st = st;
    if (t0_) (void)xb_add(&bar[XB_XCNT(b.x)], 1u);
    return b;
}
__device__ __forceinline__ void xcd_barrier_complete(unsigned* bar, unsigned x, unsigned& nloc, unsigned& nx) {
    const unsigned G = gridDim.x * gridDim.y * gridDim.z;
    unsigned sum, cnt, mine, sp = 0u;
    for (;;) {
        sum = 0u; cnt = 0u; mine = 0u;
#pragma unroll
        for (unsigned j = 0; j < 16; ++j) { const unsigned c = xb_ld(&bar[XB_XCNT(j)]); sum += c; cnt += (c > 0u) ? 1u : 0u; mine = (j == x) ? c : mine; }
        if (sum == G) break;
        __builtin_amdgcn_s_sleep(1);
        if ((++sp & 255u) == 0u) { if (xb_ld(&bar[XB_TMO])) break; if (sp > XB_SPIN_CAP) { atomicAdd(&bar[XB_TMO], 1u); break; } }
    }
    nloc = mine > 0u ? mine : 1u; nx = cnt > 0u ? cnt : 1u;
}

__device__ __forceinline__ void xcd_barrier(const XcdBarrier& b, const bool t0_) {
    asm volatile("s_waitcnt vmcnt(0)" ::: "memory");
    __syncthreads();
    if (t0_) {
        unsigned* bar = b.bar;
        __builtin_amdgcn_s_waitcnt(0);
        unsigned nloc = b.st[0], nx = b.st[1];
        if (nloc == 0u) { xcd_barrier_complete(bar, b.x, nloc, nx); b.st[0] = nloc; b.st[1] = nx; }
        const unsigned old = xb_add(&bar[XB_XSUB(b.x)], 1u);
        const unsigned gen = old / nloc;
        if (old + 1u == (gen + 1u) * nloc) {
            __builtin_amdgcn_fence(__ATOMIC_RELEASE, "agent");
            asm volatile("s_waitcnt vmcnt(0)" ::: "memory");
            const unsigned og = xb_add(&bar[XB_TOP], 1u);
            const unsigned tg = og / nx;
            if (og + 1u == (tg + 1u) * nx) xb_add(&bar[XB_TOPGEN], 1u);
            else XB_SPIN(xb_ld(&bar[XB_TOPGEN]) == tg, bar);
            __builtin_amdgcn_fence(__ATOMIC_ACQUIRE, "agent");
            xb_add(&bar[XB_XGEN(b.x)], 1u);
            asm volatile("s_waitcnt vmcnt(0)" ::: "memory");
        } else {
            XB_SPIN(xb_ld(&bar[XB_XGEN(b.x)]) == gen, bar);
            __builtin_amdgcn_fence(__ATOMIC_ACQUIRE, "agent");
            asm volatile("s_waitcnt vmcnt(0)" ::: "memory");
        }
    }
    __syncthreads();
}

__global__ void __launch_bounds__(512, 2) trunk_fwd(Args a) {
    extern __shared__ __attribute__((aligned(16))) unsigned char lds[];
    __builtin_assume(__builtin_amdgcn_workitem_id_y() == 0); __builtin_assume(__builtin_amdgcn_workitem_id_z() == 0);
    cg::grid_group grid = cg::this_grid();
    const int G = gridDim.x, blk = blockIdx.x;
    unsigned char* ws = a.ws;
    PG8_LAS unsigned char* lds3 = (PG8_LAS unsigned char*)lds;
    bf16* XB = (bf16*)(ws + WS_XB); bf16* MIX = (bf16*)(ws + WS_MIX); bf16* ZH = (bf16*)(ws + WS_ZH); float* SS = (float*)(ws + WS_SS);

    volatile LAS unsigned* bst = (volatile LAS unsigned*)((LAS unsigned char*)lds + (LDS_BYTES - 64));
    const int WV = __builtin_amdgcn_readfirstlane((int)(threadIdx.x >> 6));
    if (WV == 0 && lane_id_() == 0) { bst[0] = 0u; bst[1] = 0u; }
    __syncthreads();
    (void)xcd_barrier_post((unsigned*)(ws + WS_BAR), bst, WV == 0 && lane_id_() == 0);
#define GRID_BAR() do { unsigned char* wsl_ = a.ws; asm volatile("" : "+s"(wsl_)); XcdBarrier xb_; xb_.bar = (unsigned*)(wsl_ + WS_BAR); xb_.x = xb_xcc_id(); xb_.st = (volatile LAS unsigned*)((LAS unsigned char*)lds + (LDS_BYTES - 64)); xcd_barrier(xb_, WV == 0 && lane_id_() == 0); } while (0)
    p0_prologue(a, lds, WV);
    if (a.ws == nullptr) grid.sync();
    GRID_BAR();
    _Pragma("unroll") for (int layer = 0; layer < 2; ++layer) {
        const int NIN = layer == 0 ? N0 : 4096;
        if (layer == 0) {
            pg8::Gemm g{XB, (const bf16*)(ws + WS_W0IN), M, N0, 1024}; int blkl = blk; asm volatile("" : "+s"(blkl)); pg8::StaticOrder S; S.init(M, N0, G, blkl, WGM_WIDE);
            rs_table_build<true>(lds, SS, S, WV);
            EpiAct<2> E{ZH, N0, (const float*)(ws + WS_PAR), (const lds_f32_t*)((PG8_LAS unsigned char*)lds + RS_OFF), 0};
            pg8::gemm_phase<EpiAct<2>, pg8::StaticOrder, true, true>(lds3, g, S, E, WV);
        } else {
            pg8::Gemm g{XB, (const bf16*)(ws + WS_W1IN), M, 4096, 1024}; int blkl = blk; asm volatile("" : "+s"(blkl)); pg8::StaticOrder S; S.init(M, 4096, G, blkl, WGM_WIDE);
            rs_table_build<false>(lds, SS + (size_t)2 * SS_STRIDE, S, WV);
            EpiAct<0> E{ZH, 4096, nullptr, (const lds_f32_t*)((PG8_LAS unsigned char*)lds + RS_OFF), 0};
            pg8::gemm_phase<EpiAct<0>, pg8::StaticOrder, true, true>(lds3, g, S, E, WV);
        }
        GRID_BAR();
        if (layer == 0) {
            fox_prep(a, WV);
            for (int u = blk; u < 2048; u += G) gdn_prep_unit(a, u, lds, WV);
            GRID_BAR();
            const float* C2g = (const float*)(ws + WS_C2);
            int Gl = G; asm volatile("" : "+s"(Gl));
            const bool bal = (Gl == 256); const int sstride = bal ? 64 : Gl;
            if (blk < sstride) for (int u = blk; u < 64; u += sstride) gdn_scan_unit(a, u, lds, WV);
            const int nk = bal ? 4 : (1024 + Gl - 1) / Gl;
#pragma unroll 1
            for (int k = 0; k < nk; ++k) {
                const int i = blk - 64;
                const int u = bal ? (blk < 64 ? 768 + 64 * k + blk : 192 * k + ((k & 1) ? 191 - i : i)) : blk + Gl * k;
                if (u < 1024) { const int qb = 7 - (u >> 7), bh = u & 127; fox_unit(ZH, C2g, MIX, bh >> 3, bh & 7, qb, lds, WV); }
            }
        } else {
            for (int u = blk; u < 128; u += G) hgrn_unit(a, u >> 3, u & 7, lds, WV);
        }
        GRID_BAR();
        if (layer == 0) {
            pg8::Gemm g{MIX, (const bf16*)(ws + WS_W0OUT), M, 1024, 1024}; int blkl = blk; asm volatile("" : "+s"(blkl)); pg8::StaticOrder S; S.init(M, 1024, G, blkl);
            EpiRes<false, false> E{a.in[0], nullptr, XB, SS + (size_t)1 * SS_STRIDE};
            pg8::gemm_phase<EpiRes<false, false>, pg8::StaticOrder, true, true>(lds3, g, S, E, WV);
        } else {
            pg8::Gemm g{MIX, (const bf16*)(ws + WS_W1OUT), M, 1024, 1024}; int blkl = blk; asm volatile("" : "+s"(blkl)); pg8::StaticOrder S; S.init(M, 1024, G, blkl);
            EpiRes<true, false> E{XB, nullptr, XB, SS + (size_t)3 * SS_STRIDE};
            pg8::gemm_phase<EpiRes<true, false>, pg8::StaticOrder, true, true>(lds3, g, S, E, WV);
        }
        GRID_BAR();
        {
            pg8::Gemm g{XB, (const bf16*)(ws + (layer == 0 ? WS_W0F1 : WS_W1F1)), M, 4096, 1024}; int blkl = blk; asm volatile("" : "+s"(blkl)); pg8::StaticOrder S; S.init(M, 4096, G, blkl, WGM_WIDE);
            rs_table_build<false>(lds, SS + (size_t)(2 * layer + 1) * SS_STRIDE, S, WV);
            EpiAct<1> E{ZH, 4096, nullptr, (const lds_f32_t*)((PG8_LAS unsigned char*)lds + RS_OFF), 0};
            pg8::gemm_phase<EpiAct<1>, pg8::StaticOrder, true, true>(lds3, g, S, E, WV);
        }
        GRID_BAR();
        if (layer == 0) {
            pg8::Gemm g{ZH, (const bf16*)(ws + WS_W0F2), M, 1024, 4096}; int blkl = blk; asm volatile("" : "+s"(blkl)); pg8::StaticOrder S; S.init(M, 1024, G, blkl);
            EpiRes<true, false> E{XB, nullptr, XB, SS + 2 * SS_STRIDE};
            pg8::gemm_phase<EpiRes<true, false>, pg8::StaticOrder, true, true>(lds3, g, S, E, WV);
        } else {
            pg8::Gemm g{ZH, (const bf16*)(ws + WS_W1F2), M, 1024, 4096}; int blkl = blk; asm volatile("" : "+s"(blkl)); pg8::StaticOrder S; S.init(M, 1024, G, blkl);
            EpiRes<true, true> E{XB, a.out, nullptr, nullptr};
            pg8::gemm_phase<EpiRes<true, true>, pg8::StaticOrder, true, true>(lds3, g, S, E, WV);
        }
        if (layer == 0) GRID_BAR();
    }
}

extern "C" void kernel_launch(void* const* d_in, const int* in_sizes, int n_in, void* d_out, int out_size, void* d_ws, size_t ws_size, hipStream_t stream) {
    static int grid = 0;
    if (grid == 0) {
        if (n_in != 22 || out_size != M * DM || ws_size < WS_END) { fprintf(stderr, "kernel_launch: unexpected problem (n_in %d out %d ws %zu)\n", n_in, out_size, ws_size); grid = -1; return; }
        int dev = 0, cus = 0, per_cu = 0;
        (void)hipGetDevice(&dev);
        (void)hipDeviceGetAttribute(&cus, hipDeviceAttributeMultiprocessorCount, dev);
        (void)hipFuncSetAttribute((const void*)trunk_fwd, hipFuncAttributeMaxDynamicSharedMemorySize, LDS_BYTES);
        (void)hipOccupancyMaxActiveBlocksPerMultiprocessor(&per_cu, (const void*)trunk_fwd, 512, LDS_BYTES);
        if (per_cu < 1) per_cu = 1;
        grid = cus * per_cu;
        fprintf(stderr, "kernel_launch: grid %d (cus %d x %d)\n", grid, cus, per_cu);
    }
    if (grid < 0) return;
    Args a{};
    for (int i = 0; i < 22; ++i) a.in[i] = (const float*)d_in[i];
    a.out = (float*)d_out; a.ws = (unsigned char*)d_ws;
    (void)hipMemsetAsync((unsigned char*)d_ws + WS_BAR, 0, 16384, stream);
    void* args[] = {&a};
    hipError_t e = hipLaunchCooperativeKernel((const void*)trunk_fwd, dim3(grid), dim3(512), args, LDS_BYTES, stream);
    if (e != hipSuccess) fprintf(stderr, "kernel_launch: cooperative launch failed: %s (grid %d)\n", hipGetErrorString(e), grid);
}
```

```cpp
#include <hip/hip_runtime.h>
#include <hip/hip_cooperative_groups.h>
#include <cstdio>
#include <cstdint>
namespace cg = cooperative_groups;
__device__ __forceinline__ int lane_id_() { int l; asm volatile("v_mbcnt_lo_u32_b32 %0, -1, 0\n\tv_mbcnt_hi_u32_b32 %0, -1, %0" : "=v"(l)); return l; }
#define TIDX(wv_) ((wv_) * 64 + lane_id_())
namespace pg8 {
#define PG8_LAS __attribute__((address_space(3)))
typedef unsigned short bf16_t;
typedef short bf16x8 __attribute__((ext_vector_type(8)));
typedef float f32x4 __attribute__((ext_vector_type(4)));
typedef unsigned u32x4 __attribute__((ext_vector_type(4)));
constexpr int BM = 256, BK = 64, HALF = 128, HTB = HALF * BK * 2  , STAGE_BYTES = 8 * HTB, NXCD = 8, WGM = 8;

__host__ __device__ __forceinline__ int lds_byte(int r, int c) { const int st = (r >> 4) * 2 + (c >> 5), rr = r & 15, cc = c & 31, ob = rr * 64 + cc * 2; return st * 1024 + (ob ^ (((ob >> 9) & 1) << 5)); }
__host__ __device__ __forceinline__ void stage_rc(int b, int& R, int& C) { const int st = b / 1024, sb = b % 1024, swz = sb ^ (((sb >> 9) & 1) << 5); R = (st >> 1) * 16 + swz / 64; C = (st & 1) * 32 + (swz % 64) / 2; }
__host__ __device__ __forceinline__ int perm32(int rho) { const int n = rho >> 4, i = rho & 15; return 8 * (i >> 2) + 4 * n + (i & 3); }

struct Unit { int pm, pn; };
struct Gemm { const bf16_t* A; const bf16_t* Bt; int M, N, K; };

struct StaticOrder {
    int nM, nN, nwg, G, c, wgm;
    __host__ __device__ void init(int M, int N, int G_, int c_, int wgm_ = WGM) { nM = M / BM; nN = N / BM; nwg = nM * nN; G = G_; c = c_; wgm = wgm_; }
    __host__ __device__ bool next(int i, Unit& u) const {
        const long L = (long)i * G + c; if (L >= nwg) return false;
        int wgid = (int)L; { const int q = nwg / NXCD, r = nwg % NXCD, xcd = wgid % NXCD, off = wgid / NXCD; wgid = (xcd < r ? xcd * (q + 1) : r * (q + 1) + (xcd - r) * q) + off; }
        const int nig = wgm * nN, gid = wgid / nig, fm = gid * wgm, gsz = (nM - fm) < wgm ? (nM - fm) : wgm;
        u.pm = fm + ((wgid % nig) % gsz); u.pn = (wgid % nig) / gsz; return true;
    }
    __device__ __forceinline__ void a_ready(const Unit&) const {}
    __device__ __forceinline__ void done(const Unit&) const {}
};

__device__ __forceinline__ unsigned cvt_pk_bf16_unused(float lo, float hi) { return 0; }
template <class Epi, class Sched, bool ALIGN_EPI = false, bool SP2 = false>
__device__ __forceinline__ void gemm_phase(PG8_LAS unsigned char* lds, const Gemm g, const Sched& S, const Epi& E, const int wv_) {
    int tid_ = TIDX(wv_); asm volatile("" : "+v"(tid_)); const int tid = tid_, wid = __builtin_amdgcn_readfirstlane(tid >> 6), lane = tid & 63, wr = wid >> 2, wc = wid & 3, fr = lane & 15, fq = lane >> 4;
    const int K = g.K, nt = K / BK;
    unsigned voffA[2], voffB[2];
#pragma unroll
    for (int i = 0; i < 2; ++i) { int R, C; stage_rc(tid * 16 + i * 8192, R, C); const int Rb = Epi::PERM ? ((R & ~31) + perm32(R & 31)) : R;
        voffA[i] = (unsigned)(R * K + C) * 2u; voffB[i] = (unsigned)(Rb * K + C) * 2u; }
    const size_t kstep = (size_t)(BK * 2);
    const size_t hstep = (size_t)HALF * K * 2;
    const size_t tstep = 2 * hstep;
    const unsigned ldsw = (unsigned)wid * 1024u;
    const int aoff = lds_byte(wr * 64 + fr, fq * 8), boff = lds_byte(wc * 32 + fr, fq * 8);
#define PG8_SA(b, h) (((b) * 2 + (h)) * HTB)
#define PG8_SB(b, h) ((4 + (b) * 2 + (h)) * HTB)
#define PG8_STAGE(bufoff, gbase, voff) do { _Pragma("unroll") for (int _i = 0; _i < 2; ++_i) \
        __builtin_amdgcn_global_load_lds((const unsigned*)((const char*)(gbase) + (voff)[_i]), (PG8_LAS unsigned*)(lds + (bufoff) + ldsw + _i * 8192), 16, 0, 0); } while (0)
#define PG8_LDA(dst, b, h) do { _Pragma("unroll") for (int m = 0; m < 4; ++m) _Pragma("unroll") for (int k = 0; k < 2; ++k) dst[m][k] = *(const PG8_LAS bf16x8*)(lds + PG8_SA(b, h) + aoff + m * 2048 + k * 1024); } while (0)
#define PG8_LDB(dst, b, h) do { _Pragma("unroll") for (int n = 0; n < 2; ++n) _Pragma("unroll") for (int k = 0; k < 2; ++k) dst[n][k] = *(const PG8_LAS bf16x8*)(lds + PG8_SB(b, h) + boff + n * 2048 + k * 1024); } while (0)
#define PG8_MMA(ai, bj, At, Bt) do { __builtin_amdgcn_s_setprio(1); _Pragma("unroll") for (int m = 0; m < 4; ++m) _Pragma("unroll") for (int n = 0; n < 2; ++n) _Pragma("unroll") for (int k = 0; k < 2; ++k) \
        acc[ai][bj][m][n] = __builtin_amdgcn_mfma_f32_16x16x32_bf16(Bt[n][k], At[m][k], acc[ai][bj][m][n], 0, 0, 0); __builtin_amdgcn_s_setprio(0); } while (0)
#define PG8_WAIT_V(n) asm volatile("s_waitcnt vmcnt(" #n ")" ::: "memory")
#define PG8_WAIT_L(n) asm volatile("s_waitcnt lgkmcnt(" #n ")" ::: "memory")
#define PG8_BAR __builtin_amdgcn_s_barrier()
#define PG8_SCHED __builtin_amdgcn_sched_barrier(0)
    Unit cur, nxt; int ui = 0;
    if (!S.next(0, cur)) return;
    f32x4 acc[2][2][4][2];
#pragma unroll
    for (int a = 0; a < 2; ++a)
#pragma unroll
        for (int b = 0; b < 2; ++b)
#pragma unroll
            for (int m = 0; m < 4; ++m)
#pragma unroll
                for (int n = 0; n < 2; ++n) acc[a][b][m][n] = (f32x4){0.f, 0.f, 0.f, 0.f};
    bf16x8 At[4][2], B0[2][2], B1[2][2];
    const char* cA = (const char*)g.A + (size_t)cur.pm * tstep; const char* cB = (const char*)g.Bt + (size_t)cur.pn * tstep;
    S.a_ready(cur);
    if constexpr (SP2) {
        PG8_STAGE(PG8_SB(0, 0), cB, voffB); PG8_STAGE(PG8_SB(0, 1), cB + hstep, voffB); PG8_STAGE(PG8_SA(0, 0), cA, voffA); PG8_STAGE(PG8_SA(0, 1), cA + hstep, voffA);
        if (wr == 1) PG8_BAR;
        PG8_WAIT_V(2); PG8_BAR;
        PG8_STAGE(PG8_SB(1, 0), cB + kstep, voffB); PG8_STAGE(PG8_SA(1, 0), cA + kstep, voffA); PG8_STAGE(PG8_SB(1, 1), cB + hstep + kstep, voffB);
        PG8_WAIT_V(6); PG8_BAR;
    } else {
        PG8_STAGE(PG8_SB(0, 0), cB, voffB); PG8_STAGE(PG8_SA(0, 0), cA, voffA); PG8_STAGE(PG8_SB(0, 1), cB + hstep, voffB); PG8_STAGE(PG8_SA(0, 1), cA + hstep, voffA);
        if (wr == 1) PG8_BAR;
        PG8_WAIT_V(4); PG8_BAR;
        PG8_STAGE(PG8_SB(1, 0), cB + kstep, voffB); PG8_STAGE(PG8_SA(1, 0), cA + kstep, voffA); PG8_STAGE(PG8_SB(1, 1), cB + hstep + kstep, voffB);
        PG8_WAIT_V(6); PG8_BAR;
    }
    for (;;) {
        const bool has_next = S.next(ui + 1, nxt);
        const char* nA = has_next ? (const char*)g.A + (size_t)nxt.pm * tstep : cA; const char* nB = has_next ? (const char*)g.Bt + (size_t)nxt.pn * tstep : cB;
        for (int t = 0; t < nt; t += 2) {
            const bool last = (t == nt - 2);
            const char* a1 = cA + (size_t)(t + 1) * kstep;
            const char* a2 = last ? nA : cA + (size_t)(t + 2) * kstep; const char* b2 = last ? nB : cB + (size_t)(t + 2) * kstep;
            const char* a3 = a2 + kstep; const char* b3 = b2 + kstep;
            if (last && has_next) S.a_ready(nxt);
            if constexpr (SP2) {
            PG8_LDB(B0, 0, 0); PG8_LDB(B1, 0, 1); PG8_SCHED; PG8_LDA(At, 0, 0); PG8_STAGE(PG8_SA(1, 1), a1 + hstep, voffA);
            PG8_WAIT_V(8); PG8_WAIT_L(0); PG8_BAR; PG8_MMA(0, 0, At, B0); PG8_MMA(0, 1, At, B1); PG8_BAR; PG8_SCHED;
            PG8_LDA(At, 0, 1); PG8_STAGE(PG8_SB(0, 0), b2, voffB); PG8_STAGE(PG8_SB(0, 1), b2 + hstep, voffB); PG8_STAGE(PG8_SA(0, 0), a2, voffA);
            PG8_WAIT_V(8); PG8_WAIT_L(0); PG8_BAR; PG8_MMA(1, 0, At, B0); PG8_MMA(1, 1, At, B1); PG8_BAR; PG8_SCHED;
            PG8_LDB(B0, 1, 0); PG8_LDB(B1, 1, 1); PG8_SCHED; PG8_LDA(At, 1, 0); PG8_STAGE(PG8_SA(0, 1), a2 + hstep, voffA);
            PG8_WAIT_V(8); PG8_WAIT_L(0); PG8_BAR; PG8_MMA(0, 0, At, B0); PG8_MMA(0, 1, At, B1); PG8_BAR; PG8_SCHED;
            PG8_LDA(At, 1, 1); PG8_STAGE(PG8_SB(1, 0), b3, voffB); PG8_STAGE(PG8_SB(1, 1), b3 + hstep, voffB); PG8_STAGE(PG8_SA(1, 0), a3, voffA);
            PG8_WAIT_V(8); PG8_WAIT_L(0); PG8_BAR; PG8_MMA(1, 0, At, B0); PG8_MMA(1, 1, At, B1); PG8_BAR; PG8_SCHED;
            } else {
            PG8_LDB(B0, 0, 0); PG8_SCHED; PG8_LDA(At, 0, 0); PG8_STAGE(PG8_SA(1, 1), a1 + hstep, voffA);
            PG8_WAIT_L(8); PG8_BAR; PG8_WAIT_L(0); PG8_MMA(0, 0, At, B0); PG8_BAR; PG8_SCHED;
            PG8_LDB(B1, 0, 1); PG8_STAGE(PG8_SB(0, 0), b2, voffB);
            PG8_BAR; PG8_WAIT_L(0); PG8_MMA(0, 1, At, B1); PG8_BAR;
            PG8_LDA(At, 0, 1); PG8_STAGE(PG8_SA(0, 0), a2, voffA);
            PG8_BAR; PG8_WAIT_L(0); PG8_MMA(1, 0, At, B0); PG8_BAR; PG8_SCHED;
            PG8_STAGE(PG8_SB(0, 1), b2 + hstep, voffB);
            PG8_WAIT_V(6); PG8_BAR; PG8_MMA(1, 1, At, B1); PG8_BAR;
            PG8_LDB(B0, 1, 0); PG8_SCHED; PG8_LDA(At, 1, 0); PG8_STAGE(PG8_SA(0, 1), a2 + hstep, voffA);
            PG8_WAIT_L(8); PG8_BAR; PG8_WAIT_L(0); PG8_MMA(0, 0, At, B0); PG8_BAR; PG8_SCHED;
            PG8_LDB(B1, 1, 1); PG8_STAGE(PG8_SB(1, 0), b3, voffB);
            PG8_BAR; PG8_WAIT_L(0); PG8_MMA(0, 1, At, B1); PG8_BAR;
            PG8_LDA(At, 1, 1); PG8_STAGE(PG8_SA(1, 0), a3, voffA);
            PG8_BAR; PG8_WAIT_L(0); PG8_MMA(1, 0, At, B0); PG8_BAR; PG8_SCHED;
            PG8_STAGE(PG8_SB(1, 1), b3 + hstep, voffB);
            PG8_WAIT_V(6); PG8_BAR; PG8_MMA(1, 1, At, B1); PG8_BAR;
            }
        }
        if constexpr (ALIGN_EPI) { if (wr == 0) PG8_BAR; }
        if constexpr (!Epi::AFTER_DRAIN) { E(acc, cur, wr, wc, fr, fq); S.done(cur); }
        if (!has_next) break;
#pragma unroll
        for (int a = 0; a < 2; ++a)
#pragma unroll
            for (int b = 0; b < 2; ++b)
#pragma unroll
                for (int m = 0; m < 4; ++m)
#pragma unroll
                    for (int n = 0; n < 2; ++n) acc[a][b][m][n] = (f32x4){0.f, 0.f, 0.f, 0.f};
        cur = nxt; cA = nA; cB = nB; ++ui;
        if constexpr (ALIGN_EPI) { if (wr == 1) PG8_BAR; }
    }
    PG8_WAIT_V(0);
    if constexpr (!ALIGN_EPI) { if (wr == 0) PG8_BAR; }
    PG8_BAR;
    if constexpr (Epi::AFTER_DRAIN) { E.fused(acc, cur, wr, wc, fr, fq, lds, wid, lane); S.done(cur); }
#undef PG8_SA
#undef PG8_SB
#undef PG8_STAGE
#undef PG8_LDA
#undef PG8_LDB
#undef PG8_MMA
#undef PG8_WAIT_V
#undef PG8_WAIT_L
#undef PG8_BAR
#undef PG8_SCHED
}
}
#define DI __device__ __forceinline__
typedef __attribute__((address_space(3))) float lds_f32_t;
typedef unsigned short bf16;
typedef float f32x4 __attribute__((ext_vector_type(4)));
typedef float f32x2 __attribute__((ext_vector_type(2)));
typedef float f32x16 __attribute__((ext_vector_type(16)));
typedef short bf16x8 __attribute__((ext_vector_type(8)));
typedef short s16x4 __attribute__((ext_vector_type(4)));
typedef unsigned u32x4 __attribute__((ext_vector_type(4)));
typedef __bf16 bf16x2_t __attribute__((ext_vector_type(2)));
#define MFMA32(a, b, c) __builtin_amdgcn_mfma_f32_32x32x16_bf16((a), (b), (c), 0, 0, 0)
#define LDS_FENCE() asm volatile("s_waitcnt lgkmcnt(0)" ::: "memory")

DI unsigned pk2(float lo, float hi) { f32x2 v = {lo, hi}; bf16x2_t b = __builtin_convertvector(v, bf16x2_t); return __builtin_bit_cast(unsigned, b); }
DI float bflo(unsigned u) { return __uint_as_float(u << 16); }
DI float bfhi(unsigned u) { return __uint_as_float(u & 0xffff0000u); }
DI float bf2f(bf16 h) { return __uint_as_float((unsigned)h << 16); }
DI float wave_sum(float v) {
#pragma unroll
    for (int o = 1; o < 64; o <<= 1) v += __shfl_xor(v, o);
    return v;
}
DI float sigmoid_(float x) { return 1.f / (1.f + __expf(-x)); }
DI float silu_(float x) { return x / (1.f + __expf(-x)); }
DI float softplus_(float x) { return x > 20.f ? x : __logf(1.0f + __expf(x)); }
DI int crow(int reg, int h) { return (reg & 3) + 8 * (reg >> 2) + 4 * h; }

constexpr int BATCH = 16, SEQ = 2048, DM = 1024, M = BATCH * SEQ, FF = 4096, N0 = 3840;
constexpr float EPS = 1e-6f, LOG2E = 1.4426950408889634f;
constexpr size_t MiB = 1u << 20;
constexpr size_t WS_W0IN = 0, WS_W0OUT = 8 * MiB, WS_W0F1 = 10 * MiB, WS_W0F2 = 18 * MiB, WS_W1IN = 26 * MiB, WS_W1OUT = 34 * MiB, WS_W1F1 = 36 * MiB, WS_W1F2 = 44 * MiB;
constexpr size_t WS_MIX = 52 * MiB, WS_ZH = 116 * MiB, WS_SS = 372 * MiB, WS_C2 = 380 * MiB, WS_XB = 384 * MiB, WS_END = 512 * MiB;
constexpr size_t WS_PAR = 381 * MiB;
constexpr int P_QN = 0, P_KN = 64, P_FB = 128, P_CONV = 256, P_ALOG = 6400, P_DTB = 6404, P_GON = 6528, P_HON = 6656, P_LB = 6784, P_END = 8832;
constexpr size_t WS_BAR = 381 * MiB + 131072;
constexpr size_t SS_STRIDE = (size_t)M * 16;
constexpr int LDS_BYTES = 147456;
#ifndef WGM_WIDE
#define WGM_WIDE 4
#endif

constexpr int RS_OFF = 131072;
template <int ACT> struct EpiAct {
    static constexpr bool PERM = true, AFTER_DRAIN = false;
    bf16* O; int ldc; const float* par; const lds_f32_t* rs; mutable int ui;
    DI void operator()(const f32x4 (&acc)[2][2][4][2], const pg8::Unit& u, int wr, int wc, int fr, int fq) const {
        const int row0 = u.pm * 256 + wr * 64 + fr, col0 = u.pn * 256 + wc * 32 + 8 * fq;
        float rsv[2][4];
#pragma unroll
        for (int ai = 0; ai < 2; ++ai)
#pragma unroll
            for (int m = 0; m < 4; ++m) rsv[ai][m] = rs[ui * 256 + ai * 128 + wr * 64 + m * 16 + fr];
        ++ui;
#pragma unroll
        for (int ai = 0; ai < 2; ++ai)
#pragma unroll
            for (int m = 0; m < 4; ++m) {
                const int row = row0 + ai * 128 + m * 16;
                const float r = rsv[ai][m];
                bf16* rowp = O + (size_t)row * ldc + col0;
                if (ACT == 2 && u.pn < 4) {
                    float ssq = 0.f;
#pragma unroll
                    for (int bj = 0; bj < 2; ++bj)
#pragma unroll
                        for (int n = 0; n < 2; ++n) { const f32x4 t = acc[ai][bj][m][n]; ssq += (t[0] * t[0] + t[1] * t[1]) + (t[2] * t[2] + t[3] * t[3]); }
                    ssq += __shfl_xor(ssq, 16); ssq += __shfl_xor(ssq, 32);
                    const float rn = r * rsqrtf(ssq * r * r * (1.0f / 64.0f) + EPS) * (u.pn < 2 ? 0.125f * LOG2E : 1.0f);
                    int fql = fq; asm volatile("" : "+v"(fql));
                    const float* gq = par + (u.pn < 2 ? P_QN : P_KN) + 8 * fql;
#pragma unroll
                    for (int bj = 0; bj < 2; ++bj) {
                        const f32x4 g0 = *(const f32x4*)(gq + bj * 32), g1 = *(const f32x4*)(gq + bj * 32 + 4);
                        const f32x4 v0 = acc[ai][bj][m][0] * rn * g0, v1 = acc[ai][bj][m][1] * rn * g1;
                        u32x4 w; w.x = pk2(v0[0], v0[1]); w.y = pk2(v0[2], v0[3]); w.z = pk2(v1[0], v1[1]); w.w = pk2(v1[2], v1[3]);
                        __builtin_nontemporal_store(w, (u32x4*)(rowp + bj * 128));
                    }
                    continue;
                }
#pragma unroll
                for (int bj = 0; bj < 2; ++bj) {
                    f32x4 v0 = acc[ai][bj][m][0] * r, v1 = acc[ai][bj][m][1] * r;
                    if (ACT == 1) {
#pragma unroll
                        for (int e = 0; e < 4; ++e) { const float x0 = fmaxf(v0[e], 0.f), x1 = fmaxf(v1[e], 0.f); v0[e] = x0 * x0; v1[e] = x1 * x1; }
                    }
                    u32x4 w; w.x = pk2(v0[0], v0[1]); w.y = pk2(v0[2], v0[3]); w.z = pk2(v1[0], v1[1]); w.w = pk2(v1[2], v1[3]);
                    __builtin_nontemporal_store(w, (u32x4*)(rowp + bj * 128));
                }
            }
    }
};
template <bool FINISHED, class Sched> DI void rs_table_build(unsigned char* lds, const float* ss, const Sched& S, const int wv_) {
    int tid = TIDX(wv_); asm volatile("" : "+v"(tid));
    float* rs = (float*)(lds + RS_OFF);
    const int r = tid & 255, par = tid >> 8;
    pg8::Unit u;
#pragma unroll
    for (int k = 0; k < 4; ++k) {
        const int i = 2 * k + par;
        if (S.next(i, u)) {
            const int row = u.pm * 256 + r;
            if (FINISHED) rs[i * 256 + r] = ss[row];
            else {
                const f32x4* p = (const f32x4*)(ss + (size_t)row * 16);
                const f32x4 a = p[0], b = p[1], c = p[2], d = p[3];
                const float sm = ((a.x + a.y) + (a.z + a.w)) + ((b.x + b.y) + (b.z + b.w)) + ((c.x + c.y) + (c.z + c.w)) + ((d.x + d.y) + (d.z + d.w));
                rs[i * 256 + r] = rsqrtf(sm * (1.0f / 1024.0f) + EPS);
            }
        }
    }
    __syncthreads();
}
template <bool BASE_BF16, bool OUT_F32> struct EpiRes {
    static constexpr bool PERM = true, AFTER_DRAIN = false;
    const void* base; float* out; bf16* xb; float* ss_out;
    DI void operator()(const f32x4 (&acc)[2][2][4][2], const pg8::Unit& u, int wr, int wc, int fr, int fq) const {
        const int row0 = u.pm * 256 + wr * 64 + fr, col0 = u.pn * 256 + wc * 32 + 8 * fq;
#pragma unroll
        for (int ai = 0; ai < 2; ++ai) {
            f32x4 bb[4][2][2];
#pragma unroll
            for (int m = 0; m < 4; ++m)
#pragma unroll
                for (int bj = 0; bj < 2; ++bj) {
                    const size_t off = (size_t)(row0 + ai * 128 + m * 16) * 1024 + col0 + bj * 128;
                    if (BASE_BF16) {
                        const u32x4 w = *(const u32x4*)((const bf16*)base + off);
                        bb[m][bj][0] = (f32x4){bflo(w[0]), bfhi(w[0]), bflo(w[1]), bfhi(w[1])}; bb[m][bj][1] = (f32x4){bflo(w[2]), bfhi(w[2]), bflo(w[3]), bfhi(w[3])};
                    } else {
                        bb[m][bj][0] = __builtin_nontemporal_load((const f32x4*)((const float*)base + off)); bb[m][bj][1] = __builtin_nontemporal_load((const f32x4*)((const float*)base + off + 4));
                    }
                }
            __builtin_amdgcn_sched_barrier(0);
#pragma unroll
            for (int m = 0; m < 4; ++m) {
                const int row = row0 + ai * 128 + m * 16;
                float s = 0.f;
#pragma unroll
                for (int bj = 0; bj < 2; ++bj) {
                    const size_t off = (size_t)row * 1024 + col0 + bj * 128;
                    const f32x4 v0 = acc[ai][bj][m][0] + bb[m][bj][0], v1 = acc[ai][bj][m][1] + bb[m][bj][1];
                    if (OUT_F32) { *(f32x4*)(out + off) = v0; *(f32x4*)(out + off + 4) = v1; }
                    else {
                        s += ((v0[0] * v0[0] + v0[1] * v0[1]) + (v0[2] * v0[2] + v0[3] * v0[3])) + ((v1[0] * v1[0] + v1[1] * v1[1]) + (v1[2] * v1[2] + v1[3] * v1[3]));
                        u32x4 w; w.x = pk2(v0[0], v0[1]); w.y = pk2(v0[2], v0[3]); w.z = pk2(v1[0], v1[1]); w.w = pk2(v1[2], v1[3]); *(u32x4*)(xb + off) = w;
                    }
                }
                if (!OUT_F32) { s += __shfl_xor(s, 16); s += __shfl_xor(s, 32); if (fq == 0) ss_out[(size_t)row * 16 + u.pn * 4 + wc] = s; }
            }
            __builtin_amdgcn_sched_barrier(0);
        }
    }
};

DI int src_col0(int n) {
    if (n < 1024) { const int tile = n >> 8, c = n & 255, half = c >> 7, wc = (c >> 5) & 3, dl = c & 31; return (tile >> 1) * 512 + ((tile & 1) * 4 + wc) * 64 + half * 32 + dl; }
    return n < 1536 ? n : n < 3072 ? n + 8 : n < 3584 ? n + 16 : n < 3592 ? n - 3584 + 1536 : n < 3600 ? n - 3592 + 3080 : -1;
}
DI int fox_col(int which, int h, int d) { return which * 512 + 256 * (h >> 2) + (d >> 5) * 128 + 32 * (h & 3) + (d & 31); }
template <bool MAP> DI void transpose_item(const float* __restrict__ W, int K, int Nsrc, int Ndst, const float* __restrict__ gain, bf16* __restrict__ WT, float* scr, int item, int lane) {
    const int nblk = Ndst / 32, kb = item / nblk, nb = item % nblk, k0 = 64 * kb, n0 = 32 * nb;
    const int n = n0 + (lane & 31), sc = MAP ? src_col0(n) : n;
    float vals[32];
#pragma unroll
    for (int i = 0; i < 32; ++i) {
        const int kk = 2 * i + (lane >> 5); float v = 0.f;
        if (sc >= 0) v = __builtin_nontemporal_load(W + (size_t)(k0 + kk) * Nsrc + sc);
        vals[i] = v;
    }
#pragma unroll
    for (int i = 0; i < 32; ++i) {
        const int kk = 2 * i + (lane >> 5); float v = vals[i];
        if (gain) v *= gain[k0 + kk];
        scr[kk * 33 + (lane & 31)] = v;
    }
    LDS_FENCE();
    const int c = lane & 7;
#pragma unroll
    for (int j = 0; j < 4; ++j) {
        const int nn = (lane >> 3) + 8 * j; const float* s = scr + (8 * c) * 33 + nn;
        u32x4 o; o.x = pk2(s[0 * 33], s[1 * 33]); o.y = pk2(s[2 * 33], s[3 * 33]); o.z = pk2(s[4 * 33], s[5 * 33]); o.w = pk2(s[6 * 33], s[7 * 33]);
        *(u32x4*)(WT + (size_t)(n0 + nn) * K + k0 + 8 * c) = o;
    }
    LDS_FENCE();
}

struct Args { const float* in[22]; float* out; unsigned char* ws; };

DI void p0_prologue(const Args& a, unsigned char* lds, const int wv_) {
    int tid = TIDX(wv_); asm volatile("" : "+v"(tid)); const int lane = tid & 63, wave = __builtin_amdgcn_readfirstlane(tid >> 6), gw = blockIdx.x * 8 + wave, NGW = gridDim.x * 8;
    float* scr = (float*)(lds + wave * 16384);
    unsigned char* ws = a.ws;
    constexpr int I0 = 16 * (N0 / 32), I_O = 16 * 32, I_1 = 16 * 128, I_2 = 64 * 32;
    constexpr int NITEMS = I0 + I_O + I_1 + I_2 + I_1 + I_O + I_1 + I_2;
    for (int it = gw; it < NITEMS; it += NGW) {
        int r = it;
        if (r < I0) { transpose_item<true>(a.in[2], 1024, 3600, N0, a.in[1], (bf16*)(ws + WS_W0IN), scr, r, lane); continue; } r -= I0;
        if (r < I_O) { transpose_item<false>(a.in[10], 1024, 1024, 1024, nullptr, (bf16*)(ws + WS_W0OUT), scr, r, lane); continue; } r -= I_O;
        if (r < I_1) { transpose_item<false>(a.in[12], 1024, 4096, 4096, a.in[11], (bf16*)(ws + WS_W0F1), scr, r, lane); continue; } r -= I_1;
        if (r < I_2) { transpose_item<false>(a.in[13], 4096, 1024, 1024, nullptr, (bf16*)(ws + WS_W0F2), scr, r, lane); continue; } r -= I_2;
        if (r < I_1) { transpose_item<false>(a.in[15], 1024, 4096, 4096, a.in[14], (bf16*)(ws + WS_W1IN), scr, r, lane); continue; } r -= I_1;
        if (r < I_O) { transpose_item<false>(a.in[17], 1024, 1024, 1024, nullptr, (bf16*)(ws + WS_W1OUT), scr, r, lane); continue; } r -= I_O;
        if (r < I_1) { transpose_item<false>(a.in[19], 1024, 4096, 4096, a.in[18], (bf16*)(ws + WS_W1F1), scr, r, lane); continue; } r -= I_1;
        transpose_item<false>(a.in[20], 4096, 1024, 1024, nullptr, (bf16*)(ws + WS_W1F2), scr, r, lane);
    }
    if (blockIdx.x == 0) {
        float* P = (float*)(ws + WS_PAR);
        for (int i = tid; i < P_END; i += 512) {
            float v = 0.f;
            if (i < 64) v = a.in[3][i]; else if (i < 128) v = a.in[4][i - 64]; else if (i < 136) v = a.in[5][i - 128];
            else if (i >= P_CONV && i < P_CONV + 6144) v = a.in[6][i - P_CONV];
            else if (i >= P_ALOG && i < P_ALOG + 4) v = a.in[7][i - P_ALOG]; else if (i >= P_DTB && i < P_DTB + 4) v = a.in[8][i - P_DTB];
            else if (i >= P_GON && i < P_GON + 128) v = a.in[9][i - P_GON]; else if (i >= P_HON && i < P_HON + 128) v = a.in[16][i - P_HON];
            else if (i >= P_LB) v = a.in[21][i - P_LB];
            P[i] = v;
        }
    }
    const float* x = a.in[0]; bf16* XB = (bf16*)(ws + WS_XB); float* SS = (float*)(ws + WS_SS);
    for (int m0 = gw; m0 < M; m0 += 2 * NGW) {
        const int m1 = m0 + NGW; const bool has1 = m1 < M;
        const f32x4* xr0 = (const f32x4*)(x + (size_t)m0 * DM) + lane; const f32x4* xr1 = (const f32x4*)(x + (size_t)(has1 ? m1 : m0) * DM) + lane;
        f32x4 v0[4], v1[4]; float s0 = 0.f, s1 = 0.f;
#pragma unroll
        for (int j = 0; j < 4; ++j) { v0[j] = __builtin_nontemporal_load(xr0 + 64 * j); v1[j] = __builtin_nontemporal_load(xr1 + 64 * j); }
#pragma unroll
        for (int j = 0; j < 4; ++j) {
            s0 += (v0[j].x * v0[j].x + v0[j].y * v0[j].y) + (v0[j].z * v0[j].z + v0[j].w * v0[j].w);
            s1 += (v1[j].x * v1[j].x + v1[j].y * v1[j].y) + (v1[j].z * v1[j].z + v1[j].w * v1[j].w);
        }
#pragma unroll
        for (int o = 1; o < 64; o <<= 1) { s0 += __shfl_xor(s0, o); s1 += __shfl_xor(s1, o); }
        unsigned long long* o80 = (unsigned long long*)(XB + (size_t)m0 * DM) + lane;
#pragma unroll
        for (int j = 0; j < 4; ++j) o80[64 * j] = (unsigned long long)pk2(v0[j].x, v0[j].y) | ((unsigned long long)pk2(v0[j].z, v0[j].w) << 32);
        if (lane == 0) SS[m0] = rsqrtf(s0 * (1.0f / 1024.0f) + EPS);
        if (has1) {
            unsigned long long* o81 = (unsigned long long*)(XB + (size_t)m1 * DM) + lane;
#pragma unroll
            for (int j = 0; j < 4; ++j) o81[64 * j] = (unsigned long long)pk2(v1[j].x, v1[j].y) | ((unsigned long long)pk2(v1[j].z, v1[j].w) << 32);
            if (lane == 0) SS[m1] = rsqrtf(s1 * (1.0f / 1024.0f) + EPS);
        }
    }
}

DI void fox_prep(const Args& a, const int wv_) {
    int tid = TIDX(wv_); asm volatile("" : "+v"(tid)); const int lane = tid & 63, wave = __builtin_amdgcn_readfirstlane(tid >> 6), gw = blockIdx.x * 8 + wave, NGW = gridDim.x * 8;
    bf16* Z = (bf16*)(a.ws + WS_ZH); float* C2 = (float*)(a.ws + WS_C2);
    for (int it = gw; it < 128; it += NGW) {
        const int b = it >> 3, h = it & 7; const float bias = ((const float*)(a.ws + WS_PAR))[P_FB + h];
        float loc[32]; float run = 0.f;
#pragma unroll
        for (int i = 0; i < 32; ++i) {
            const int t = 32 * lane + i; const float x = bf2f(Z[((size_t)b * SEQ + t) * N0 + 3584 + h]) + bias;
            const float ls = fminf(x, 0.f) - __logf(1.0f + __expf(-fabsf(x))); run += ls; loc[i] = run;
        }
        float incl = run;
#pragma unroll
        for (int o = 1; o < 64; o <<= 1) { const float y = __shfl_up(incl, o); if (lane >= o) incl += y; }
        const float excl = incl - run;
#pragma unroll
        for (int i = 0; i < 32; ++i) C2[(size_t)it * SEQ + 32 * lane + i] = (loc[i] + excl) * LOG2E;
    }
}

constexpr int LDK = 72;
DI void fox_unit(const bf16* __restrict__ Z, const float* __restrict__ C2, bf16* __restrict__ MIX, int b, int h, int qb, unsigned char* lds, const int wv_) {
    int tid = TIDX(wv_); asm volatile("" : "+v"(tid)); const int lane = tid & 63, r = lane & 31, hh = lane >> 5, w = tid >> 6;
    bf16* Ks0 = (bf16*)lds; bf16* Vt0 = (bf16*)(lds + 18432); float* C2s = (float*)(lds + 36864); float* AS = (float*)(lds + 45056) + w * 32;
    const int q0 = qb * 256, nT = (q0 + 256) / 64;
    const size_t rowbase = (size_t)b * SEQ;
    const float* c2g = C2 + (size_t)(b * 8 + h) * SEQ;
    {
        float cv[4];
#pragma unroll
        for (int k = 0; k < 4; ++k) { const int i = tid + 512 * k; cv[k] = i < q0 + 256 ? c2g[i] : 0.f; }
#pragma unroll
        for (int k = 0; k < 4; ++k) { const int i = tid + 512 * k; if (i < q0 + 256) C2s[i] = -cv[k]; }
    }
    const int qrow = q0 + 32 * w + r;
    bf16x8 qr[4];
#pragma unroll
    for (int ks = 0; ks < 4; ++ks) qr[ks] = *(const bf16x8*)(Z + (rowbase + qrow) * N0 + fox_col(0, h, ks * 16 + hh * 8));
    float m_run = -INFINITY, l_run = 0.f;
    f32x16 o0, o1;
#pragma unroll
    for (int i = 0; i < 16; ++i) { o0[i] = 0.f; o1[i] = 0.f; }
    const int kr = tid >> 3, ch = tid & 7;
    const bf16* kvp = Z + (rowbase + kr) * N0 + fox_col(1, h, ch * 8);
    const int voff = 1024 + h * 64 + ch * 8 - fox_col(1, h, ch * 8);
    u32x4 kv = *(const u32x4*)kvp, vv = *(const u32x4*)(kvp + voff);
    {
        *(u32x4*)(Ks0 + kr * LDK + ch * 8) = kv;
#pragma unroll
        for (int e = 0; e < 8; ++e) Vt0[(ch * 8 + e) * LDK + kr] = (bf16)(vv[e >> 1] >> (16 * (e & 1)));
        if (1 < nT) { const bf16* np = kvp + (size_t)64 * N0; kv = *(const u32x4*)np; vv = *(const u32x4*)(np + voff); }
    }
    __syncthreads();
    for (int jt = 0; jt < nT; ++jt) {
        const bf16* Ks = Ks0 + (jt & 1) * 4608; const bf16* Vt = Vt0 + (jt & 1) * 4608;
        if (jt + 1 < nT) {
            bf16* Kn = Ks0 + ((jt + 1) & 1) * 4608; bf16* Vn = Vt0 + ((jt + 1) & 1) * 4608;
            *(u32x4*)(Kn + kr * LDK + ch * 8) = kv;
#pragma unroll
            for (int e = 0; e < 8; ++e) Vn[(ch * 8 + e) * LDK + kr] = (bf16)(vv[e >> 1] >> (16 * (e & 1)));
            if (jt + 2 < nT) { const bf16* np = kvp + (size_t)(jt + 2) * 64 * N0; kv = *(const u32x4*)np; vv = *(const u32x4*)(np + voff); }
        }
        const int kv0 = jt * 64;
        if (kv0 <= q0 + 32 * w + 31) {
            f32x16 p0, p1;
#pragma unroll
            for (int g = 0; g < 4; ++g) {
                const f32x4 c0v = *(const f32x4*)(C2s + kv0 + 8 * g + 4 * hh), c1v = *(const f32x4*)(C2s + kv0 + 32 + 8 * g + 4 * hh);
#pragma unroll
                for (int e = 0; e < 4; ++e) { p0[4 * g + e] = c0v[e]; p1[4 * g + e] = c1v[e]; }
            }
#pragma unroll
            for (int ks = 0; ks < 4; ++ks) {
                const bf16x8 a0 = *(const bf16x8*)(Ks + r * LDK + ks * 16 + hh * 8);
                const bf16x8 a1 = *(const bf16x8*)(Ks + (32 + r) * LDK + ks * 16 + hh * 8);
                p0 = MFMA32(a0, qr[ks], p0); p1 = MFMA32(a1, qr[ks], p1);
            }
            float mt = -INFINITY;
            const bool need_mask = kv0 + 63 > q0 + 32 * w;
#pragma unroll
            for (int g = 0; g < 4; ++g) {
#pragma unroll
                for (int e = 0; e < 4; ++e) {
                    const int i = 4 * g + e, kvi = kv0 + 8 * g + 4 * hh + e;
                    float s0 = p0[i], s1 = p1[i];
                    if (need_mask) { if (kvi > qrow) s0 = -INFINITY; if (kvi + 32 > qrow) s1 = -INFINITY; }
                    p0[i] = s0; p1[i] = s1; mt = fmaxf(mt, fmaxf(s0, s1));
                }
            }
            mt = fmaxf(mt, __shfl_xor(mt, 32));
            const float m_new = fmaxf(m_run, mt);
            const float alpha = __builtin_amdgcn_exp2f(m_run - m_new);
            m_run = m_new;
            float ps = 0.f;
#pragma unroll
            for (int i = 0; i < 16; ++i) { p0[i] = __builtin_amdgcn_exp2f(p0[i] - m_new); p1[i] = __builtin_amdgcn_exp2f(p1[i] - m_new); ps += p0[i] + p1[i]; }
            l_run = l_run * alpha + ps;
            if (hh == 0) AS[r] = alpha;
            LDS_FENCE();
#pragma unroll
            for (int i = 0; i < 16; ++i) { const float al = AS[crow(i, hh)]; o0[i] *= al; o1[i] *= al; }
            bf16x8 pa[4];
#pragma unroll
            for (int s = 0; s < 2; ++s) {
                u32x4 t0, t1;
#pragma unroll
                for (int e = 0; e < 4; ++e) { t0[e] = pk2(p0[8 * s + 2 * e], p0[8 * s + 2 * e + 1]); t1[e] = pk2(p1[8 * s + 2 * e], p1[8 * s + 2 * e + 1]); }
                pa[s] = __builtin_bit_cast(bf16x8, t0); pa[2 + s] = __builtin_bit_cast(bf16x8, t1);
            }
#pragma unroll
            for (int k4 = 0; k4 < 4; ++k4) {
                const int half = k4 >> 1, s = k4 & 1;
                const bf16* vb0 = Vt + r * LDK + 32 * half + 16 * s + 4 * hh;
                const bf16* vb1 = Vt + (32 + r) * LDK + 32 * half + 16 * s + 4 * hh;
                const s16x4 lo0 = *(const s16x4*)vb0, hi0 = *(const s16x4*)(vb0 + 8);
                const s16x4 lo1 = *(const s16x4*)vb1, hi1 = *(const s16x4*)(vb1 + 8);
                const bf16x8 vf0 = __builtin_shufflevector(lo0, hi0, 0, 1, 2, 3, 4, 5, 6, 7);
                const bf16x8 vf1 = __builtin_shufflevector(lo1, hi1, 0, 1, 2, 3, 4, 5, 6, 7);
                o0 = MFMA32(pa[k4], vf0, o0); o1 = MFMA32(pa[k4], vf1, o1);
            }
            LDS_FENCE();
        }
        __syncthreads();
    }
    const float l_tot = l_run + __shfl_xor(l_run, 32);
    if (hh == 0) AS[r] = 1.0f / l_tot;
    LDS_FENCE();
#pragma unroll
    for (int i = 0; i < 16; ++i) {
        const float inv = AS[crow(i, hh)]; const size_t row = rowbase + q0 + 32 * w + crow(i, hh);
        bf16* op = MIX + row * 1024 + h * 64 + r;
        op[0] = (bf16)(pk2(o0[i] * inv, 0.f) & 0xffffu); op[32] = (bf16)(pk2(o1[i] * inv, 0.f) & 0xffffu);
    }
    __syncthreads();
}


typedef __attribute__((address_space(3))) unsigned char lds_u8;
typedef __attribute__((address_space(3))) float lds_f32;
DI void norm_gate_store(const float* Of, const float* gain, const bf16* gate_row0, size_t gate_pitch, bf16* out_row0, int tid) {
    const int t = tid >> 3, seg = tid & 7;
    const f32x4* op = (const f32x4*)(Of + t * 128 + seg * 16);
    f32x4 o[4]; float ss = 0.f;
#pragma unroll
    for (int q = 0; q < 4; ++q) { o[q] = op[q]; ss += (o[q][0] * o[q][0] + o[q][1] * o[q][1]) + (o[q][2] * o[q][2] + o[q][3] * o[q][3]); }
    ss += __shfl_xor(ss, 1); ss += __shfl_xor(ss, 2); ss += __shfl_xor(ss, 4);
    const float rn = rsqrtf(ss * (1.0f / 128.0f) + EPS);
    const u32x4* gp = (const u32x4*)(gate_row0 + (size_t)t * gate_pitch + seg * 16);
    const u32x4 ga = gp[0], gb = gp[1];
    const f32x4* gn = (const f32x4*)(gain + seg * 16);
    u32x4 w0, w1;
#pragma unroll
    for (int q = 0; q < 4; ++q) {
        const f32x4 g4 = gn[q];
        const unsigned gw0 = q < 2 ? ga[2 * q] : gb[2 * q - 4], gw1 = q < 2 ? ga[2 * q + 1] : gb[2 * q - 3];
        const float y0 = o[q][0] * rn * g4[0] * silu_(bflo(gw0)), y1 = o[q][1] * rn * g4[1] * silu_(bfhi(gw0));
        const float y2 = o[q][2] * rn * g4[2] * silu_(bflo(gw1)), y3 = o[q][3] * rn * g4[3] * silu_(bfhi(gw1));
        if (q < 2) { w0[2 * q] = pk2(y0, y1); w0[2 * q + 1] = pk2(y2, y3); } else { w1[2 * q - 4] = pk2(y0, y1); w1[2 * q - 3] = pk2(y2, y3); }
    }
    u32x4* dst = (u32x4*)(out_row0 + (size_t)t * 1024 + seg * 16);
    dst[0] = w0; dst[1] = w1;
}

#define MFMA16(a, b, c) __builtin_amdgcn_mfma_f32_16x16x32_bf16((a), (b), (c), 0, 0, 0)
constexpr int LDH = 136, LDW = 68;
constexpr int G_QH = 0, G_KH = 17408, G_U = 0, G_VH = 34816, G_WT = 34816, G_A = 52224, G_NW = 68608, G_QD = 84992, G_KD = 101376, G_AI = 117760, G_SM = 125952;
DI bf16 f2bf(float x) { return (bf16)(pk2(x, 0.f) & 0xffffu); }
DI float dpp_xor1(float v) { return __int_as_float(__builtin_amdgcn_update_dpp(0, __float_as_int(v), 0xB1, 0xF, 0xF, true)); }
DI void norm_gate_store_pre(const float* Of, const f32x4 (&gn)[4], u32x4 ga, u32x4 gb, bf16* out_row0, int tid) {
    const int t = tid >> 3, seg = tid & 7;
    const f32x4* op = (const f32x4*)(Of + t * 128 + seg * 16);
    f32x4 o[4]; float ss = 0.f;
#pragma unroll
    for (int q = 0; q < 4; ++q) { o[q] = op[q]; ss += (o[q][0] * o[q][0] + o[q][1] * o[q][1]) + (o[q][2] * o[q][2] + o[q][3] * o[q][3]); }
    ss += __shfl_xor(ss, 1); ss += __shfl_xor(ss, 2); ss += __shfl_xor(ss, 4);
    const float rn = rsqrtf(ss * (1.0f / 128.0f) + EPS);
    u32x4 w0, w1;
#pragma unroll
    for (int q = 0; q < 4; ++q) {
        const f32x4 g4 = gn[q];
        const unsigned gw0 = q < 2 ? ga[2 * q] : gb[2 * q - 4], gw1 = q < 2 ? ga[2 * q + 1] : gb[2 * q - 3];
        const float y0 = o[q][0] * rn * g4[0] * silu_(bflo(gw0)), y1 = o[q][1] * rn * g4[1] * silu_(bfhi(gw0));
        const float y2 = o[q][2] * rn * g4[2] * silu_(bflo(gw1)), y3 = o[q][3] * rn * g4[3] * silu_(bfhi(gw1));
        if (q < 2) { w0[2 * q] = pk2(y0, y1); w0[2 * q + 1] = pk2(y2, y3); } else { w1[2 * q - 4] = pk2(y0, y1); w1[2 * q - 3] = pk2(y2, y3); }
    }
    u32x4* dst = (u32x4*)(out_row0 + (size_t)t * 1024 + seg * 16);
    dst[0] = w0; dst[1] = w1;
}
constexpr int SL_NW = 0, SL_QD = 16384, SL_KD = 32768, SL_AI = 49152, SL_UB = 55296, SL_BYTES = 71680, SL_FIRST = 1872;
DI unsigned char* gdn_slot(unsigned char* ws, int idx) { return idx < SL_FIRST ? ws + WS_XB + (size_t)idx * SL_BYTES : ws + WS_ZH + 240 * MiB + (size_t)(idx - SL_FIRST) * SL_BYTES; }
constexpr size_t WS_EGL = 381 * MiB + 262144;

DI void gdn_prep_unit(const Args& a, int idx, unsigned char* lds, const int wv_) {
    const int ch = idx & 31, h = (idx >> 5) & 3, b = idx >> 7, t0 = ch * 64;
    const bf16* Z = (const bf16*)(a.ws + WS_ZH);
    bf16* QH = (bf16*)(lds + G_QH); bf16* KH = (bf16*)(lds + G_KH); bf16* VH = (bf16*)(lds + G_VH); bf16* WT = (bf16*)(lds + G_WT); float* U = (float*)(lds + G_U); float* Am = (float*)(lds + G_A);
    unsigned char* NW = lds + G_NW; unsigned char* QD = lds + G_QD; unsigned char* KD = lds + G_KD; unsigned char* AI = lds + G_AI;
    float* Gs = (float*)(lds + G_SM); float* BETA = Gs + 64; float* EG = Gs + 128; float* BE = Gs + 192;
    int tl = TIDX(wv_); asm volatile("" : "+v"(tl));
    const int lane = tl & 63, w = tl >> 6, c0 = 2 * lane;
    const float* PAR = (const float*)(a.ws + WS_PAR); const float* convw = PAR + P_CONV;
    const float negA = -__expf(PAR[P_ALOG + h]), dtb = PAR[P_DTB + h];
    float qn[8][2], kn[8][2];
    float cwa[3][4][2];
#pragma unroll
    for (int ten = 0; ten < 3; ++ten)
#pragma unroll
        for (int jj = 0; jj < 4; ++jj) { cwa[ten][jj][0] = convw[jj * 1536 + ten * 512 + h * 128 + c0]; cwa[ten][jj][1] = convw[jj * 1536 + ten * 512 + h * 128 + c0 + 1]; }
#pragma unroll
    for (int ten = 0; ten < 3; ++ten) {
        float cw[4][2];
#pragma unroll
        for (int jj = 0; jj < 4; ++jj) { cw[jj][0] = cwa[ten][jj][0]; cw[jj][1] = cwa[ten][jj][1]; }
        unsigned pre[11];
#pragma unroll
        for (int rr = 0; rr < 11; ++rr) {
            const int t = t0 + 8 * w - 3 + rr; const int tc = t < 0 ? 0 : t;
            const unsigned u = __builtin_nontemporal_load((const unsigned*)(Z + ((size_t)b * SEQ + tc) * N0 + 1536 + ten * 512 + h * 128 + c0));
            pre[rr] = t < 0 ? 0u : u;
        }
#pragma unroll
        for (int rr = 0; rr < 8; ++rr) {
            float y0 = 0.f, y1 = 0.f;
#pragma unroll
            for (int jj = 0; jj < 4; ++jj) { y0 += cw[jj][0] * bflo(pre[rr + jj]); y1 += cw[jj][1] * bfhi(pre[rr + jj]); }
            y0 = silu_(y0); y1 = silu_(y1);
            const int t = 8 * w + rr;
            if (ten < 2) {
                const float ss = wave_sum(y0 * y0 + y1 * y1); float sc = rsqrtf(ss + EPS);
                if (ten == 0) sc *= 0.08838834764831845f;
                y0 *= sc; y1 *= sc;
                if (ten == 0) { qn[rr][0] = y0; qn[rr][1] = y1; *(unsigned*)(QH + t * LDH + c0) = pk2(y0, y1); }
                else { kn[rr][0] = y0; kn[rr][1] = y1; *(unsigned*)(KH + t * LDH + c0) = pk2(y0, y1); }
            } else {
                *(unsigned*)(VH + t * LDH + c0) = pk2(y0, y1);
            }
        }
    }
    if (w == 0) {
        const size_t m = (size_t)b * SEQ + t0 + lane;
        const float gb = bf2f(Z[m * N0 + 3592 + h]), ga = bf2f(Z[m * N0 + 3596 + h]);
        float la = negA * softplus_(ga + dtb);
#pragma unroll
        for (int o = 1; o < 64; o <<= 1) { const float y = __shfl_up(la, o); if (lane >= o) la += y; }
        const float be = sigmoid_(gb), eg = __expf(la);
        Gs[lane] = la; BETA[lane] = be; EG[lane] = eg; BE[lane] = be * eg;
        if (lane == 63) ((float*)(a.ws + WS_EGL))[idx] = eg;
    }
    __syncthreads();
    {
        const int fr = lane & 15, fq = lane >> 4, tb = w >> 1;
#pragma unroll
        for (int si = 0; si < 2; ++si) {
            const int sb = 2 * (w & 1) + si; f32x4 akk = {0.f, 0.f, 0.f, 0.f}, aqk = {0.f, 0.f, 0.f, 0.f};
#pragma unroll
            for (int kk = 0; kk < 4; ++kk) {
                const bf16x8 kt = *(const bf16x8*)(KH + (16 * tb + fr) * LDH + kk * 32 + fq * 8);
                const bf16x8 qt = *(const bf16x8*)(QH + (16 * tb + fr) * LDH + kk * 32 + fq * 8);
                const bf16x8 ks_ = *(const bf16x8*)(KH + (16 * sb + fr) * LDH + kk * 32 + fq * 8);
                akk = MFMA16(kt, ks_, akk); aqk = MFMA16(qt, ks_, aqk);
            }
#pragma unroll
            for (int jj = 0; jj < 4; ++jj) {
                const int t = 16 * tb + 4 * fq + jj, s2 = 16 * sb + fr;
                const float dec = __expf(fminf(Gs[t] - Gs[s2], 0.f));
                Am[(s2 & 1) * 2048 + t * 32 + (s2 >> 1)] = s2 < t ? BETA[t] * akk[jj] * dec : 0.f;
                const float qkv = s2 <= t ? aqk[jj] * dec : 0.f;
                const int x = s2 & 15, hp = (x >> 2) & 1, j = ((x >> 3) << 2) | (x & 3);
                const int off = ((((t >> 5) * 4 + (s2 >> 4)) * 64) + hp * 32 + (t & 31)) * 16 + j * 2;
                *(bf16*)(AI + off) = f2bf(qkv);
            }
        }
        const float gl = Gs[63];
#pragma unroll
        for (int rr = 0; rr < 8; ++rr) {
            const int t = 8 * w + rr; const float eg = EG[t], ekd = __expf(gl - Gs[t]);
            {
                const int ks = c0 >> 4, x = c0 & 15, hp = (x >> 2) & 1, j = ((x >> 3) << 2) | (x & 3);
                const int off = ((((t >> 5) * 8 + ks) * 64) + hp * 32 + (t & 31)) * 16 + j * 2;
                *(unsigned*)(QD + off) = pk2(qn[rr][0] * eg, qn[rr][1] * eg);
            }
#pragma unroll
            for (int e = 0; e < 2; ++e) {
                const int dk = c0 + e, x = t & 15, hp = (x >> 2) & 1, j = ((x >> 3) << 2) | (x & 3);
                const int off = ((((dk >> 5) * 4 + (t >> 4)) * 64) + hp * 32 + (dk & 31)) * 16 + j * 2;
                *(bf16*)(KD + off) = f2bf(kn[rr][e] * ekd);
            }
        }
    }
    __syncthreads();
    unsigned char* slot = gdn_slot(a.ws, idx);
    {
#pragma unroll
        for (int k2 = 0; k2 < 2; ++k2) {
            const int q = tl + 512 * k2;
            __builtin_nontemporal_store(*(const u32x4*)(QD + q * 16), (u32x4*)(slot + SL_QD + q * 16));
            __builtin_nontemporal_store(*(const u32x4*)(KD + q * 16), (u32x4*)(slot + SL_KD + q * 16));
        }
        if (tl < 384) { const int src_off = tl < 128 ? tl * 16 : 4096 + (tl - 128) * 16; __builtin_nontemporal_store(*(const u32x4*)(AI + src_off), (u32x4*)(slot + SL_AI + tl * 16)); }
    }
    {
        const int c = tl >> 1, p = tl & 1;
        const float* Ap = Am + p * 2048;
        const float* scl = c < 128 ? BETA : BE;
        const bf16* src = c < 128 ? VH + c : KH + (c - 128);
        float xm[32];
#pragma unroll
        for (int i = 0; i < 32; ++i) xm[i] = 0.f;
        f32x4 ab[2][8]; float rh[2];
        rh[0] = scl[0] * bf2f(src[0]);
#pragma unroll
        for (int t = 0; t < 64; ++t) {
            if (t + 1 < 64) {
#pragma unroll
                for (int i4 = 0; i4 < (((t + 2) / 2) + 3) / 4; ++i4) ab[(t + 1) & 1][i4] = *(const f32x4*)(Ap + (t + 1) * 32 + 4 * i4);
                rh[(t + 1) & 1] = scl[t + 1] * bf2f(src[(t + 1) * LDH]);
            }
            __builtin_amdgcn_sched_barrier(0);
            float acc0 = 0.f, acc1 = 0.f;
#pragma unroll
            for (int i4 = 0; i4 < (((t + 1) / 2) + 3) / 4; ++i4) {
                const f32x4 a4 = ab[t & 1][i4];
                acc0 += a4[0] * xm[4 * i4];
                if (2 * (4 * i4 + 1) < t) acc1 += a4[1] * xm[4 * i4 + 1];
                if (2 * (4 * i4 + 2) < t) acc0 += a4[2] * xm[4 * i4 + 2];
                if (2 * (4 * i4 + 3) < t) acc1 += a4[3] * xm[4 * i4 + 3];
            }
            const float part = acc0 + acc1;
            const float xt = rh[t & 1] - (part + dpp_xor1(part));
            xm[t >> 1] = (p == (t & 1)) ? xt : xm[t >> 1];
            __builtin_amdgcn_sched_barrier(0);
        }
        __syncthreads();
        if (c < 128) {
#pragma unroll
            for (int i = 0; i < 32; ++i) U[(2 * i + p) * 128 + c] = xm[i];
        } else {
            const int dk = c - 128;
#pragma unroll
            for (int i = 0; i < 32; ++i) {
                const float other = dpp_xor1(xm[i]);
                const float lo = p ? other : xm[i], hi = p ? xm[i] : other;
                if ((i & 1) == 0) { if (p == 0) *(unsigned*)(WT + dk * LDW + 2 * i) = pk2(-lo, -hi); }
                else { if (p == 1) *(unsigned*)(WT + dk * LDW + 2 * i) = pk2(-lo, -hi); }
            }
        }
    }
    __syncthreads();
#pragma unroll
    for (int k2 = 0; k2 < 2; ++k2) {
        const int q = tl + 512 * k2, f = q >> 6, lp = q & 63, hp = lp >> 5, rp = lp & 31;
        const int t = 32 * (f >> 3) + rp, dkb = 16 * (f & 7) + 4 * hp;
        u32x4 o;
        o[0] = (unsigned)WT[(dkb + 0) * LDW + t] | ((unsigned)WT[(dkb + 1) * LDW + t] << 16);
        o[1] = (unsigned)WT[(dkb + 2) * LDW + t] | ((unsigned)WT[(dkb + 3) * LDW + t] << 16);
        o[2] = (unsigned)WT[(dkb + 8) * LDW + t] | ((unsigned)WT[(dkb + 9) * LDW + t] << 16);
        o[3] = (unsigned)WT[(dkb + 10) * LDW + t] | ((unsigned)WT[(dkb + 11) * LDW + t] << 16);
        __builtin_nontemporal_store(o, (u32x4*)(slot + SL_NW + q * 16));
    }
    {
        const int dq = tl >> 7, tt = (tl >> 6) & 1, lp = tl & 63, hp = lp >> 5, rp = lp & 31;
        const float* ub = U + (32 * tt + 4 * hp) * 128 + 32 * dq + rp;
        u32x4 o0, o1;
#pragma unroll
        for (int e = 0; e < 4; ++e) {
            const int i0 = 2 * e, i1 = 2 * e + 1, i2 = 8 + 2 * e, i3 = 9 + 2 * e;
            o0[e] = pk2(ub[((i0 & 3) + 8 * (i0 >> 2)) * 128], ub[((i1 & 3) + 8 * (i1 >> 2)) * 128]);
            o1[e] = pk2(ub[((i2 & 3) + 8 * (i2 >> 2)) * 128], ub[((i3 & 3) + 8 * (i3 >> 2)) * 128]);
        }
        u32x4* dst = (u32x4*)(slot + SL_UB + tl * 32);
        __builtin_nontemporal_store(o0, dst); __builtin_nontemporal_store(o1, dst + 1);
    }
    __syncthreads();
}

DI void gdn_scan_unit(const Args& a, int bh, unsigned char* lds, const int wv_) {
    const bf16* Z = (const bf16*)(a.ws + WS_ZH); bf16* MIX = (bf16*)(a.ws + WS_MIX);
    const float* PAR = (const float*)(a.ws + WS_PAR); const float* EGL = (const float*)(a.ws + WS_EGL);
    const int b = bh >> 2, h = bh & 3;
    int tid = TIDX(wv_); asm volatile("" : "+v"(tid));
    f32x16 S[4];
#pragma unroll
    for (int kb = 0; kb < 4; ++kb)
#pragma unroll
        for (int i = 0; i < 16; ++i) S[kb][i] = 0.f;
    {
        const unsigned char* sl = gdn_slot(a.ws, bh * 32);
        for (int q = tid; q < SL_BYTES / 16; q += 512) *(u32x4*)(lds + q * 16) = __builtin_nontemporal_load((const u32x4*)(sl + q * 16));
    }
    __syncthreads();
    u32x4 gate_na, gate_nb; float egl_n;
    {
        const u32x4* gp0 = (const u32x4*)(Z + ((size_t)b * SEQ + (tid >> 3)) * N0 + 3072 + h * 128 + (tid & 7) * 16);
        gate_na = __builtin_nontemporal_load(gp0); gate_nb = __builtin_nontemporal_load(gp0 + 1); egl_n = EGL[bh * 32];
    }
#pragma unroll 1
    for (int ch = 0; ch < 32; ++ch) {
        int tl = tid; asm volatile("" : "+v"(tl));
        const int lane = tl & 63, w = tl >> 6, r = lane & 31, hh = lane >> 5, dq = w & 3;
        const int idx = bh * 32 + ch;
        const unsigned cur = (ch & 1) * SL_BYTES, nxt = ((ch + 1) & 1) * SL_BYTES;
        const u32x4 gate_a = gate_na, gate_b = gate_nb; const float egl = egl_n;
        f32x4 gng[4];
#pragma unroll
        for (int q = 0; q < 4; ++q) gng[q] = *(const f32x4*)(PAR + P_GON + (tl & 7) * 16 + 4 * q);
        f32x16 O0, O1;
        if (w >= 4) {
            if (ch < 31) {
                const unsigned char* sl = gdn_slot(a.ws, idx + 1) + (tl - 256) * 16;
                unsigned char* dl = lds + nxt + (tl - 256) * 16;
#pragma unroll
                for (int k0 = 0; k0 < 18; k0 += 6) {
                    u32x4 stage[6];
#pragma unroll
                    for (int k = 0; k < 6; ++k) { if (k0 + k < 17 || tl - 256 < 128) stage[k] = __builtin_nontemporal_load((const u32x4*)(sl + (k0 + k) * 4096)); }
#pragma unroll
                    for (int k = 0; k < 6; ++k) { if (k0 + k < 17 || tl - 256 < 128) *(u32x4*)(dl + (k0 + k) * 4096) = stage[k]; }
                }
            }
        } else {
            lds_u8* l3 = (lds_u8*)lds;
            unsigned fo = cur + lane * 16; asm volatile("" : "+v"(fo)); const lds_u8* fp = l3 + fo;
#define LFRAG(o_) (*(const __attribute__((address_space(3))) bf16x8*)(fp + (o_)))
            bf16x8 xs[8];
#pragma unroll
            for (int kb = 0; kb < 4; ++kb)
#pragma unroll
                for (int s2 = 0; s2 < 2; ++s2) {
                    u32x4 t4;
#pragma unroll
                    for (int e = 0; e < 4; ++e) t4[e] = pk2(S[kb][8 * s2 + 2 * e], S[kb][8 * s2 + 2 * e + 1]);
                    xs[2 * kb + s2] = __builtin_bit_cast(bf16x8, t4);
                }
            f32x16 V0, V1;
            {
                const __attribute__((address_space(3))) u32x4* up = (const __attribute__((address_space(3))) u32x4*)(l3 + cur + SL_UB + ((dq * 2) * 64 + lane) * 32);
                const u32x4 a0 = up[0], a1 = up[1], b0 = up[128], b1 = up[129];
#pragma unroll
                for (int e = 0; e < 4; ++e) {
                    V0[2 * e] = bflo(a0[e]); V0[2 * e + 1] = bfhi(a0[e]); V0[8 + 2 * e] = bflo(a1[e]); V0[9 + 2 * e] = bfhi(a1[e]);
                    V1[2 * e] = bflo(b0[e]); V1[2 * e + 1] = bfhi(b0[e]); V1[8 + 2 * e] = bflo(b1[e]); V1[9 + 2 * e] = bfhi(b1[e]);
                }
            }
#pragma unroll
            for (int i = 0; i < 16; ++i) { O0[i] = 0.f; O1[i] = 0.f; }
#pragma unroll
            for (int ks = 0; ks < 8; ++ks) {
                V0 = MFMA32(LFRAG(SL_NW + (0 * 8 + ks) * 1024), xs[ks], V0);
                V1 = MFMA32(LFRAG(SL_NW + (1 * 8 + ks) * 1024), xs[ks], V1);
                O0 = MFMA32(LFRAG(SL_QD + (0 * 8 + ks) * 1024), xs[ks], O0);
                O1 = MFMA32(LFRAG(SL_QD + (1 * 8 + ks) * 1024), xs[ks], O1);
            }
            bf16x8 vx[4];
#pragma unroll
            for (int s2 = 0; s2 < 2; ++s2) {
                u32x4 t4, t5;
#pragma unroll
                for (int e = 0; e < 4; ++e) { t4[e] = pk2(V0[8 * s2 + 2 * e], V0[8 * s2 + 2 * e + 1]); t5[e] = pk2(V1[8 * s2 + 2 * e], V1[8 * s2 + 2 * e + 1]); }
                vx[s2] = __builtin_bit_cast(bf16x8, t4); vx[2 + s2] = __builtin_bit_cast(bf16x8, t5);
            }
#pragma unroll
            for (int ks = 0; ks < 2; ++ks) O0 = MFMA32(LFRAG(SL_AI + ks * 1024), vx[ks], O0);
#pragma unroll
            for (int ks = 0; ks < 4; ++ks) O1 = MFMA32(LFRAG(SL_AI + 2048 + ks * 1024), vx[ks], O1);
#pragma unroll
            for (int kb = 0; kb < 4; ++kb) {
#pragma unroll
                for (int i = 0; i < 16; ++i) S[kb][i] *= egl;
#pragma unroll
                for (int ks = 0; ks < 4; ++ks) S[kb] = MFMA32(LFRAG(SL_KD + (kb * 4 + ks) * 1024), vx[ks], S[kb]);
            }
#undef LFRAG
        }
        __syncthreads();
        if (w < 4) {
            unsigned obo = cur + ((4 * hh) * 128 + 32 * dq + r) * 4; asm volatile("" : "+v"(obo)); lds_f32* ob = (lds_f32*)((lds_u8*)lds + obo);
#pragma unroll
            for (int i = 0; i < 16; ++i) { ob[((i & 3) + 8 * (i >> 2)) * 128] = O0[i]; ob[(32 + (i & 3) + 8 * (i >> 2)) * 128] = O1[i]; }
        }
        __syncthreads();
        {
            const int cn = ch < 31 ? ch + 1 : ch;
            const u32x4* gpn = (const u32x4*)(Z + ((size_t)b * SEQ + cn * 64 + (tl >> 3)) * N0 + 3072 + h * 128 + (tl & 7) * 16);
            gate_na = __builtin_nontemporal_load(gpn); gate_nb = __builtin_nontemporal_load(gpn + 1); egl_n = EGL[bh * 32 + cn];
        }
        norm_gate_store_pre((const float*)(lds + cur), gng, gate_a, gate_b, MIX + ((size_t)b * SEQ + ch * 64) * 1024 + 512 + h * 128, tl);
        __syncthreads();
    }
}

constexpr int L_QD = 0, L_KD = 16384, L_AI = 32768, L_VF = 40960, L_DEC = 57344, L_BF = 57856, L_QH = 90624, L_KH = 108032;
DI void hgrn_unit(const Args& a, int b, int h, unsigned char* lds, const int wv_) {
    const bf16* Z = (const bf16*)(a.ws + WS_ZH); bf16* MIX = (bf16*)(a.ws + WS_MIX);
    unsigned char* QD = lds + L_QD; unsigned char* KD = lds + L_KD; unsigned char* AI = lds + L_AI; unsigned char* VF = lds + L_VF;
    float* DEC = (float*)(lds + L_DEC); float* Bf = (float*)(lds + L_BF); bf16* QH = (bf16*)(lds + L_QH); bf16* KH = (bf16*)(lds + L_KH);
    float* TOT = (float*)(lds + L_KH + 17408);
    int tid = TIDX(wv_); asm volatile("" : "+v"(tid));
    const float* PAR = (const float*)(a.ws + WS_PAR); const float* lbl = PAR + P_LB;
    f32x16 S[4];
#pragma unroll
    for (int kb = 0; kb < 4; ++kb)
#pragma unroll
        for (int i = 0; i < 16; ++i) S[kb][i] = 0.f;
    unsigned pq[8], pf[8], pi[8];
    float lb0, lb1;
    {
        const int lane = tid & 63, w = tid >> 6, cg0 = h * 128 + 2 * lane;
        lb0 = 1.0f / (1.0f + __expf(lbl[cg0] - lbl[1024 + cg0])); lb1 = 1.0f / (1.0f + __expf(lbl[cg0 + 1] - lbl[1024 + cg0 + 1]));
#pragma unroll
        for (int rr = 0; rr < 8; ++rr) {
            const bf16* zp = Z + ((size_t)b * SEQ + 8 * w + rr) * 4096 + cg0;
            pq[rr] = __builtin_nontemporal_load((const unsigned*)zp); pf[rr] = __builtin_nontemporal_load((const unsigned*)(zp + 1024)); pi[rr] = __builtin_nontemporal_load((const unsigned*)(zp + 2048));
        }
    }
#pragma unroll 1
    for (int ch = 0; ch < 32; ++ch) {
        const int t0 = ch * 64;
        int tl = tid; asm volatile("" : "+v"(tl));
        const int lane = tl & 63, w = tl >> 6, r = lane & 31, hh = lane >> 5, c0 = 2 * lane, cg0 = h * 128 + c0;
        float qv[8][2], kv[8][2], Bl[8][2];
        {
            float run0 = 0.f, run1 = 0.f;
#pragma unroll
            for (int rr = 0; rr < 8; ++rr) {
                const int t = 8 * w + rr;
                const unsigned uq = pq[rr], uf = pf[rr], ui = pi[rr];
                qv[rr][0] = silu_(bflo(uq)); qv[rr][1] = silu_(bfhi(uq));
                const float f0 = lb0 + (1.f - lb0) * sigmoid_(bflo(uf)), f1 = lb1 + (1.f - lb1) * sigmoid_(bfhi(uf));
                kv[rr][0] = 1.f - f0; kv[rr][1] = 1.f - f1;
                run0 += __logf(f0); run1 += __logf(f1);
                Bl[rr][0] = run0; Bl[rr][1] = run1;
#pragma unroll
                for (int e = 0; e < 2; ++e) {
                    const int dv = c0 + e; const int off = ((((dv >> 5) * 4 + (t >> 4)) * 64) + ((t >> 3) & 1) * 32 + (dv & 31)) * 16 + (t & 7) * 2;
                    *(bf16*)(VF + off) = (bf16)(e ? (ui >> 16) : (ui & 0xffffu));
                }
            }
            TOT[w * 128 + c0] = run0; TOT[w * 128 + c0 + 1] = run1;
        }
        {
            const int tn = (ch < 31 ? t0 + 64 : t0);
#pragma unroll
            for (int rr = 0; rr < 8; ++rr) {
                const bf16* zp = Z + ((size_t)b * SEQ + tn + 8 * w + rr) * 4096 + cg0;
                pq[rr] = __builtin_nontemporal_load((const unsigned*)zp); pf[rr] = __builtin_nontemporal_load((const unsigned*)(zp + 1024)); pi[rr] = __builtin_nontemporal_load((const unsigned*)(zp + 2048));
            }
        }
        const u32x4* gatep = (const u32x4*)(Z + ((size_t)b * SEQ + t0 + (tl >> 3)) * 4096 + 3072 + h * 128 + (tl & 7) * 16);
        const u32x4 gate_a = __builtin_nontemporal_load(gatep), gate_b = __builtin_nontemporal_load(gatep + 1);

        __syncthreads();
        {
            float off0 = 0.f, off1 = 0.f, bm0 = 0.f, bm1 = 0.f, bl0 = 0.f, bl1 = 0.f;
#pragma unroll
            for (int ww = 0; ww < 8; ++ww) {
                const float t0v = TOT[ww * 128 + c0], t1v = TOT[ww * 128 + c0 + 1];
                if (ww < w) { off0 += t0v; off1 += t1v; }
                if (ww < 4) { bm0 += t0v; bm1 += t1v; }
                bl0 += t0v; bl1 += t1v;
            }
            if (w == 0) { DEC[c0] = __expf(bl0); DEC[c0 + 1] = __expf(bl1); }
#pragma unroll
            for (int rr = 0; rr < 8; ++rr) {
                const int t = 8 * w + rr;
                const float B0 = Bl[rr][0] + off0, B1 = Bl[rr][1] + off1;
                const float qd0 = qv[rr][0] * __expf(B0), qd1 = qv[rr][1] * __expf(B1);
                const float qh0 = qv[rr][0] * __expf(fminf(B0 - bm0, 80.f)), qh1 = qv[rr][1] * __expf(fminf(B1 - bm1, 80.f));
                const float kh0 = kv[rr][0] * __expf(fminf(bm0 - B0, 80.f)), kh1 = kv[rr][1] * __expf(fminf(bm1 - B1, 80.f));
                const float kd0 = kv[rr][0] * __expf(bl0 - B0), kd1 = kv[rr][1] * __expf(bl1 - B1);
                {
                    const int ks = c0 >> 4, x = c0 & 15, hp = (x >> 2) & 1, j = ((x >> 3) << 2) | (x & 3);
                    const int off = ((((t >> 5) * 8 + ks) * 64) + hp * 32 + (t & 31)) * 16 + j * 2;
                    *(unsigned*)(QD + off) = pk2(qd0, qd1);
                }
#pragma unroll
                for (int e = 0; e < 2; ++e) {
                    const int dk = c0 + e; const int off = ((((dk >> 5) * 4 + (t >> 4)) * 64) + ((t >> 3) & 1) * 32 + (dk & 31)) * 16 + (t & 7) * 2;
                    *(bf16*)(KD + off) = f2bf(e ? kd1 : kd0);
                }
                *(unsigned*)(QH + t * LDH + c0) = pk2(qh0, qh1);
                *(unsigned*)(KH + t * LDH + c0) = pk2(kh0, kh1);
            }
        }
        __syncthreads();
        {
            const int fr = lane & 15, fq = lane >> 4, tb = w >> 1;
#pragma unroll
            for (int si = 0; si < 2; ++si) {
                const int sb = 2 * (w & 1) + si; f32x4 acc = {0.f, 0.f, 0.f, 0.f};
#pragma unroll
                for (int kk = 0; kk < 4; ++kk) {
                    const bf16x8 av = *(const bf16x8*)(QH + (16 * tb + fr) * LDH + kk * 32 + fq * 8);
                    const bf16x8 bv = *(const bf16x8*)(KH + (16 * sb + fr) * LDH + kk * 32 + fq * 8);
                    acc = MFMA16(av, bv, acc);
                }
#pragma unroll
                for (int jj = 0; jj < 4; ++jj) {
                    const int t = 16 * tb + 4 * fq + jj, s2 = 16 * sb + fr;
                    const float val = s2 <= t ? acc[jj] : 0.f;
                    const int off = ((((t >> 5) * 4 + (s2 >> 4)) * 64) + ((s2 >> 3) & 1) * 32 + (t & 31)) * 16 + (s2 & 7) * 2;
                    *(bf16*)(AI + off) = f2bf(val);
                }
            }
        }
        __syncthreads();
        if (w < 4) {
            const int dq = w;
            bf16x8 xs[8];
#pragma unroll
            for (int kb = 0; kb < 4; ++kb)
#pragma unroll
                for (int s2 = 0; s2 < 2; ++s2) {
                    u32x4 t4;
#pragma unroll
                    for (int e = 0; e < 4; ++e) t4[e] = pk2(S[kb][8 * s2 + 2 * e], S[kb][8 * s2 + 2 * e + 1]);
                    xs[2 * kb + s2] = __builtin_bit_cast(bf16x8, t4);
                }
            f32x16 O0, O1;
            unsigned obo = L_BF + ((4 * hh) * 128 + 32 * dq + r) * 4; asm volatile("" : "+v"(obo)); lds_f32* ob = (lds_f32*)((lds_u8*)lds + obo);
#pragma unroll
            for (int i = 0; i < 16; ++i) { O0[i] = 0.f; O1[i] = 0.f; }
            lds_u8* l3 = (lds_u8*)lds; unsigned fo = lane * 16; asm volatile("" : "+v"(fo)); const lds_u8* fp = l3 + fo;
#define HF(o_) (*(const __attribute__((address_space(3))) bf16x8*)(fp + (o_)))
#define SB() __builtin_amdgcn_sched_barrier(0)
            bf16x8 ga[8], gb[8];
#pragma unroll
            for (int k = 0; k < 4; ++k) { ga[k] = HF(L_QD + (0 * 8 + k) * 1024); ga[4 + k] = HF(L_QD + (1 * 8 + k) * 1024); }
#pragma unroll
            for (int k = 0; k < 4; ++k) { gb[k] = HF(L_QD + (0 * 8 + 4 + k) * 1024); gb[4 + k] = HF(L_QD + (1 * 8 + 4 + k) * 1024); }
            SB();
#pragma unroll
            for (int k = 0; k < 4; ++k) { O0 = MFMA32(ga[k], xs[k], O0); O1 = MFMA32(ga[4 + k], xs[k], O1); }
            SB();
#pragma unroll
            for (int k = 0; k < 4; ++k) ga[k] = HF(L_VF + (dq * 4 + k) * 1024);
            ga[4] = HF(L_AI + (0 * 4 + 0) * 1024); ga[5] = HF(L_AI + (0 * 4 + 1) * 1024); ga[6] = HF(L_AI + (1 * 4 + 0) * 1024); ga[7] = HF(L_AI + (1 * 4 + 1) * 1024);
            SB();
#pragma unroll
            for (int k = 0; k < 4; ++k) { O0 = MFMA32(gb[k], xs[4 + k], O0); O1 = MFMA32(gb[4 + k], xs[4 + k], O1); }
            SB();
            gb[0] = HF(L_AI + (1 * 4 + 2) * 1024); gb[1] = HF(L_AI + (1 * 4 + 3) * 1024);
#pragma unroll
            for (int k = 0; k < 4; ++k) gb[2 + k] = HF(L_KD + (0 * 4 + k) * 1024);
            f32x4 dd[4];
#define LDD(kb_) do { _Pragma("unroll") for (int g = 0; g < 4; ++g) dd[g] = *(const f32x4*)(DEC + 32 * (kb_) + 8 * g + 4 * hh); } while (0)
#define MULD(kb_) do { _Pragma("unroll") for (int g = 0; g < 4; ++g) _Pragma("unroll") for (int e = 0; e < 4; ++e) S[kb_][4 * g + e] *= dd[g][e]; } while (0)
            LDD(0);
            SB();
            const bf16x8 vf0 = ga[0], vf1 = ga[1], vf2 = ga[2], vf3 = ga[3];
            O0 = MFMA32(ga[4], vf0, O0); O0 = MFMA32(ga[5], vf1, O0); O1 = MFMA32(ga[6], vf0, O1); O1 = MFMA32(ga[7], vf1, O1);
            SB();
#pragma unroll
            for (int k = 0; k < 4; ++k) ga[4 + k] = HF(L_KD + (1 * 4 + k) * 1024);
            SB();
            O1 = MFMA32(gb[0], vf2, O1); O1 = MFMA32(gb[1], vf3, O1);
            MULD(0);
            S[0] = MFMA32(gb[2], vf0, S[0]); S[0] = MFMA32(gb[3], vf1, S[0]); S[0] = MFMA32(gb[4], vf2, S[0]); S[0] = MFMA32(gb[5], vf3, S[0]);
            SB();
            LDD(1);
#pragma unroll
            for (int k = 0; k < 4; ++k) gb[k] = HF(L_KD + (2 * 4 + k) * 1024);
            SB();
            MULD(1);
            S[1] = MFMA32(ga[4], vf0, S[1]); S[1] = MFMA32(ga[5], vf1, S[1]); S[1] = MFMA32(ga[6], vf2, S[1]); S[1] = MFMA32(ga[7], vf3, S[1]);
            SB();
            LDD(2);
#pragma unroll
            for (int k = 0; k < 4; ++k) ga[4 + k] = HF(L_KD + (3 * 4 + k) * 1024);
            SB();
            MULD(2);
            S[2] = MFMA32(gb[0], vf0, S[2]); S[2] = MFMA32(gb[1], vf1, S[2]); S[2] = MFMA32(gb[2], vf2, S[2]); S[2] = MFMA32(gb[3], vf3, S[2]);
            SB();
            LDD(3);
            SB();
            MULD(3);
            S[3] = MFMA32(ga[4], vf0, S[3]); S[3] = MFMA32(ga[5], vf1, S[3]); S[3] = MFMA32(ga[6], vf2, S[3]); S[3] = MFMA32(ga[7], vf3, S[3]);
#undef LDD
#undef MULD
#undef HF
#undef SB
#pragma unroll
            for (int i = 0; i < 16; ++i) { ob[((i & 3) + 8 * (i >> 2)) * 128] = O0[i]; ob[(32 + (i & 3) + 8 * (i >> 2)) * 128] = O1[i]; }
        }
        f32x4 gnh[4];
#pragma unroll
        for (int q = 0; q < 4; ++q) gnh[q] = *(const f32x4*)(PAR + P_HON + (tl & 7) * 16 + 4 * q);
        __syncthreads();
        norm_gate_store_pre(Bf, gnh, gate_a, gate_b, MIX + ((size_t)b * SEQ + t0) * 1024 + h * 128, tl);
    }
    __syncthreads();
}

#define LAS __attribute__((address_space(3)))
#define XB_TMO      128
#define XB_XCNT(j)  (256  + 64 * (j))
#define XB_XSUB(j)  (1280 + 64 * (j))
#define XB_XGEN(j)  (2304 + 64 * (j))
#define XB_TOP      3328
#define XB_TOPGEN   3392
#define XCD_BAR_WORDS 3456
#define XB_SPIN_CAP (1u << 18)

__device__ __forceinline__ unsigned xb_ld(unsigned* p)              { return __hip_atomic_load(p, __ATOMIC_RELAXED, __HIP_MEMORY_SCOPE_AGENT); }
__device__ __forceinline__ unsigned xb_add(unsigned* p, unsigned v) { return __hip_atomic_fetch_add(p, v, __ATOMIC_RELAXED, __HIP_MEMORY_SCOPE_AGENT); }
__device__ __forceinline__ unsigned xb_xcc_id() { return (unsigned)__builtin_amdgcn_s_getreg((3 << 11) | 20) & 0xFu; }
#define XB_SPIN(cond, bar) do { unsigned _sp = 0; while (cond) { __builtin_amdgcn_s_sleep(1); \
    if ((++_sp & 255u) == 0u) { if (xb_ld(&(bar)[XB_TMO])) break; if (_sp > XB_SPIN_CAP) { atomicAdd(&(bar)[XB_TMO], 1u); break; } } } } while (0)

struct XcdBarrier {
    unsigned* bar; unsigned x;
    volatile LAS unsigned* st;
};

__device__ __forceinline__ XcdBarrier xcd_barrier_post(unsigned* bar, volatile LAS unsigned* st, const bool t0_) {
    XcdBarrier b; b.bar = bar; b.x = xb_xcc_id(); b.st = st;
    if (t0_) (void)xb_add(&bar[XB_XCNT(b.x)], 1u);
    return b;
}
__device__ __forceinline__ void xcd_barrier_complete(unsigned* bar, unsigned x, unsigned& nloc, unsigned& nx) {
    const unsigned G = gridDim.x * gridDim.y * gridDim.z;
    unsigned sum, cnt, mine, sp = 0u;
    for (;;) {
        sum = 0u; cnt = 0u; mine = 0u;
#pragma unroll
        for (unsigned j = 0; j < 16; ++j) { const unsigned c = xb_ld(&bar[XB_XCNT(j)]); sum += c; cnt += (c > 0u) ? 1u : 0u; mine = (j == x) ? c : mine; }
        if (sum == G) break;
        __builtin_amdgcn_s_sleep(1);
        if ((++sp & 255u) == 0u) { if (xb_ld(&bar[XB_TMO])) break; if (sp > XB_SPIN_CAP) { atomicAdd(&bar[XB_TMO], 1u); break; } }
    }
    nloc = mine > 0u ? mine : 1u; nx = cnt > 0u ? cnt : 1u;
}

__device__ __forceinline__ void xcd_barrier(const XcdBarrier& b, const bool t0_) {
    asm volatile("s_waitcnt vmcnt(0)" ::: "memory");
    __syncthreads();
    if (t0_) {
        unsigned* bar = b.bar;
        __builtin_amdgcn_s_waitcnt(0);
        unsigned nloc = b.st[0], nx = b.st[1];
        if (nloc == 0u) { xcd_barrier_complete(bar, b.x, nloc, nx); b.st[0] = nloc; b.st[1] = nx; }
        const unsigned old = xb_add(&bar[XB_XSUB(b.x)], 1u);
        const unsigned gen = old / nloc;
        if (old + 1u == (gen + 1u) * nloc) {
            __builtin_amdgcn_fence(__ATOMIC_RELEASE, "agent");
            asm volatile("s_waitcnt vmcnt(0)" ::: "memory");
            const unsigned og = xb_add(&bar[XB_TOP], 1u);
            const unsigned tg = og / nx;
            if (og + 1u == (tg + 1u) * nx) xb_add(&bar[XB_TOPGEN], 1u);
            else XB_SPIN(xb_ld(&bar[XB_TOPGEN]) == tg, bar);
            __builtin_amdgcn_fence(__ATOMIC_ACQUIRE, "agent");
            xb_add(&bar[XB_XGEN(b.x)], 1u);
            asm volatile("s_waitcnt vmcnt(0)" ::: "memory");
        } else {
            XB_SPIN(xb_ld(&bar[XB_XGEN(b.x)]) == gen, bar);
            __builtin_amdgcn_fence(__ATOMIC_ACQUIRE, "agent");
            asm volatile("s_waitcnt vmcnt(0)" ::: "memory");
        }
    }
    __syncthreads();
}

__global__ void __launch_bounds__(512, 2) trunk_fwd(Args a) {
    extern __shared__ __attribute__((aligned(16))) unsigned char lds[];
    __builtin_assume(__builtin_amdgcn_workitem_id_y() == 0); __builtin_assume(__builtin_amdgcn_workitem_id_z() == 0);
    cg::grid_group grid = cg::this_grid();
    const int G = gridDim.x, blk = blockIdx.x;
    unsigned char* ws = a.ws;
    PG8_LAS unsigned char* lds3 = (PG8_LAS unsigned char*)lds;
    bf16* XB = (bf16*)(ws + WS_XB); bf16* MIX = (bf16*)(ws + WS_MIX); bf16* ZH = (bf16*)(ws + WS_ZH); float* SS = (float*)(ws + WS_SS);

    volatile LAS unsigned* bst = (volatile LAS unsigned*)((LAS unsigned char*)lds + (LDS_BYTES - 64));
    const int WV = __builtin_amdgcn_readfirstlane((int)(threadIdx.x >> 6));
    if (WV == 0 && lane_id_() == 0) { bst[0] = 0u; bst[1] = 0u; }
    __syncthreads();
    (void)xcd_barrier_post((unsigned*)(ws + WS_BAR), bst, WV == 0 && lane_id_() == 0);
#define GRID_BAR() do { unsigned char* wsl_ = a.ws; asm volatile("" : "+s"(wsl_)); XcdBarrier xb_; xb_.bar = (unsigned*)(wsl_ + WS_BAR); xb_.x = xb_xcc_id(); xb_.st = (volatile LAS unsigned*)((LAS unsigned char*)lds + (LDS_BYTES - 64)); xcd_barrier(xb_, WV == 0 && lane_id_() == 0); } while (0)
    p0_prologue(a, lds, WV);
    if (a.ws == nullptr) grid.sync();
    GRID_BAR();
    _Pragma("unroll") for (int layer = 0; layer < 2; ++layer) {
        const int NIN = layer == 0 ? N0 : 4096;
        if (layer == 0) {
            pg8::Gemm g{XB, (const bf16*)(ws + WS_W0IN), M, N0, 1024}; int blkl = blk; asm volatile("" : "+s"(blkl)); pg8::StaticOrder S; S.init(M, N0, G, blkl, WGM_WIDE);
            rs_table_build<true>(lds, SS, S, WV);
            EpiAct<2> E{ZH, N0, (const float*)(ws + WS_PAR), (const lds_f32_t*)((PG8_LAS unsigned char*)lds + RS_OFF), 0};
            pg8::gemm_phase<EpiAct<2>, pg8::StaticOrder, true, true>(lds3, g, S, E, WV);
        } else {
            pg8::Gemm g{XB, (const bf16*)(ws + WS_W1IN), M, 4096, 1024}; int blkl = blk; asm volatile("" : "+s"(blkl)); pg8::StaticOrder S; S.init(M, 4096, G, blkl, WGM_WIDE);
            rs_table_build<false>(lds, SS + (size_t)2 * SS_STRIDE, S, WV);
            EpiAct<0> E{ZH, 4096, nullptr, (const lds_f32_t*)((PG8_LAS unsigned char*)lds + RS_OFF), 0};
            pg8::gemm_phase<EpiAct<0>, pg8::StaticOrder, true, true>(lds3, g, S, E, WV);
        }
        GRID_BAR();
        if (layer == 0) {
            fox_prep(a, WV);
            for (int u = blk; u < 2048; u += G) gdn_prep_unit(a, u, lds, WV);
            GRID_BAR();
            const float* C2g = (const float*)(ws + WS_C2);
            int Gl = G; asm volatile("" : "+s"(Gl));
            const bool bal = (Gl == 256); const int sstride = bal ? 64 : Gl;
            if (blk < sstride) for (int u = blk; u < 64; u += sstride) gdn_scan_unit(a, u, lds, WV);
            const int nk = bal ? 4 : (1024 + Gl - 1) / Gl;
#pragma unroll 1
            for (int k = 0; k < nk; ++k) {
                const int i = blk - 64;
                const int u = bal ? (blk < 64 ? 768 + 64 * k + blk : 192 * k + ((k & 1) ? 191 - i : i)) : blk + Gl * k;
                if (u < 1024) { const int qb = 7 - (u >> 7), bh = u & 127; fox_unit(ZH, C2g, MIX, bh >> 3, bh & 7, qb, lds, WV); }
            }
        } else {
            for (int u = blk; u < 128; u += G) hgrn_unit(a, u >> 3, u & 7, lds, WV);
        }
        GRID_BAR();
        if (layer == 0) {
            pg8::Gemm g{MIX, (const bf16*)(ws + WS_W0OUT), M, 1024, 1024}; int blkl = blk; asm volatile("" : "+s"(blkl)); pg8::StaticOrder S; S.init(M, 1024, G, blkl);
            EpiRes<false, false> E{a.in[0], nullptr, XB, SS + (size_t)1 * SS_STRIDE};
            pg8::gemm_phase<EpiRes<false, false>, pg8::StaticOrder, true, true>(lds3, g, S, E, WV);
        } else {
            pg8::Gemm g{MIX, (const bf16*)(ws + WS_W1OUT), M, 1024, 1024}; int blkl = blk; asm volatile("" : "+s"(blkl)); pg8::StaticOrder S; S.init(M, 1024, G, blkl);
            EpiRes<true, false> E{XB, nullptr, XB, SS + (size_t)3 * SS_STRIDE};
            pg8::gemm_phase<EpiRes<true, false>, pg8::StaticOrder, true, true>(lds3, g, S, E, WV);
        }
        GRID_BAR();
        {
            pg8::Gemm g{XB, (const bf16*)(ws + (layer == 0 ? WS_W0F1 : WS_W1F1)), M, 4096, 1024}; int blkl = blk; asm volatile("" : "+s"(blkl)); pg8::StaticOrder S; S.init(M, 4096, G, blkl, WGM_WIDE);
            rs_table_build<false>(lds, SS + (size_t)(2 * layer + 1) * SS_STRIDE, S, WV);
            EpiAct<1> E{ZH, 4096, nullptr, (const lds_f32_t*)((PG8_LAS unsigned char*)lds + RS_OFF), 0};
            pg8::gemm_phase<EpiAct<1>, pg8::StaticOrder, true, true>(lds3, g, S, E, WV);
        }
        GRID_BAR();
        if (layer == 0) {
            pg8::Gemm g{ZH, (const bf16*)(ws + WS_W0F2), M, 1024, 4096}; int blkl = blk; asm volatile("" : "+s"(blkl)); pg8::StaticOrder S; S.init(M, 1024, G, blkl);
            EpiRes<true, false> E{XB, nullptr, XB, SS + 2 * SS_STRIDE};
            pg8::gemm_phase<EpiRes<true, false>, pg8::StaticOrder, true, true>(lds3, g, S, E, WV);
        } else {
            pg8::Gemm g{ZH, (const bf16*)(ws + WS_W1F2), M, 1024, 4096}; int blkl = blk; asm volatile("" : "+s"(blkl)); pg8::StaticOrder S; S.init(M, 1024, G, blkl);
            EpiRes<true, true> E{XB, a.out, nullptr, nullptr};
            pg8::gemm_phase<EpiRes<true, true>, pg8::StaticOrder, true, true>(lds3, g, S, E, WV);
        }
        if (layer == 0) GRID_BAR();
    }
}

extern "C" void kernel_launch(void* const* d_in, const int* in_sizes, int n_in, void* d_out, int out_size, void* d_ws, size_t ws_size, hipStream_t stream) {
    static int grid = 0;
    if (grid == 0) {
        if (n_in != 22 || out_size != M * DM || ws_size < WS_END) { fprintf(stderr, "kernel_launch: unexpected problem (n_in %d out %d ws %zu)\n", n_in, out_size, ws_size); grid = -1; return; }
        int dev = 0, cus = 0, per_cu = 0;
        (void)hipGetDevice(&dev);
        (void)hipDeviceGetAttribute(&cus, hipDeviceAttributeMultiprocessorCount, dev);
        (void)hipFuncSetAttribute((const void*)trunk_fwd, hipFuncAttributeMaxDynamicSharedMemorySize, LDS_BYTES);
        (void)hipOccupancyMaxActiveBlocksPerMultiprocessor(&per_cu, (const void*)trunk_fwd, 512, LDS_BYTES);
        if (per_cu < 1) per_cu = 1;
        grid = cus * per_cu;
        fprintf(stderr, "kernel_launch: grid %d (cus %d x %d)\n", grid, cus, per_cu);
    }
    if (grid < 0) return;
    Args a{};
    for (int i = 0; i < 22; ++i) a.in[i] = (const float*)d_in[i];
    a.out = (float*)d_out; a.ws = (unsigned char*)d_ws;
    (void)hipMemsetAsync((unsigned char*)d_ws + WS_BAR, 0, 16384, stream);
    void* args[] = {&a};
    hipError_t e = hipLaunchCooperativeKernel((const void*)trunk_fwd, dim3(grid), dim3(512), args, LDS_BYTES, stream);
    if (e != hipSuccess) fprintf(stderr, "kernel_launch: cooperative launch failed: %s (grid %d)\n", hipGetErrorString(e), grid);
}
```
